# Optimizing an MI355X kernel written in HIP

```python
import jax
import jax.numpy as jnp
from jax import lax
import numpy as np

D_MODEL = 1024
BATCH = 16
SEQ = 256
DEPTH = 2
DEC_BATCH = 4
DEC_SEQ = 4096
PAST_LEN = 512

GRID_W = 64
EPS = 1e-6
GN_EPS = 64e-5
CHUNK = 64
Q_BLOCK = 128
ROPE_THETA = 10000.0

RW_HEADS = 8
RW_DIM = 64
RW_W = RW_HEADS * RW_DIM
RW_LORA_W = 64
RW_LORA_A = 64
RW_SLAB = 3 * RW_W + 2 * RW_LORA_W + RW_LORA_A
RW_DECAY_SCALE = 0.6065306597126334

AT_HEADS = 8
AT_KV_HEADS = 2
AT_DIM = 64
AT_W = AT_HEADS * AT_DIM
AT_KV_W = AT_KV_HEADS * AT_DIM
ATT_SCALE = AT_DIM ** -0.5

GLA_HEADS = 4
GLA_DK = 64
GLA_DV = 128
GLA_QK_W = GLA_HEADS * GLA_DK
GLA_W = GLA_HEADS * GLA_DV
GLA_LORA = 16
GLA_GATE_NORM = 16.0
GLA_SCALE = GLA_DK ** -0.5

GDN_HEADS = 4
GDN_DK = 128
GDN_DV = 128
GDN_QK_W = GDN_HEADS * GDN_DK
GDN_W = GDN_HEADS * GDN_DV
GDN_CONV = 3
GDN_SCALE = GDN_DK ** -0.5

L0_SPLITS = (RW_SLAB, RW_W, AT_W, AT_KV_W, AT_KV_W, AT_W)
L0_IN = sum(L0_SPLITS)
L0_OUT = RW_W + AT_W
L1_SPLITS = (GLA_QK_W, GLA_QK_W, GLA_W, GLA_LORA, GLA_LORA, GLA_W,
             2 * GDN_QK_W + GDN_W, GDN_HEADS, GDN_HEADS, GDN_HEADS, GDN_W)
L1_IN = sum(L1_SPLITS)
L1_OUT = GLA_W + GDN_W

kernel_name = 'hybrid_diffusion_rwkv7_gqa_gla_gdn_step'


def rmsnorm(x, g):
    xf = x.astype(jnp.float32)
    y = xf * lax.rsqrt(jnp.mean(xf * xf, axis=-1, keepdims=True) + EPS)
    return (y * g.astype(jnp.float32)).astype(x.dtype)


def l2norm(x):
    xf = x.astype(jnp.float32)
    return (xf * lax.rsqrt(jnp.sum(xf * xf, axis=-1, keepdims=True) + EPS)).astype(x.dtype)


def head_groupnorm(o, g, b):
    of = o.astype(jnp.float32)
    mu = jnp.mean(of, axis=-1, keepdims=True)
    var = jnp.mean(jnp.square(of - mu), axis=-1, keepdims=True)
    y = (of - mu) * lax.rsqrt(var + GN_EPS) * g.astype(jnp.float32) + b.astype(jnp.float32)
    return y.astype(o.dtype)


def split_cols(p, sizes):
    idx = [int(s) for s in np.cumsum(sizes)[:-1]]
    return jnp.split(p, idx, axis=-1)


def token_shift(p):
    prev = jnp.pad(p[:, :-1], ((0, 0), (1, 0), (0, 0)))
    nxt = jnp.pad(p[:, 1:], ((0, 0), (0, 1), (0, 0)))
    return 0.5 * (prev + nxt)


def centred_dwconv(x, w):
    k = w.shape[0]
    return lax.conv_general_dilated(
        x, w[:, None, :].astype(x.dtype), window_strides=(1,),
        padding=[(k // 2, k // 2)], dimension_numbers=('NWC', 'WIO', 'NWC'),
        feature_group_count=x.shape[-1])


def rope_2d(x):
    t = x.shape[1]
    rows = t // GRID_W
    row_id = jnp.repeat(jnp.arange(rows, dtype=jnp.float32), GRID_W)
    col_id = jnp.tile(jnp.arange(GRID_W, dtype=jnp.float32), rows)
    half = x.shape[-1] // 2
    nf = half // 2
    inv = ROPE_THETA ** (-jnp.arange(nf, dtype=jnp.float32) / nf)

    def rot(xh, pos):
        ang = pos[:, None] * inv[None, :]
        cos = jnp.cos(ang)[None, :, None, :].astype(x.dtype)
        sin = jnp.sin(ang)[None, :, None, :].astype(x.dtype)
        x1, x2 = xh[..., :nf], xh[..., nf:]
        return jnp.concatenate([x1 * cos - x2 * sin, x2 * cos + x1 * sin], axis=-1)

    return jnp.concatenate([rot(x[..., :half], row_id), rot(x[..., half:], col_id)], axis=-1)


def block_attention(q, k, v):
    b, tq, hq, dh = q.shape
    g = hq // AT_KV_HEADS
    qb = jnp.moveaxis(q.reshape(b, tq // Q_BLOCK, Q_BLOCK, AT_KV_HEADS, g, dh), 1, 0)

    def one_block(qblk):
        s = jnp.einsum('bqhgd,bkhd->bhgqk', qblk, k).astype(jnp.float32) * ATT_SCALE
        pr = jax.nn.softmax(s, axis=-1).astype(v.dtype)
        return jnp.einsum('bhgqk,bkhd->bqhgd', pr, v)

    o = lax.map(one_block, qb)
    return jnp.moveaxis(o, 0, 1).reshape(b, tq, hq, dh)


def rwkv_scan(s0, r, w, k, v, kk, a, reverse):
    def step(s, inp):
        r_t, w_t, k_t, v_t, kk_t, a_t = inp
        sa = jnp.einsum('bhvk,bhk->bhv', s, -kk_t)
        s = (s * w_t[:, :, None, :] + sa[..., None] * (kk_t * a_t)[:, :, None, :]
             + v_t[..., None] * k_t[:, :, None, :])
        return s, jnp.einsum('bhvk,bhk->bhv', s, r_t)

    xs = tuple(jnp.moveaxis(t, 1, 0) for t in (r, w, k, v, kk, a))
    s_fin, o = lax.scan(step, s0, xs, reverse=reverse)
    return s_fin, jnp.moveaxis(o, 0, 1)


def gla_chunked(q, k, v, logw, s0):
    b, t, h, dk = q.shape
    dt = q.dtype
    n = t // CHUNK

    def chunks(x):
        return jnp.moveaxis(x.reshape(b, n, CHUNK, h, x.shape[-1]), 1, 0)

    mask = jnp.tril(jnp.ones((CHUNK, CHUNK), dtype=bool))[None, :, :, None, None]

    def step(s, inp):
        q_c, k_c, v_c, g_c = inp
        cum = jnp.cumsum(g_c.astype(jnp.float32), axis=1)
        diff = cum[:, :, None] - cum[:, None, :]
        dec = jnp.where(mask, jnp.exp(jnp.minimum(diff, 0.0)), 0.0).astype(dt)
        att = jnp.einsum('bthd,bshd,btshd->bhts', q_c, k_c, dec)
        o = (jnp.einsum('bhts,bshv->bthv', att, v_c)
             + jnp.einsum('bthd,bhdv->bthv', q_c * jnp.exp(cum).astype(dt), s))
        last = cum[:, -1]
        k_dec = k_c * jnp.exp(last[:, None] - cum).astype(dt)
        s = s * jnp.exp(last).astype(dt)[..., None] + jnp.einsum('bshd,bshv->bhdv', k_dec, v_c)
        return s, o

    s_fin, o = lax.scan(step, s0, (chunks(q), chunks(k), chunks(v), chunks(logw)))
    return s_fin, jnp.moveaxis(o, 0, 1).reshape(b, t, h, v.shape[-1])


def gdn_chunked(q, k, v, beta, loga, s0):
    b, t, h, dk = q.shape
    dv = v.shape[-1]
    dt = q.dtype
    n = t // CHUNK

    def chunks(x):
        return x.reshape(b, n, CHUNK, h, x.shape[-1]).transpose(1, 0, 3, 2, 4)

    qc, kc, vc = chunks(q), chunks(k), chunks(v)
    bc = chunks(beta[..., None])[..., 0].astype(jnp.float32)
    g = jnp.cumsum(chunks(loga[..., None])[..., 0].astype(jnp.float32), axis=-1)
    dec = jnp.exp(jnp.minimum(g[..., :, None] - g[..., None, :], 0.0))
    strict = jnp.tril(jnp.ones((CHUNK, CHUNK), dtype=bool), -1)
    incl = jnp.tril(jnp.ones((CHUNK, CHUNK), dtype=bool))
    kk = jnp.einsum('nbhtd,nbhsd->nbhts', kc, kc).astype(jnp.float32)
    lhs = jnp.eye(CHUNK, dtype=jnp.float32) + jnp.where(strict, dec * kk * bc[..., None], 0.0)
    gam = jnp.exp(g)
    w_mat = lax.linalg.triangular_solve(
        lhs, (bc * gam)[..., None] * kc.astype(jnp.float32),
        left_side=True, lower=True, unit_diagonal=True).astype(dt)
    u_mat = lax.linalg.triangular_solve(
        lhs, bc[..., None] * vc.astype(jnp.float32),
        left_side=True, lower=True, unit_diagonal=True).astype(dt)
    aqk = jnp.where(incl, dec * jnp.einsum('nbhtd,nbhsd->nbhts', qc, kc).astype(jnp.float32),
                    0.0).astype(dt)
    q_g = qc * gam[..., None].astype(dt)
    k_dec = kc * jnp.exp(g[..., -1:] - g)[..., None].astype(dt)
    g_last = jnp.exp(g[..., -1]).astype(dt)

    def step(s, inp):
        w_c, u_c, a_c, q_c, k_c, gl = inp
        u = u_c - jnp.einsum('bhtd,bhdv->bhtv', w_c, s)
        o = jnp.einsum('bhtd,bhdv->bhtv', q_c, s) + jnp.einsum('bhts,bhsv->bhtv', a_c, u)
        s = s * gl[..., None, None] + jnp.einsum('bhsd,bhsv->bhdv', k_c, u)
        return s, o

    s_fin, o = lax.scan(step, s0, (w_mat, u_mat, aqk, q_g, k_dec, g_last))
    return s_fin, o.transpose(1, 0, 3, 2, 4).reshape(b, t, h, dv)


def mix_even(h, p, ctx):
    b, t, _ = h.shape
    proj = h @ p['w_in']
    slab, rw_gate, q, k, v, at_gate = split_cols(proj, L0_SPLITS)
    slab = slab + p['rw_mu'] * (token_shift(slab) - slab)
    r, kr, vr, wf_in, wb_in, a_in = split_cols(
        slab, (RW_W, RW_W, RW_W, RW_LORA_W, RW_LORA_W, RW_LORA_A))

    def hd(x):
        return x.reshape(b, t, RW_HEADS, RW_DIM)

    w_f = hd(jnp.exp(-RW_DECAY_SCALE * jax.nn.sigmoid(p['rw_w0_f'] + jnp.tanh(wf_in) @ p['rw_w2_f'])))
    w_b = hd(jnp.exp(-RW_DECAY_SCALE * jax.nn.sigmoid(p['rw_w0_b'] + jnp.tanh(wb_in) @ p['rw_w2_b'])))
    a = hd(jax.nn.sigmoid(p['rw_a0'] + a_in @ p['rw_a2']))
    r, kr, vr = hd(r), hd(kr), hd(vr)
    kk = l2norm(kr * p['rw_k_k'])
    kr = kr * (1.0 + (a - 1.0) * p['rw_k_a'])
    if ctx is None:
        s0f = jnp.zeros((b, RW_HEADS, RW_DIM, RW_DIM), h.dtype)
        s0b = jnp.zeros((b, RW_HEADS, RW_DIM, RW_DIM), h.dtype)
    else:
        s0f, s0b, k_ctx, v_ctx = ctx
    s_f, o_f = rwkv_scan(s0f, r, w_f, kr, vr, kk, a, False)
    s_b, o_b = rwkv_scan(s0b, r, w_b, kr, vr, kk, a, True)
    o_rw = (head_groupnorm(o_f + o_b, p['rw_gn_g'], p['rw_gn_b'])
            + jnp.sum(r * kr * p['rw_r_k'], axis=-1, keepdims=True) * vr)
    o_rw = o_rw.reshape(b, t, RW_W) * jax.nn.silu(rw_gate)

    q = rmsnorm(q.reshape(b, t, AT_HEADS, AT_DIM), p['at_gq'])
    k = rmsnorm(k.reshape(b, t, AT_KV_HEADS, AT_DIM), p['at_gk'])
    v = v.reshape(b, t, AT_KV_HEADS, AT_DIM)
    if ctx is None:
        o_at = block_attention(q, k, v)
        new = (s_f, s_b, k, v)
    else:
        k_all = jnp.concatenate([k_ctx, rope_2d(k)], axis=1)
        v_all = jnp.concatenate([v_ctx, v], axis=1)
        o_at = block_attention(rope_2d(q), k_all, v_all)
        new = None
    o_at = o_at.reshape(b, t, AT_W) * jax.nn.silu(at_gate)
    return jnp.concatenate([o_rw, o_at], axis=-1) @ p['w_out'], new


def mix_odd(h, p, ctx):
    b, t, _ = h.shape
    proj = h @ p['w_in']
    gq, gk, gv, gf_in, gb_in, gla_gate, d_qkv, af_in, ab_in, beta_in, gdn_gate = split_cols(proj, L1_SPLITS)
    q = gq.reshape(b, t, GLA_HEADS, GLA_DK) * GLA_SCALE
    k = gk.reshape(b, t, GLA_HEADS, GLA_DK)
    v = gv.reshape(b, t, GLA_HEADS, GLA_DV)
    logw_f = (jax.nn.log_sigmoid(gf_in @ p['gla_g2_f'] + p['gla_gb_f']) / GLA_GATE_NORM).reshape(b, t, GLA_HEADS, GLA_DK)
    logw_b = (jax.nn.log_sigmoid(gb_in @ p['gla_g2_b'] + p['gla_gb_b']) / GLA_GATE_NORM).reshape(b, t, GLA_HEADS, GLA_DK)

    dq, dk, dv = split_cols(jax.nn.silu(centred_dwconv(d_qkv, p['gdn_conv'])), (GDN_QK_W, GDN_QK_W, GDN_W))
    dq = l2norm(dq.reshape(b, t, GDN_HEADS, GDN_DK)) * GDN_SCALE
    dk = l2norm(dk.reshape(b, t, GDN_HEADS, GDN_DK))
    dv = dv.reshape(b, t, GDN_HEADS, GDN_DV)
    beta = jax.nn.sigmoid(beta_in)
    loga_f = -jnp.exp(p['gdn_A_log_f']) * jax.nn.softplus(af_in + p['gdn_dt_bias_f'])
    loga_b = -jnp.exp(p['gdn_A_log_b']) * jax.nn.softplus(ab_in + p['gdn_dt_bias_b'])

    if ctx is None:
        s_gla_f = jnp.zeros((b, GLA_HEADS, GLA_DK, GLA_DV), h.dtype)
        s_gla_b = jnp.zeros((b, GLA_HEADS, GLA_DK, GLA_DV), h.dtype)
        s_gdn_f = jnp.zeros((b, GDN_HEADS, GDN_DK, GDN_DV), h.dtype)
        s_gdn_b = jnp.zeros((b, GDN_HEADS, GDN_DK, GDN_DV), h.dtype)
    else:
        s_gla_f, s_gla_b, s_gdn_f, s_gdn_b = ctx

    def flip(x):
        return jnp.flip(x, axis=1)

    sgf, o_gf = gla_chunked(q, k, v, logw_f, s_gla_f)
    sgb, o_gb = gla_chunked(flip(q), flip(k), flip(v), flip(logw_b), s_gla_b)
    o_gla = rmsnorm(o_gf + flip(o_gb), p['gla_norm_g']).reshape(b, t, GLA_W) * jax.nn.silu(gla_gate)
    sdf, o_df = gdn_chunked(dq, dk, dv, beta, loga_f, s_gdn_f)
    sdb, o_db = gdn_chunked(flip(dq), flip(dk), flip(dv), flip(beta), flip(loga_b), s_gdn_b)
    o_gdn = rmsnorm(o_df + flip(o_db), p['gdn_norm_g']).reshape(b, t, GDN_W) * jax.nn.silu(gdn_gate)
    out = jnp.concatenate([o_gla, o_gdn], axis=-1) @ p['w_out']
    new = (sgf, sgb, sdf, sdb) if ctx is None else None
    return out, new


def sublayer(x, cvec, p, mix_fn, ctx):
    shift, scale, gate = jnp.split(jax.nn.silu(cvec) @ p['mod_w'] + p['mod_b'], 3, axis=-1)
    h = rmsnorm(x, p['g_pre']) * (1.0 + scale) + shift
    out, new = mix_fn(h, p, ctx)
    return x + gate * rmsnorm(out, p['g_post']), new


def setup_inputs(seed: int = 0) -> dict:
    key = jax.random.key(seed)
    keys = jax.random.split(key, 64)
    counter = [0]

    def nxt():
        kk = keys[counter[0]]
        counter[0] += 1
        return kk

    def nrm(shape, scale=1.0):
        return scale * jax.random.normal(nxt(), shape, dtype=jnp.float32)

    def gain(shape):
        return 1.0 + nrm(shape, 0.01)

    def unif(shape, lo, hi):
        return jax.random.uniform(nxt(), shape, dtype=jnp.float32, minval=lo, maxval=hi)

    d = {}
    d['x_prompt'] = nrm((BATCH, SEQ, D_MODEL))
    d['x_sample'] = nrm((DEC_BATCH, DEC_SEQ, D_MODEL))
    d['state_l0_rwkv_fwd'] = nrm((DEC_BATCH, RW_HEADS, RW_DIM, RW_DIM), 0.1)
    d['state_l0_rwkv_bwd'] = nrm((DEC_BATCH, RW_HEADS, RW_DIM, RW_DIM), 0.1)
    d['cache_l0_k'] = nrm((DEC_BATCH, PAST_LEN, AT_KV_HEADS, AT_DIM))
    d['cache_l0_v'] = nrm((DEC_BATCH, PAST_LEN, AT_KV_HEADS, AT_DIM))
    d['state_l1_gla_fwd'] = nrm((DEC_BATCH, GLA_HEADS, GLA_DK, GLA_DV), 0.1)
    d['state_l1_gla_bwd'] = nrm((DEC_BATCH, GLA_HEADS, GLA_DK, GLA_DV), 0.1)
    d['state_l1_gdn_fwd'] = nrm((DEC_BATCH, GDN_HEADS, GDN_DK, GDN_DV), 0.1)
    d['state_l1_gdn_bwd'] = nrm((DEC_BATCH, GDN_HEADS, GDN_DK, GDN_DV), 0.1)
    d['c'] = nrm((DEC_BATCH, D_MODEL))
    d['c_ctx'] = nrm((D_MODEL,))
    d['l0_mod_w'] = nrm((D_MODEL, 3 * D_MODEL), 0.5 * D_MODEL ** -0.5)
    d['l0_mod_b'] = nrm((3 * D_MODEL,), 0.01)
    d['l0_g_pre'] = gain((D_MODEL,))
    d['l0_g_post'] = gain((D_MODEL,))
    d['l0_w_in'] = nrm((D_MODEL, L0_IN), D_MODEL ** -0.5)
    d['l0_w_out'] = nrm((L0_OUT, D_MODEL), L0_OUT ** -0.5)
    d['l0_rw_mu'] = unif((RW_SLAB,), 0.0, 1.0)
    d['l0_rw_w0_f'] = nrm((RW_W,), 0.5)
    d['l0_rw_w2_f'] = nrm((RW_LORA_W, RW_W), RW_LORA_W ** -0.5)
    d['l0_rw_w0_b'] = nrm((RW_W,), 0.5)
    d['l0_rw_w2_b'] = nrm((RW_LORA_W, RW_W), RW_LORA_W ** -0.5)
    d['l0_rw_a0'] = nrm((RW_W,), 0.5)
    d['l0_rw_a2'] = nrm((RW_LORA_A, RW_W), RW_LORA_A ** -0.5)
    d['l0_rw_k_k'] = 0.85 + nrm((RW_HEADS, RW_DIM), 0.05)
    d['l0_rw_k_a'] = 1.0 + nrm((RW_HEADS, RW_DIM), 0.05)
    d['l0_rw_r_k'] = nrm((RW_HEADS, RW_DIM), 0.1)
    d['l0_rw_gn_g'] = gain((RW_HEADS, RW_DIM))
    d['l0_rw_gn_b'] = nrm((RW_HEADS, RW_DIM), 0.01)
    d['l0_at_gq'] = gain((AT_DIM,))
    d['l0_at_gk'] = gain((AT_DIM,))
    d['l1_mod_w'] = nrm((D_MODEL, 3 * D_MODEL), 0.5 * D_MODEL ** -0.5)
    d['l1_mod_b'] = nrm((3 * D_MODEL,), 0.01)
    d['l1_g_pre'] = gain((D_MODEL,))
    d['l1_g_post'] = gain((D_MODEL,))
    d['l1_w_in'] = nrm((D_MODEL, L1_IN), D_MODEL ** -0.5)
    d['l1_w_out'] = nrm((L1_OUT, D_MODEL), L1_OUT ** -0.5)
    d['l1_gla_g2_f'] = nrm((GLA_LORA, GLA_QK_W), GLA_LORA ** -0.5)
    d['l1_gla_gb_f'] = nrm((GLA_QK_W,), 0.5)
    d['l1_gla_g2_b'] = nrm((GLA_LORA, GLA_QK_W), GLA_LORA ** -0.5)
    d['l1_gla_gb_b'] = nrm((GLA_QK_W,), 0.5)
    d['l1_gla_norm_g'] = gain((GLA_DV,))
    d['l1_gdn_conv'] = nrm((GDN_CONV, 2 * GDN_QK_W + GDN_W), GDN_CONV ** -0.5)
    d['l1_gdn_A_log_f'] = jnp.log(unif((GDN_HEADS,), 1.0, 8.0))
    d['l1_gdn_dt_bias_f'] = unif((GDN_HEADS,), -6.0, -2.5)
    d['l1_gdn_A_log_b'] = jnp.log(unif((GDN_HEADS,), 1.0, 8.0))
    d['l1_gdn_dt_bias_b'] = unif((GDN_HEADS,), -6.0, -2.5)
    d['l1_gdn_norm_g'] = gain((GDN_DV,))
    return d


def reference(x_prompt, x_sample, state_l0_rwkv_fwd, state_l0_rwkv_bwd, cache_l0_k, cache_l0_v,
              state_l1_gla_fwd, state_l1_gla_bwd, state_l1_gdn_fwd, state_l1_gdn_bwd, c, c_ctx,
              l0_mod_w, l0_mod_b, l0_g_pre, l0_g_post, l0_w_in, l0_w_out, l0_rw_mu,
              l0_rw_w0_f, l0_rw_w2_f, l0_rw_w0_b, l0_rw_w2_b, l0_rw_a0, l0_rw_a2,
              l0_rw_k_k, l0_rw_k_a, l0_rw_r_k, l0_rw_gn_g, l0_rw_gn_b, l0_at_gq, l0_at_gk,
              l1_mod_w, l1_mod_b, l1_g_pre, l1_g_post, l1_w_in, l1_w_out,
              l1_gla_g2_f, l1_gla_gb_f, l1_gla_g2_b, l1_gla_gb_b, l1_gla_norm_g,
              l1_gdn_conv, l1_gdn_A_log_f, l1_gdn_dt_bias_f, l1_gdn_A_log_b, l1_gdn_dt_bias_b,
              l1_gdn_norm_g):
    p0 = {'mod_w': l0_mod_w, 'mod_b': l0_mod_b, 'g_pre': l0_g_pre, 'g_post': l0_g_post,
          'w_in': l0_w_in, 'w_out': l0_w_out, 'rw_mu': l0_rw_mu,
          'rw_w0_f': l0_rw_w0_f, 'rw_w2_f': l0_rw_w2_f, 'rw_w0_b': l0_rw_w0_b, 'rw_w2_b': l0_rw_w2_b,
          'rw_a0': l0_rw_a0, 'rw_a2': l0_rw_a2, 'rw_k_k': l0_rw_k_k, 'rw_k_a': l0_rw_k_a,
          'rw_r_k': l0_rw_r_k, 'rw_gn_g': l0_rw_gn_g, 'rw_gn_b': l0_rw_gn_b,
          'at_gq': l0_at_gq, 'at_gk': l0_at_gk}
    p1 = {'mod_w': l1_mod_w, 'mod_b': l1_mod_b, 'g_pre': l1_g_pre, 'g_post': l1_g_post,
          'w_in': l1_w_in, 'w_out': l1_w_out,
          'gla_g2_f': l1_gla_g2_f, 'gla_gb_f': l1_gla_gb_f, 'gla_g2_b': l1_gla_g2_b,
          'gla_gb_b': l1_gla_gb_b, 'gla_norm_g': l1_gla_norm_g, 'gdn_conv': l1_gdn_conv,
          'gdn_A_log_f': l1_gdn_A_log_f, 'gdn_dt_bias_f': l1_gdn_dt_bias_f,
          'gdn_A_log_b': l1_gdn_A_log_b, 'gdn_dt_bias_b': l1_gdn_dt_bias_b,
          'gdn_norm_g': l1_gdn_norm_g}
    params = (p0, p1)
    mixers = (mix_even, mix_odd)
    caches = ((state_l0_rwkv_fwd, state_l0_rwkv_bwd, cache_l0_k, cache_l0_v),
              (state_l1_gla_fwd, state_l1_gla_bwd, state_l1_gdn_fwd, state_l1_gdn_bwd))

    x = x_prompt
    ctx_out = []
    for l in range(DEPTH):
        x, new = sublayer(x, c_ctx, params[l], mixers[l % 2], None)
        ctx_out.append(new)
    y_prompt = x

    x = x_sample
    c_lat = c[:, None, :]
    for l in range(DEPTH):
        x, _ = sublayer(x, c_lat, params[l], mixers[l % 2], caches[l])
    y_sample = x

    new_rw_f, new_rw_b, new_k, new_v = ctx_out[0]
    new_gla_f, new_gla_b, new_gdn_f, new_gdn_b = ctx_out[1]
    return (y_prompt, y_sample, new_rw_f, new_rw_b, new_k, new_v, new_gla_f, new_gla_b, new_gdn_f, new_gdn_b)
```

```cpp
#include <hip/hip_runtime.h>
#include <hip/hip_cooperative_groups.h>
#include <hip/hip_bf16.h>
#include <cstdio>
#include <cstdint>
#include <cmath>
namespace cg = cooperative_groups;

namespace pg8 {
#define PG8_LAS __attribute__((address_space(3)))
typedef unsigned short bf16_t;
typedef short bf16x8 __attribute__((ext_vector_type(8)));
typedef float f32x4 __attribute__((ext_vector_type(4)));
typedef unsigned u32x4 __attribute__((ext_vector_type(4)));
constexpr int BM = 256, BK = 64, HALF = 128, HTB = HALF * BK * 2  , STAGE_BYTES = 8 * HTB, NXCD = 8, WGM = 8;

__host__ __device__ __forceinline__ int lds_byte(int r, int c) { const int st = (r >> 4) * 2 + (c >> 5), rr = r & 15, cc = c & 31, ob = rr * 64 + cc * 2; return st * 1024 + (ob ^ (((ob >> 9) & 1) << 5)); }
__host__ __device__ __forceinline__ void stage_rc(int b, int& R, int& C) { const int st = b / 1024, sb = b % 1024, swz = sb ^ (((sb >> 9) & 1) << 5); R = (st >> 1) * 16 + swz / 64; C = (st & 1) * 32 + (swz % 64) / 2; }
__host__ __device__ __forceinline__ int perm32(int rho) { const int n = rho >> 4, i = rho & 15; return 8 * (i >> 2) + 4 * n + (i & 3); }

struct Unit { int pm, pn; };
struct Gemm { const bf16_t* A; const bf16_t* Bt; int M, N, K, lda; };

struct StaticOrder {
    int nM, nN, nwg, G, c;
    __host__ __device__ void init(int M, int N, int G_, int c_) { nM = M / BM; nN = N / BM; nwg = nM * nN; G = G_; c = c_; }
    __host__ __device__ bool next(int i, Unit& u) const {
        const long L = (long)i * G + c; if (L >= nwg) return false;
        int wgid = (int)L; { const int q = nwg / NXCD, r = nwg % NXCD, xcd = wgid % NXCD, off = wgid / NXCD; wgid = (xcd < r ? xcd * (q + 1) : r * (q + 1) + (xcd - r) * q) + off; }
        const int nig = WGM * nN, gid = wgid / nig, fm = gid * WGM, gsz = (nM - fm) < WGM ? (nM - fm) : WGM;
        u.pm = fm + ((wgid % nig) % gsz); u.pn = (wgid % nig) / gsz; return true;
    }
    __device__ __forceinline__ void a_ready(const Unit&) const {}
    __device__ __forceinline__ void done(const Unit&) const {}
};

__device__ __forceinline__ unsigned cvt_pk_bf16(float lo, float hi) { unsigned r; asm volatile("v_cvt_pk_bf16_f32 %0, %1, %2" : "=v"(r) : "v"(lo), "v"(hi)); return r; }
template <class Epi, class Sched, bool ALIGN_EPI = false, bool SP2 = false>
__device__ __forceinline__ void gemm_phase(PG8_LAS unsigned char* lds, const Gemm g, const Sched& S, const Epi& E) {
    const int tid = threadIdx.x, wid = __builtin_amdgcn_readfirstlane(tid >> 6), lane = tid & 63, wr = wid >> 2, wc = wid & 3, fr = lane & 15, fq = lane >> 4;
    const int K = g.K, nt = K / BK;
    unsigned voffA[2], voffB[2];
#pragma unroll
    for (int i = 0; i < 2; ++i) { int R, C; stage_rc(tid * 16 + i * 8192, R, C); const int Rb = Epi::PERM ? ((R & ~31) + perm32(R & 31)) : R;
        voffA[i] = (unsigned)(R * g.lda + C) * 2u; voffB[i] = (unsigned)(Rb * K + C) * 2u; }
    const size_t kstep = (size_t)(BK * 2);
    const size_t hstepB = (size_t)HALF * K * 2, hstepA = (size_t)HALF * g.lda * 2;
    const size_t tstepA = 2 * hstepA, tstepB = 2 * hstepB;
    const unsigned ldsw = (unsigned)wid * 1024u;
    const int aoff = lds_byte(wr * 64 + fr, fq * 8), boff = lds_byte(wc * 32 + fr, fq * 8);
#define PG8_SA(b, h) (((b) * 2 + (h)) * HTB)
#define PG8_SB(b, h) ((4 + (b) * 2 + (h)) * HTB)
#define PG8_STAGE(bufoff, gbase, voff) do { _Pragma("unroll") for (int _i = 0; _i < 2; ++_i) \
        __builtin_amdgcn_global_load_lds((const unsigned*)((const char*)(gbase) + (voff)[_i]), (PG8_LAS unsigned*)(lds + (bufoff) + ldsw + _i * 8192), 16, 0, 0); } while (0)
#define PG8_LDA(dst, b, h) do { _Pragma("unroll") for (int m = 0; m < 4; ++m) _Pragma("unroll") for (int k = 0; k < 2; ++k) dst[m][k] = *(const PG8_LAS bf16x8*)(lds + PG8_SA(b, h) + aoff + m * 2048 + k * 1024); } while (0)
#define PG8_LDB(dst, b, h) do { _Pragma("unroll") for (int n = 0; n < 2; ++n) _Pragma("unroll") for (int k = 0; k < 2; ++k) dst[n][k] = *(const PG8_LAS bf16x8*)(lds + PG8_SB(b, h) + boff + n * 2048 + k * 1024); } while (0)
#define PG8_MMA(ai, bj, At, Bt) do { __builtin_amdgcn_s_setprio(1); _Pragma("unroll") for (int m = 0; m < 4; ++m) _Pragma("unroll") for (int n = 0; n < 2; ++n) _Pragma("unroll") for (int k = 0; k < 2; ++k) \
        acc[ai][bj][m][n] = __builtin_amdgcn_mfma_f32_16x16x32_bf16(Bt[n][k], At[m][k], acc[ai][bj][m][n], 0, 0, 0); __builtin_amdgcn_s_setprio(0); } while (0)
#define PG8_WAIT_V(n) asm volatile("s_waitcnt vmcnt(" #n ")" ::: "memory")
#define PG8_WAIT_L(n) asm volatile("s_waitcnt lgkmcnt(" #n ")" ::: "memory")
#define PG8_BAR __builtin_amdgcn_s_barrier()
#define PG8_SCHED __builtin_amdgcn_sched_barrier(0)
    Unit cur, nxt; int ui = 0;
    if (!S.next(0, cur)) return;
    f32x4 acc[2][2][4][2];
#pragma unroll
    for (int a = 0; a < 2; ++a)
#pragma unroll
        for (int b = 0; b < 2; ++b)
#pragma unroll
            for (int m = 0; m < 4; ++m)
#pragma unroll
                for (int n = 0; n < 2; ++n) acc[a][b][m][n] = (f32x4){0.f, 0.f, 0.f, 0.f};
    bf16x8 At[4][2], B0[2][2], B1[2][2];
    const char* cA = (const char*)g.A + (size_t)cur.pm * tstepA; const char* cB = (const char*)g.Bt + (size_t)cur.pn * tstepB;
    S.a_ready(cur);
    if constexpr (SP2) {
        PG8_STAGE(PG8_SB(0, 0), cB, voffB); PG8_STAGE(PG8_SB(0, 1), cB + hstepB, voffB); PG8_STAGE(PG8_SA(0, 0), cA, voffA); PG8_STAGE(PG8_SA(0, 1), cA + hstepA, voffA);
        if (wr == 1) PG8_BAR;
        PG8_WAIT_V(2); PG8_BAR;
        PG8_STAGE(PG8_SB(1, 0), cB + kstep, voffB); PG8_STAGE(PG8_SA(1, 0), cA + kstep, voffA); PG8_STAGE(PG8_SB(1, 1), cB + hstepB + kstep, voffB);
        PG8_WAIT_V(6); PG8_BAR;
    } else {
        PG8_STAGE(PG8_SB(0, 0), cB, voffB); PG8_STAGE(PG8_SA(0, 0), cA, voffA); PG8_STAGE(PG8_SB(0, 1), cB + hstepB, voffB); PG8_STAGE(PG8_SA(0, 1), cA + hstepA, voffA);
        if (wr == 1) PG8_BAR;
        PG8_WAIT_V(4); PG8_BAR;
        PG8_STAGE(PG8_SB(1, 0), cB + kstep, voffB); PG8_STAGE(PG8_SA(1, 0), cA + kstep, voffA); PG8_STAGE(PG8_SB(1, 1), cB + hstepB + kstep, voffB);
        PG8_WAIT_V(6); PG8_BAR;
    }
    for (;;) {
        const bool has_next = S.next(ui + 1, nxt);
        const char* nA = has_next ? (const char*)g.A + (size_t)nxt.pm * tstepA : cA; const char* nB = has_next ? (const char*)g.Bt + (size_t)nxt.pn * tstepB : cB;
        for (int t = 0; t < nt; t += 2) {
            const bool last = (t == nt - 2);
            const char* a1 = cA + (size_t)(t + 1) * kstep;
            const char* a2 = last ? nA : cA + (size_t)(t + 2) * kstep; const char* b2 = last ? nB : cB + (size_t)(t + 2) * kstep;
            const char* a3 = a2 + kstep; const char* b3 = b2 + kstep;
            if (last && has_next) S.a_ready(nxt);
            if constexpr (SP2) {
            PG8_LDB(B0, 0, 0); PG8_LDB(B1, 0, 1); PG8_SCHED; PG8_LDA(At, 0, 0); PG8_STAGE(PG8_SA(1, 1), a1 + hstepA, voffA);
            PG8_WAIT_V(8); PG8_WAIT_L(0); PG8_BAR; PG8_MMA(0, 0, At, B0); PG8_MMA(0, 1, At, B1); PG8_BAR; PG8_SCHED;
            PG8_LDA(At, 0, 1); PG8_STAGE(PG8_SB(0, 0), b2, voffB); PG8_STAGE(PG8_SB(0, 1), b2 + hstepB, voffB); PG8_STAGE(PG8_SA(0, 0), a2, voffA);
            PG8_WAIT_V(8); PG8_WAIT_L(0); PG8_BAR; PG8_MMA(1, 0, At, B0); PG8_MMA(1, 1, At, B1); PG8_BAR; PG8_SCHED;
            PG8_LDB(B0, 1, 0); PG8_LDB(B1, 1, 1); PG8_SCHED; PG8_LDA(At, 1, 0); PG8_STAGE(PG8_SA(0, 1), a2 + hstepA, voffA);
            PG8_WAIT_V(8); PG8_WAIT_L(0); PG8_BAR; PG8_MMA(0, 0, At, B0); PG8_MMA(0, 1, At, B1); PG8_BAR; PG8_SCHED;
            PG8_LDA(At, 1, 1); PG8_STAGE(PG8_SB(1, 0), b3, voffB); PG8_STAGE(PG8_SB(1, 1), b3 + hstepB, voffB); PG8_STAGE(PG8_SA(1, 0), a3, voffA);
            PG8_WAIT_V(8); PG8_WAIT_L(0); PG8_BAR; PG8_MMA(1, 0, At, B0); PG8_MMA(1, 1, At, B1); PG8_BAR; PG8_SCHED;
            } else {
            PG8_LDB(B0, 0, 0); PG8_SCHED; PG8_LDA(At, 0, 0); PG8_STAGE(PG8_SA(1, 1), a1 + hstepA, voffA);
            PG8_WAIT_L(8); PG8_BAR; PG8_WAIT_L(0); PG8_MMA(0, 0, At, B0); PG8_BAR; PG8_SCHED;
            PG8_LDB(B1, 0, 1); PG8_STAGE(PG8_SB(0, 0), b2, voffB);
            PG8_BAR; PG8_WAIT_L(0); PG8_MMA(0, 1, At, B1); PG8_BAR;
            PG8_LDA(At, 0, 1); PG8_STAGE(PG8_SA(0, 0), a2, voffA);
            PG8_BAR; PG8_WAIT_L(0); PG8_MMA(1, 0, At, B0); PG8_BAR; PG8_SCHED;
            PG8_STAGE(PG8_SB(0, 1), b2 + hstepB, voffB);
            PG8_WAIT_V(6); PG8_BAR; PG8_MMA(1, 1, At, B1); PG8_BAR;
            PG8_LDB(B0, 1, 0); PG8_SCHED; PG8_LDA(At, 1, 0); PG8_STAGE(PG8_SA(0, 1), a2 + hstepA, voffA);
            PG8_WAIT_L(8); PG8_BAR; PG8_WAIT_L(0); PG8_MMA(0, 0, At, B0); PG8_BAR; PG8_SCHED;
            PG8_LDB(B1, 1, 1); PG8_STAGE(PG8_SB(1, 0), b3, voffB);
            PG8_BAR; PG8_WAIT_L(0); PG8_MMA(0, 1, At, B1); PG8_BAR;
            PG8_LDA(At, 1, 1); PG8_STAGE(PG8_SA(1, 0), a3, voffA);
            PG8_BAR; PG8_WAIT_L(0); PG8_MMA(1, 0, At, B0); PG8_BAR; PG8_SCHED;
            PG8_STAGE(PG8_SB(1, 1), b3 + hstepB, voffB);
            PG8_WAIT_V(6); PG8_BAR; PG8_MMA(1, 1, At, B1); PG8_BAR;
            }
        }
        if constexpr (ALIGN_EPI) { if (wr == 0) PG8_BAR; }
        if constexpr (!Epi::AFTER_DRAIN) { E(acc, cur, wr, wc, fr, fq); S.done(cur); }
        if (!has_next) break;
#pragma unroll
        for (int a = 0; a < 2; ++a)
#pragma unroll
            for (int b = 0; b < 2; ++b)
#pragma unroll
                for (int m = 0; m < 4; ++m)
#pragma unroll
                    for (int n = 0; n < 2; ++n) acc[a][b][m][n] = (f32x4){0.f, 0.f, 0.f, 0.f};
        cur = nxt; cA = nA; cB = nB; ++ui;
        if constexpr (ALIGN_EPI) { if (wr == 1) PG8_BAR; }
    }
    PG8_WAIT_V(0);
    if constexpr (!ALIGN_EPI) { if (wr == 0) PG8_BAR; }
    PG8_BAR;
    if constexpr (Epi::AFTER_DRAIN) { E.fused(acc, cur, wr, wc, fr, fq, lds, wid, lane); S.done(cur); }
#undef PG8_SA
#undef PG8_SB
#undef PG8_STAGE
#undef PG8_LDA
#undef PG8_LDB
#undef PG8_MMA
#undef PG8_WAIT_V
#undef PG8_WAIT_L
#undef PG8_BAR
#undef PG8_SCHED
}
}

#include <hip/hip_bf16.h>
#include <cmath>
namespace attn_body {
using bf16=__hip_bfloat16;
using bf16x8=__attribute__((ext_vector_type(8)))short;
using s16x4=__attribute__((ext_vector_type(4)))short;
using f32x16=__attribute__((ext_vector_type(16)))float;
using u32x4=__attribute__((ext_vector_type(4)))unsigned;
constexpr int D=64,QP=512,KP=128;
constexpr int NW=8,QBLK=32,QB=QBLK*NW,KVBLK=64;
__device__ __forceinline__ int crow(int r,int hi){return (r&3)+8*(r>>2)+4*hi;}
#define SBAR() __builtin_amdgcn_sched_barrier(0)
constexpr int NSLOT=3, SLOTB=8192;
constexpr int LDS_K=0, LDS_V=NSLOT*SLOTB, LDS_WS=2*NSLOT*SLOTB, LDS_OST=LDS_WS+NW*64*4, LDS_BYTES=LDS_OST+NW*4096;
constexpr float C2=0.125f*1.4426950408889634f;
__device__ __forceinline__ void glds16(const void*gsrc,unsigned lds_dst){unsigned keep;
  asm volatile("s_mov_b32 %0, m0\n\ts_mov_b32 m0, %2\n\ts_nop 0\n\tglobal_load_lds_dwordx4 %1, off\n\ts_mov_b32 m0, %0":"=&s"(keep):"v"(gsrc),"s"(lds_dst):"memory");}
__device__ __forceinline__ float max3f(float a,float b,float c){float r;asm("v_max3_f32 %0, %1, %2, %3":"=v"(r):"v"(a),"v"(b),"v"(c));return r;}
__device__ __forceinline__ float max2f(float a,float b){float r;asm("v_max_f32_e32 %0, %1, %2":"=v"(r):"v"(a),"v"(b));return r;}
__device__ __forceinline__ float fadd_s(float a,float b){float r;asm("v_add_f32_e32 %0, %1, %2":"=v"(r):"v"(a),"v"(b));return r;}
__device__ __forceinline__ float fsub_s(float a,float b){float r;asm("v_sub_f32_e32 %0, %1, %2":"=v"(r):"v"(a),"v"(b));return r;}
typedef float f32x2_t __attribute__((ext_vector_type(2))); typedef __bf16 bf16x2_t __attribute__((ext_vector_type(2)));
__device__ __forceinline__ unsigned cvtpk_s(float lo,float hi){f32x2_t v={lo,hi};bf16x2_t b=__builtin_convertvector(v,bf16x2_t);return __builtin_bit_cast(unsigned,b);}
#define WAIT_BAR(N) asm volatile("s_waitcnt vmcnt(" #N ") lgkmcnt(0)\n\ts_barrier":::"memory")

__device__ __forceinline__ void qkt(f32x16&p0,f32x16&p1,const char*Kslot,const bf16x8*qr,const f32x16&negm,int r32,int hi){
  const char*kb=Kslot+hi*1024+r32*16;
  #pragma unroll
  for(int d0=0;d0<4;++d0){
    const bf16x8 b0=*reinterpret_cast<const bf16x8*>(kb+d0*2048);
    const bf16x8 b1=*reinterpret_cast<const bf16x8*>(kb+d0*2048+512);
    if(d0==0){p0=__builtin_amdgcn_mfma_f32_32x32x16_bf16(b0,qr[0],negm,0,0,0);p1=__builtin_amdgcn_mfma_f32_32x32x16_bf16(b1,qr[0],negm,0,0,0);}
    else{p0=__builtin_amdgcn_mfma_f32_32x32x16_bf16(b0,qr[d0],p0,0,0,0);p1=__builtin_amdgcn_mfma_f32_32x32x16_bf16(b1,qr[d0],p1,0,0,0);}}
}
typedef __attribute__((address_space(3))) const char* lds_cptr;
typedef short v4i16_t __attribute__((ext_vector_type(4)));
__device__ __forceinline__ void kload8(bf16x8*kf,lds_cptr kp){
  kf[0]=*(const __attribute__((address_space(3))) bf16x8*)(kp);      kf[1]=*(const __attribute__((address_space(3))) bf16x8*)(kp+512);
  kf[2]=*(const __attribute__((address_space(3))) bf16x8*)(kp+2048); kf[3]=*(const __attribute__((address_space(3))) bf16x8*)(kp+2560);
  kf[4]=*(const __attribute__((address_space(3))) bf16x8*)(kp+4096); kf[5]=*(const __attribute__((address_space(3))) bf16x8*)(kp+4608);
  kf[6]=*(const __attribute__((address_space(3))) bf16x8*)(kp+6144); kf[7]=*(const __attribute__((address_space(3))) bf16x8*)(kp+6656);
}
__device__ __forceinline__ void kload2(bf16x8*kf,lds_cptr kp,int j){ kf[2*j]=*(const __attribute__((address_space(3))) bf16x8*)(kp+j*2048); kf[2*j+1]=*(const __attribute__((address_space(3))) bf16x8*)(kp+j*2048+512); }
__device__ __forceinline__ s16x4 vtr(lds_cptr p){ return __builtin_bit_cast(s16x4,__builtin_amdgcn_ds_read_tr16_b64_v4i16((__attribute__((address_space(3))) v4i16_t*)p)); }
__device__ __forceinline__ float rowmax(const f32x16&p0,const f32x16&p1){
  float a=max3f(p0[0],p0[1],p1[0]),b=max3f(p0[2],p0[3],p1[1]);a=max3f(a,p1[2],p1[3]);
  #pragma unroll
  for(int r=4;r<16;r+=4){a=max3f(a,p0[r],p0[r+1]);b=max3f(b,p0[r+2],p0[r+3]);a=max3f(a,p1[r],p1[r+1]);b=max3f(b,p1[r+2],p1[r+3]);}
  const float m=max2f(a,b);
  auto rr=__builtin_amdgcn_permlane32_swap(__float_as_uint(m),__float_as_uint(m),false,false);
  return max2f(__uint_as_float(rr[0]),__uint_as_float(rr[1]));
}
__device__ __forceinline__ void pv(f32x16*o,int vb,bf16x8 pa0,bf16x8 pa1,bf16x8 pa2,bf16x8 pa3){
  #pragma unroll
  for(int d0=0;d0<2;++d0){s16x4 lo[4],hi[4];
    #pragma unroll
    for(int ks=0;ks<4;++ks){
      asm volatile("ds_read_b64_tr_b16 %0,%1 offset:%c2":"=&v"(lo[ks]):"v"(vb),"i"(d0*4096+ks*1024):"memory");
      asm volatile("ds_read_b64_tr_b16 %0,%1 offset:%c2":"=&v"(hi[ks]):"v"(vb),"i"(d0*4096+ks*1024+512):"memory");}
    asm volatile("s_waitcnt lgkmcnt(0)":::"memory");SBAR();
    #define PK(k) (bf16x8){lo[k][0],lo[k][1],lo[k][2],lo[k][3],hi[k][0],hi[k][1],hi[k][2],hi[k][3]}
    o[d0]=__builtin_amdgcn_mfma_f32_32x32x16_bf16(pa0,PK(0),o[d0],0,0,0);
    o[d0]=__builtin_amdgcn_mfma_f32_32x32x16_bf16(pa1,PK(1),o[d0],0,0,0);
    o[d0]=__builtin_amdgcn_mfma_f32_32x32x16_bf16(pa2,PK(2),o[d0],0,0,0);
    o[d0]=__builtin_amdgcn_mfma_f32_32x32x16_bf16(pa3,PK(3),o[d0],0,0,0);
    #undef PK
  }
}

#ifndef ATTN_STORE16
#define ATTN_STORE16(p,v) (*(u32x4*)(p)=(v))
#endif
template<int THRL> __device__ __forceinline__ void attn_unit(long qrow0,long kvrow0,int h,int qb,int Tk,const bf16*Q,const bf16*__restrict__ K,const bf16*__restrict__ V,bf16*O,char*shm){
  const int tid=threadIdx.x,lane=tid&63,r32=lane&31,hi=lane>>5; const int wid=__builtin_amdgcn_readfirstlane(tid>>6);
  const int q0=qb*QB;
  const bf16*Qw=Q+(qrow0+q0+wid*QBLK)*QP+h*D;
  const bf16*Kh=K+kvrow0*KP+(h>>2)*D,*Vh=V+kvrow0*KP+(h>>2)*D;
  const unsigned lds0=(unsigned)(uintptr_t)shm;
  float*wsf=(float*)(shm+LDS_WS)+wid*64;
  const bf16*ksrc=Kh+(long)lane*KP+wid*8;
  const bf16*vsrc=Vh+(long)(16*(wid&3)+(lane>>2))*KP+(wid>>2)*32+(lane&3)*8;
  const unsigned kdst=lds0+LDS_K+wid*1024, vdst=lds0+LDS_V+wid*1024;
  #define DMA_K(t,slot) glds16(ksrc+(long)(t)*KVBLK*KP,(unsigned)__builtin_amdgcn_readfirstlane(kdst+(slot)))
  #define DMA_V(t,slot) glds16(vsrc+(long)(t)*KVBLK*KP,(unsigned)__builtin_amdgcn_readfirstlane(vdst+(slot)))
  const int vb0=(int)(lds0+LDS_V)+((lane>>4)&1)*32+(lane&3)*8+(4*hi+((lane&15)>>2))*64;
  const char*Kbase=shm+LDS_K; bf16x8 kf[8];
  const lds_cptr shm3=(lds_cptr)shm; const lds_cptr kp0=shm3+LDS_K+hi*1024+r32*16; const lds_cptr vp0=shm3+LDS_V+((lane>>4)&1)*32+(lane&3)*8+(4*hi+((lane&15)>>2))*64;
  const int NT=Tk/KVBLK;
  DMA_K(0,0);DMA_V(0,0);DMA_K(1,SLOTB);
  bf16x8 qr[4];
  #pragma unroll
  for(int d0=0;d0<4;++d0)qr[d0]=*reinterpret_cast<const bf16x8*>(&Qw[(long)r32*QP+d0*16+hi*8]);
  float mhat=0.f,l_reg=0.f;f32x16 o[2];o[0]=f32x16{};o[1]=f32x16{};f32x16 negm=f32x16{};asm volatile("":"+v"(negm));
  #define CMASK(P0,P1,t) do{}while(0)
  bool resc=false;
  #define START(P0,P1) do{ const float rm=rowmax(P0,P1); resc=false; \
    { const float dl=rm; mhat=fadd_s(mhat,dl); \
      _Pragma("unroll") for(int r=0;r<16;++r){P0[r]=fsub_s(P0[r],dl);P1[r]=fsub_s(P1[r],dl);} \
      _Pragma("unroll") for(int r=0;r<16;++r)negm[r]=-mhat; asm volatile("":"+v"(negm)); } \
    _Pragma("unroll") for(int r=0;r<16;++r)P0[r]=__builtin_amdgcn_exp2f(P0[r]); }while(0)
  #define RESC() do{ if(resc){ asm volatile("s_waitcnt lgkmcnt(0)":::"memory"); \
      _Pragma("unroll") for(int d_=0;d_<2;++d_) _Pragma("unroll") for(int r=0;r<16;++r)o[d_][r]*=wsf[crow(r,hi)]; } }while(0)
  f32x16 pA0,pA1,pB0,pB1;
  int sl_prev=0,sl_cur=0,sl_next=SLOTB;
  #define ROT() do{sl_prev=sl_cur;sl_cur=sl_next;sl_next=(sl_next==(NSLOT-1)*SLOTB)?0:sl_next+SLOTB;}while(0)
  DMA_K(2,2*SLOTB);
  WAIT_BAR(3);
  qkt(pA0,pA1,Kbase,qr,negm,r32,hi);asm volatile("s_nop 15\n\ts_nop 7":"+v"(pA0),"+v"(pA1));CMASK(pA0,pA1,0);
  START(pA0,pA1);
  _Pragma("unroll") for(int r=0;r<16;++r)pA1[r]=__builtin_amdgcn_exp2f(pA1[r]);
  WAIT_BAR(0);
  DMA_K(3,0);DMA_V(1,SLOTB);
  ROT();
  kload8(kf,kp0+sl_cur);
  WAIT_BAR(2);
  s16x4 vlo[8],vhi[8]; u32x4 pw0,pw1,pw2,pw3;
  #define PKW(P,B) cvtpk_s(P[B],P[B+1])
  #define PAF(k) __builtin_bit_cast(bf16x8,pw##k)
  #define VFR(i) (bf16x8){vlo[i][0],vlo[i][1],vlo[i][2],vlo[i][3],vhi[i][0],vhi[i][1],vhi[i][2],vhi[i][3]}
  #define PIN(x) asm volatile("":"+v"(x))
  #define MX3(a,b,c) __builtin_fmaxf(__builtin_fmaxf((a),(b)),(c))
  #define GAPA(MF,A0,A1,A2,A3,W0,W1,PW) do{ MF; sacc+=A0; sacc+=A1; sacc+=A2; sacc+=A3; PIN(sacc); W0; W1; PIN(PW); SBAR(); }while(0)
  #define EX(v) __builtin_amdgcn_exp2f(v)
  #define GAPB(MF,X,B) do{ MF; X[B]=EX(X[B]); X[B+1]=EX(X[B+1]); X[B+2]=EX(X[B+2]); X[B+3]=EX(X[B+3]); PIN(X); SBAR(); }while(0)
  #define VRD(i) do{ vlo[i]=vtr(vp_+(((i)>>2)*4096+((i)&3)*1024)); vhi[i]=vtr(vp_+(((i)>>2)*4096+((i)&3)*1024+512)); }while(0)
  #define KRD(G,j) do{ if(G){ kload2(kf,kp0+sl_next,j); SBAR(); } }while(0)
  #define STEP(C0,C1,P0,P1,t,GK,GV,GL) do{ SBAR(); \
    const lds_cptr vp_=vp0+sl_prev; \
    VRD(0); SBAR(); float sacc=(P0[0]+P0[1]); \
    GAPA(C0=__builtin_amdgcn_mfma_f32_32x32x16_bf16(kf[0],qr[0],negm,0,0,0), P0[2],P0[3],P0[4],P0[5],     pw0[0]=PKW(P0,0), pw0[1]=PKW(P0,2), pw0); \
    VRD(4); SBAR(); GAPA(C1=__builtin_amdgcn_mfma_f32_32x32x16_bf16(kf[1],qr[0],negm,0,0,0), P0[6],P0[7],P0[8],P0[9],     pw0[2]=PKW(P0,4), pw0[3]=PKW(P0,6), pw0); \
    VRD(1); SBAR(); GAPA(C0=__builtin_amdgcn_mfma_f32_32x32x16_bf16(kf[2],qr[1],C0,0,0,0),   P0[10],P0[11],P0[12],P0[13], pw1[0]=PKW(P0,8), pw1[1]=PKW(P0,10), pw1); \
    VRD(5); SBAR(); GAPA(C1=__builtin_amdgcn_mfma_f32_32x32x16_bf16(kf[3],qr[1],C1,0,0,0),   P0[14],P0[15],P1[0],P1[1],   pw1[2]=PKW(P0,12),pw1[3]=PKW(P0,14), pw1); \
    VRD(2); SBAR(); GAPA(C0=__builtin_amdgcn_mfma_f32_32x32x16_bf16(kf[4],qr[2],C0,0,0,0),   P1[2],P1[3],P1[4],P1[5],     pw2[0]=PKW(P1,0), pw2[1]=PKW(P1,2), pw2); \
    VRD(6); SBAR(); GAPA(C1=__builtin_amdgcn_mfma_f32_32x32x16_bf16(kf[5],qr[2],C1,0,0,0),   P1[6],P1[7],P1[8],P1[9],     pw2[2]=PKW(P1,4), pw2[3]=PKW(P1,6), pw2); \
    VRD(3); SBAR(); GAPA(C0=__builtin_amdgcn_mfma_f32_32x32x16_bf16(kf[6],qr[3],C0,0,0,0),   P1[10],P1[11],P1[12],P1[13], pw3[0]=PKW(P1,8), pw3[1]=PKW(P1,10), pw3); \
    VRD(7); SBAR(); GAPA(C1=__builtin_amdgcn_mfma_f32_32x32x16_bf16(kf[7],qr[3],C1,0,0,0),   P1[14],P1[15],0.f,0.f,       pw3[2]=PKW(P1,12),pw3[3]=PKW(P1,14), pw3); \
    l_reg+=sacc; \
    if(GK){DMA_K((t)+3,sl_cur);} if(GV){DMA_V((t)+1,sl_next);} \
    CMASK(C0,C1,t); \
    { float a=MX3(C0[0],C0[1],C1[0]),b=MX3(C0[2],C0[3],C1[1]); a=MX3(a,C1[2],C1[3]); \
      _Pragma("unroll") for(int r=4;r<16;r+=4){a=MX3(a,C0[r],C0[r+1]);b=MX3(b,C0[r+2],C0[r+3]);a=MX3(a,C1[r],C1[r+1]);b=MX3(b,C1[r+2],C1[r+3]);} \
      float rm=__builtin_fmaxf(a,b); { auto rr=__builtin_amdgcn_permlane32_swap(__float_as_uint(rm),__float_as_uint(rm),false,false); rm=__builtin_fmaxf(__uint_as_float(rr[0]),__uint_as_float(rr[1])); } \
      resc=false; \
      if(__builtin_expect(__any(rm>(float)THRL),0)){ const float dl=__builtin_fmaxf(rm,0.f); mhat+=dl; \
        _Pragma("unroll") for(int r=0;r<16;++r){C0[r]-=dl;C1[r]-=dl;} \
        _Pragma("unroll") for(int r=0;r<16;++r)negm[r]=-mhat; asm volatile("":"+v"(negm)); \
        const float f=__builtin_amdgcn_exp2f(-dl); l_reg*=f; if(hi==0)wsf[r32]=f; resc=true; } } \
    SBAR(); \
    GAPB(o[0]=__builtin_amdgcn_mfma_f32_32x32x16_bf16(PAF(0),VFR(0),o[0],0,0,0), C0,0); \
    GAPB(o[1]=__builtin_amdgcn_mfma_f32_32x32x16_bf16(PAF(0),VFR(4),o[1],0,0,0), C0,4); \
    KRD(GL,0); GAPB(o[0]=__builtin_amdgcn_mfma_f32_32x32x16_bf16(PAF(1),VFR(1),o[0],0,0,0), C0,8); \
    KRD(GL,1); GAPB(o[1]=__builtin_amdgcn_mfma_f32_32x32x16_bf16(PAF(1),VFR(5),o[1],0,0,0), C0,12); \
    KRD(GL,2); GAPB(o[0]=__builtin_amdgcn_mfma_f32_32x32x16_bf16(PAF(2),VFR(2),o[0],0,0,0), C1,0); \
    KRD(GL,3); GAPB(o[1]=__builtin_amdgcn_mfma_f32_32x32x16_bf16(PAF(2),VFR(6),o[1],0,0,0), C1,4); \
    GAPB(o[0]=__builtin_amdgcn_mfma_f32_32x32x16_bf16(PAF(3),VFR(3),o[0],0,0,0), C1,8); \
    GAPB(o[1]=__builtin_amdgcn_mfma_f32_32x32x16_bf16(PAF(3),VFR(7),o[1],0,0,0), C1,12); \
    }while(0)
  int t=1;
  for(;t+5<NT;t+=2){
    STEP(pB0,pB1,pA0,pA1,t,true,true,true);     WAIT_BAR(2); RESC(); ROT();
    STEP(pA0,pA1,pB0,pB1,t+1,true,true,true);   WAIT_BAR(2); RESC(); ROT();
  }
  #define ENDW(tt) do{ if((tt)+3<NT){WAIT_BAR(2);} else if((tt)+2<NT){WAIT_BAR(1);} else {WAIT_BAR(0);} }while(0)
  for(;t+1<NT;t+=2){
    STEP(pB0,pB1,pA0,pA1,t,(t+3<NT),(t+1<NT),(t+1<NT));       ENDW(t);   RESC(); ROT();
    STEP(pA0,pA1,pB0,pB1,t+1,(t+4<NT),(t+2<NT),(t+2<NT));     ENDW(t+1); RESC(); ROT();
  }
  STEP(pB0,pB1,pA0,pA1,NT-1,false,false,false); RESC();
  { float sacc=pB0[0]+pB0[1]; _Pragma("unroll") for(int r=2;r<16;++r)sacc+=pB0[r]; _Pragma("unroll") for(int r=0;r<16;++r)sacc+=pB1[r]; l_reg+=sacc;
    pw0=(u32x4){PKW(pB0,0),PKW(pB0,2),PKW(pB0,4),PKW(pB0,6)};pw1=(u32x4){PKW(pB0,8),PKW(pB0,10),PKW(pB0,12),PKW(pB0,14)};pw2=(u32x4){PKW(pB1,0),PKW(pB1,2),PKW(pB1,4),PKW(pB1,6)};pw3=(u32x4){PKW(pB1,8),PKW(pB1,10),PKW(pB1,12),PKW(pB1,14)};
    SBAR(); pv(o,vb0+sl_cur,PAF(0),PAF(1),PAF(2),PAF(3)); }
  #undef PKW
  #undef PAF
  #undef VFR
  #undef PIN
  #undef MX3
  #undef GAPA
  #undef GAPB
  #undef EX
  #undef VRD
  #undef KRD
  #undef STEP
  #undef ENDW
  {auto rr=__builtin_amdgcn_permlane32_swap(__float_as_uint(l_reg),__float_as_uint(l_reg),false,false);l_reg=__uint_as_float(rr[0])+__uint_as_float(rr[1]);}
  if(hi==0)wsf[32+r32]=l_reg;asm volatile("s_waitcnt lgkmcnt(0)":::"memory");
  float rli[16];
  #pragma unroll
  for(int r=0;r<16;++r)rli[r]=__builtin_amdgcn_rcpf(wsf[32+crow(r,hi)]);
  bf16*Ow=O+(qrow0+q0+wid*QBLK)*QP+h*D;
  { bf16*stg=(bf16*)(shm+LDS_OST)+wid*2048;
    #pragma unroll
    for(int r=0;r<16;++r){const int orow=crow(r,hi);
      #pragma unroll
      for(int d0=0;d0<2;++d0)stg[orow*64+d0*32+r32]=__float2bfloat16(o[d0][r]*rli[r]);}
    asm volatile("s_waitcnt lgkmcnt(0)":::"memory");
    #pragma unroll
    for(int i=0;i<4;++i){const int row=i*8+(lane>>3),ch=lane&7; const u32x4 v=*(const u32x4*)(stg+row*64+ch*8); ATTN_STORE16(Ow+(long)row*QP+ch*8,v);} }
  asm volatile("s_waitcnt lgkmcnt(0)\n\ts_barrier":::"memory");
  #undef DMA_K
  #undef DMA_V
  #undef CMASK
  #undef START
  #undef RESC
  #undef ROT
}
constexpr int ATTN_LDS_BYTES=LDS_BYTES;
#undef SBAR
#undef WAIT_BAR
}

#define GAS __attribute__((address_space(1)))
#define LAS __attribute__((address_space(3)))
#define DEV __device__ __forceinline__
typedef unsigned short bf16_t;
typedef float f32x4 __attribute__((ext_vector_type(4)));
typedef unsigned u32x4 __attribute__((ext_vector_type(4)));
typedef unsigned u32x2 __attribute__((ext_vector_type(2)));
typedef short bf16x8 __attribute__((ext_vector_type(8)));
template <int CTRL> DEV float dpp(float x) { return __builtin_bit_cast(float, __builtin_amdgcn_mov_dpp(__builtin_bit_cast(int, x), CTRL, 0xf, 0xf, true)); }
template <int CTRL, int ROWMASK> DEV float dpp_bcast_add(float v) { return v + __builtin_bit_cast(float, __builtin_amdgcn_update_dpp(0, __builtin_bit_cast(int, v), CTRL, ROWMASK, 0xf, false)); }
DEV float readlane63(float v) { return __builtin_bit_cast(float, __builtin_amdgcn_readlane(__builtin_bit_cast(int, v), 63)); }
DEV f32x4 mfma16(bf16x8 a, bf16x8 b, f32x4 c) { return __builtin_amdgcn_mfma_f32_16x16x32_bf16(a, b, c, 0, 0, 0); }
#define LDS_WAIT() asm volatile("s_waitcnt lgkmcnt(0)" ::: "memory")
#define SCHED_BARRIER() __builtin_amdgcn_sched_barrier(0)
#define OPAQUE(x) asm volatile("" : "+v"(x))
#define BAR_LDS() asm volatile("s_waitcnt lgkmcnt(0)\n\ts_barrier" ::: "memory")
constexpr int DMODEL = 1024;
constexpr int NCTX = 16, TCTX = 256, NLAT = 4, TLAT = 4096, PAST = 512, TKL = PAST + TLAT;
constexpr int MCTX = NCTX * TCTX, MLAT = NLAT * TLAT, MROWS = MCTX + MLAT;
constexpr int L0_IN = 3520, L0_INP = 3584, L0_LD = 3520;
constexpr int L1_IN = 3628, L1_INP = 3840, L1_LD = 3632;
constexpr int C0_R = 0, C0_K = 512, C0_V = 1024, C0_WF = 1536, C0_WB = 1600, C0_A = 1664, C0_RWG = 1728, C0_Q = 2240, C0_AK = 2752, C0_AV = 2880, C0_ATG = 3008;
constexpr int C1_GQ = 0, C1_GK = 256, C1_GV = 512, C1_GF = 1024, C1_GB = 1040, C1_GLG = 1056, C1_DQKV = 1568, C1_AF = 3104, C1_AB = 3108, C1_BETA = 3112, C1_GDG = 3116;
enum { I_XP = 0, I_XS, I_RWF, I_RWB, I_CK, I_CV, I_GLF, I_GLB, I_GDF, I_GDB, I_C, I_CCTX,
       I0_MODW, I0_MODB, I0_GPRE, I0_GPOST, I0_WIN, I0_WOUT, I0_MU, I0_W0F, I0_W2F, I0_W0B, I0_W2B, I0_A0, I0_A2, I0_KK, I0_KA, I0_RK, I0_GNG, I0_GNB, I0_GQ, I0_GK,
       I1_MODW, I1_MODB, I1_GPRE, I1_GPOST, I1_WIN, I1_WOUT, I1_G2F, I1_GBF, I1_G2B, I1_GBB, I1_GLN, I1_CONV, I1_ALF, I1_DTF, I1_ALB, I1_DTB, I1_GDN, N_IN };
static_assert(N_IN == 49, "49 inputs");
constexpr size_t O_Y = 0, O_RWF = 20971520, O_RWB = 21495808, O_NK = 22020096, O_NV = 22544384, O_GLF = 23068672, O_GLB = 23592960, O_GDF = 24117248, O_GDB = 25165824, O_END = 26214400;
constexpr size_t MiB = 1u << 20;
constexpr size_t WS_LORA = 256 * 1024;
constexpr size_t WS_MODV = 1 * MiB;
constexpr size_t WS_ROPE = 1 * MiB + 128 * 1024;
constexpr size_t WS_CORR = 1 * MiB + 256 * 1024;
constexpr size_t WS_W0IN = 2 * MiB, WS_W0OUT = 9 * MiB, WS_W1IN = 11 * MiB, WS_W1OUT = 19 * MiB;
constexpr size_t WS_KC = 21 * MiB, WS_VC = 22 * MiB, WS_KL = 23 * MiB, WS_VL = 23 * MiB + 4608 * 1024;
constexpr size_t WS_XA = 32 * MiB, WS_XB = 72 * MiB;
constexpr size_t WS_PROJ = 112 * MiB;
static_assert(WS_W0IN + (size_t)L0_INP * 1024 * 2 <= WS_W0OUT && WS_W1IN + (size_t)L1_INP * 1024 * 2 <= WS_W1OUT && WS_VL + 4608 * 1024 <= WS_XA, "ws map");
static_assert(WS_XA + (size_t)MROWS * 2048 == WS_XB && WS_XB + (size_t)MROWS * 2048 == WS_PROJ && WS_PROJ + (size_t)MROWS * L1_LD * 2 <= 256 * MiB, "ws map");
static_assert(WS_CORR + (size_t)MROWS * 8 * 4 <= WS_W0IN, "ws map");
constexpr int LDS_BYTES = 147456;

struct Args { const float* in[N_IN]; float* out; unsigned char* ws; int ph_lo, ph_hi, flags, pad; };

#if defined(EMU)
struct BufRes { unsigned char* p; };
DEV BufRes make_buf(const void* p) { return BufRes{(unsigned char*)p}; }
DEV unsigned buf_ld16(BufRes r, unsigned voff, unsigned soff) { return *(const unsigned short*)(r.p + voff + soff); }
DEV void bst16(BufRes r, unsigned off, u32x4 v) { *(u32x4*)(r.p + off) = v; }
DEV void bst8(BufRes r, unsigned off, u32x2 v) { *(u32x2*)(r.p + off) = v; }
DEV u32x4 bld16(BufRes r, unsigned voff, unsigned soff) { return *(const u32x4*)(r.p + voff + soff); }
DEV u32x2 bld8(BufRes r, unsigned voff, unsigned soff) { return *(const u32x2*)(r.p + voff + soff); }
DEV void buf_st16(BufRes r, unsigned voff, unsigned soff, unsigned v) { *(unsigned short*)(r.p + voff + soff) = (unsigned short)v; }
#else
typedef __amdgpu_buffer_rsrc_t BufRes;
DEV BufRes make_buf(const void* p) { return __builtin_amdgcn_make_buffer_rsrc((void*)p, 0, 0x7ffffffe, 0x00020000); }
DEV unsigned buf_ld16(BufRes r, unsigned voff, unsigned soff) { return __builtin_amdgcn_raw_buffer_load_b16(r, voff, soff, 0); }
DEV void bst16(BufRes r, unsigned off, u32x4 v) { __builtin_amdgcn_raw_buffer_store_b128(v, r, off, 0, 16); }
DEV void bst8(BufRes r, unsigned off, u32x2 v) { __builtin_amdgcn_raw_buffer_store_b64(v, r, off, 0, 16); }
DEV u32x4 bld16(BufRes r, unsigned voff, unsigned soff) { return __builtin_amdgcn_raw_buffer_load_b128(r, voff, soff, 16); }
DEV u32x2 bld8(BufRes r, unsigned voff, unsigned soff) { return __builtin_amdgcn_raw_buffer_load_b64(r, voff, soff, 16); }
DEV void buf_st16(BufRes r, unsigned voff, unsigned soff, unsigned v) { __builtin_amdgcn_raw_buffer_store_b16((unsigned short)v, r, voff, soff, 0); }
#endif
DEV float bf2f(unsigned u16) { return __uint_as_float(u16 << 16); }
DEV unsigned f2bf_sw(float f) { unsigned u = __float_as_uint(f); return (u + 0x7fffu + ((u >> 16) & 1u)) >> 16; }
#if defined(EMU)
DEV unsigned pk2_sw(float lo, float hi) { return f2bf_sw(lo) | (f2bf_sw(hi) << 16); }
#else
DEV unsigned rne16_(float f) { const unsigned u = __float_as_uint(f); return u + 0x7fffu + ((u >> 16) & 1u); }
DEV unsigned pk2_sw(float lo, float hi) { return __builtin_amdgcn_perm(rne16_(hi), rne16_(lo), 0x07060302u); }
#endif
DEV unsigned f2bf(float f) { return f2bf_sw(f); }
DEV unsigned pk2(float lo, float hi) { return pk2_sw(lo, hi); }
DEV void unpack8(const u32x4 v, float (&f)[8]) {
    f[0] = __uint_as_float(v.x << 16); f[1] = __uint_as_float(v.x & 0xffff0000u); f[2] = __uint_as_float(v.y << 16); f[3] = __uint_as_float(v.y & 0xffff0000u);
    f[4] = __uint_as_float(v.z << 16); f[5] = __uint_as_float(v.z & 0xffff0000u); f[6] = __uint_as_float(v.w << 16); f[7] = __uint_as_float(v.w & 0xffff0000u);
}
DEV void ld8(const bf16_t* p, float (&f)[8]) { unpack8(*(const u32x4*)p, f); }
DEV void ld8h(const bf16_t* p, float (&f)[8]) { const u32x2 a = *(const u32x2*)p, b = *(const u32x2*)(p + 4); unpack8((u32x4){a.x, a.y, b.x, b.y}, f); }
DEV u32x4 pack8(const float (&f)[8]) { u32x4 v; v.x = pk2(f[0], f[1]); v.y = pk2(f[2], f[3]); v.z = pk2(f[4], f[5]); v.w = pk2(f[6], f[7]); return v; }
DEV void st8(bf16_t* p, const float (&f)[8]) { *(u32x4*)p = pack8(f); }
#if defined(EMU)
DEV float rcpf_(float x) { return 1.f / x; }
DEV float rsqf_(float x) { return 1.f / sqrtf(x); }
#else
DEV float rsqf_(float x) { return __builtin_amdgcn_rsqf(x); }
DEV float rcpf_(float x) { return __builtin_amdgcn_rcpf(x); }
#endif
DEV float sigmoidf_(float x) { return rcpf_(1.f + __expf(-x)); }
DEV float siluf_(float x) { return x * rcpf_(1.f + __expf(-x)); }
DEV float tanhf_(float x) { return 1.f - 2.f * rcpf_(__expf(2.f * x) + 1.f); }
DEV float log_sigmoidf_(float x) { return fminf(x, 0.f) - __logf(1.f + __expf(-fabsf(x))); }
DEV float softplusf_(float x) { return fmaxf(x, 0.f) + __logf(1.f + __expf(-fabsf(x))); }
DEV float sum4(float x) { x += dpp<0xB1>(x); x += dpp<0x4E>(x); return x; }
DEV float sum8(float x) { x = sum4(x); x += dpp<0x141>(x); return x; }
DEV float sum16(float x) { x = sum8(x); x += dpp<0x128>(x); return x; }
#if defined(EMU)
DEV float wave_sum(float v) {
#pragma unroll
    for (int o = 1; o < 64; o <<= 1) v += __shfl_xor(v, o);
    return v;
}
#else
DEV float wave_sum(float v) { v = sum16(v); v = dpp_bcast_add<0x142, 0xa>(v); v = dpp_bcast_add<0x143, 0xc>(v); return readlane63(v); }
#endif
DEV bf16x8 acc2b(const f32x4 lo, const f32x4 hi) {
    const unsigned a = pk2(lo[0], lo[1]), b = pk2(lo[2], lo[3]), c = pk2(hi[0], hi[1]), d = pk2(hi[2], hi[3]);
    return __builtin_bit_cast(bf16x8, (u32x4){a, b, c, d});
}
DEV bf16x8 ldperm(const LAS bf16_t* p) { const u32x2 lo = *(const LAS u32x2*)p, hi = *(const LAS u32x2*)(p + 16); return __builtin_bit_cast(bf16x8, (u32x4){lo.x, lo.y, hi.x, hi.y}); }
DEV bf16x8 ldfrag(const LAS bf16_t* p) { return *(const LAS bf16x8*)p; }

struct EpiStoreBf16 {
    static constexpr bool PERM = true, AFTER_DRAIN = false;
    bf16_t* O; int ldc;
    __device__ __forceinline__ void operator()(const pg8::f32x4 (&acc)[2][2][4][2], const pg8::Unit& u, int wr, int wc, int fr, int fq) const {
        const int row0 = u.pm * 256 + wr * 64 + fr, col0 = u.pn * 256 + wc * 32 + 8 * fq;
#pragma unroll
        for (int ai = 0; ai < 2; ++ai)
#pragma unroll
            for (int m = 0; m < 4; ++m) { bf16_t* rowp = O + (size_t)(row0 + ai * 128 + m * 16) * ldc;
#pragma unroll
                for (int bj = 0; bj < 2; ++bj) { const int c = col0 + bj * 128;
                    if (c < ldc) { const pg8::f32x4 v0 = acc[ai][bj][m][0], v1 = acc[ai][bj][m][1]; u32x4 w; w.x = pk2(v0[0], v0[1]); w.y = pk2(v0[2], v0[3]); w.z = pk2(v1[0], v1[1]); w.w = pk2(v1[2], v1[3]);
                        *(u32x4*)(rowp + c) = w; } } }
    }
};
struct EpiStoreF32 {
    static constexpr bool PERM = false, AFTER_DRAIN = false;
    float* O; int ldc;
    __device__ __forceinline__ void operator()(const pg8::f32x4 (&acc)[2][2][4][2], const pg8::Unit& u, int wr, int wc, int fr, int fq) const {
        const int row0 = u.pm * 256 + wr * 64 + fr, col0 = u.pn * 256 + wc * 32 + 4 * fq;
#pragma unroll
        for (int ai = 0; ai < 2; ++ai)
#pragma unroll
            for (int m = 0; m < 4; ++m) { float* rowp = O + (size_t)(row0 + ai * 128 + m * 16) * ldc + col0;
#pragma unroll
                for (int bj = 0; bj < 2; ++bj)
#pragma unroll
                    for (int n = 0; n < 2; ++n) *(f32x4*)(rowp + bj * 128 + n * 16) = acc[ai][bj][m][n]; }
    }
};

__device__ __forceinline__ void transpose_item(const float* W, int K, int N, bf16_t* WT, LAS float* scr, int item, int nblk, int lane) {
    const int kb = item / nblk, nb = item % nblk, k0 = 64 * kb, n0 = 32 * nb;
    const int n = n0 + (lane & 31); const bool ok = n < N;
#pragma unroll 8
    for (int i = 0; i < 32; ++i) { const int kk = 2 * i + (lane >> 5); scr[kk * 33 + (lane & 31)] = ok ? W[(size_t)(k0 + kk) * N + n] : 0.f; }
    LDS_WAIT();
    const int c = lane & 7;
#pragma unroll
    for (int j = 0; j < 4; ++j) { const int nn = (lane >> 3) + 8 * j; const LAS float* s = scr + (8 * c) * 33 + nn;
        u32x4 o; o.x = pk2(s[0 * 33], s[1 * 33]); o.y = pk2(s[2 * 33], s[3 * 33]); o.z = pk2(s[4 * 33], s[5 * 33]); o.w = pk2(s[6 * 33], s[7 * 33]);
        *(u32x4*)(WT + (size_t)(n0 + nn) * K + k0 + 8 * c) = o; }
    LDS_WAIT();
}

__device__ __forceinline__ void p0_prologue(const Args& a, LAS unsigned char* lds, int tid, int lane, int wave) {
    unsigned char* ws = a.ws;
    {
        LAS float* scr = (LAS float*)(lds + wave * 16384);
        const int gw = blockIdx.x * 8 + wave, NGW = gridDim.x * 8;
        constexpr int I0 = 16 * (L0_INP / 32), I1 = 16 * 32, I2 = 16 * (L1_INP / 32), I3 = 16 * 32;
        for (int it = gw; it < I0 + I1 + I2 + I3; it += NGW) {
            int r = it;
            if (r < I0) { transpose_item(a.in[I0_WIN], 1024, L0_IN, (bf16_t*)(ws + WS_W0IN), scr, r, L0_INP / 32, lane); continue; } r -= I0;
            if (r < I1) { transpose_item(a.in[I0_WOUT], 1024, 1024, (bf16_t*)(ws + WS_W0OUT), scr, r, 32, lane); continue; } r -= I1;
            if (r < I2) { transpose_item(a.in[I1_WIN], 1024, L1_IN, (bf16_t*)(ws + WS_W1IN), scr, r, L1_INP / 32, lane); continue; } r -= I2;
            transpose_item(a.in[I1_WOUT], 1024, 1024, (bf16_t*)(ws + WS_W1OUT), scr, r, 32, lane);
        }
    }
    {
        const int gw = blockIdx.x * 8 + wave, NGW = gridDim.x * 8, li = lane & 15, g = lane >> 4;
        for (int it = gw; it < 192; it += NGW) { const int mat = it >> 6, h = (it >> 3) & 7, tn = (it >> 1) & 3, ks = it & 1;
            const float* W = a.in[mat == 0 ? I0_W2F : (mat == 1 ? I0_W2B : I0_A2)]; float tw[8];
#pragma unroll
            for (int jj = 0; jj < 8; ++jj) tw[jj] = W[(32 * ks + 8 * g + jj) * 512 + h * 64 + 16 * tn + li];
            *(u32x4*)(ws + WS_LORA + ((size_t)it * 64 + lane) * 16) = pack8(tw); }
    }
    __syncthreads();
    if (blockIdx.x < 96) {
        const int layer = blockIdx.x / 48, jc = blockIdx.x % 48;
        LAS float* sv = (LAS float*)lds; LAS float* red = (LAS float*)(lds + 32768);
        for (int u = tid; u < 5 * 1024; u += 512) { const int c = u >> 10, i = u & 1023; const float x = (c == 0) ? a.in[I_CCTX][i] : a.in[I_C][(c - 1) * 1024 + i]; sv[u] = siluf_(x); }
        __syncthreads();
        const float* mw = a.in[layer ? I1_MODW : I0_MODW];
        const int j = jc * 64 + lane;
        float acc0 = 0.f, acc1 = 0.f, acc2 = 0.f, acc3 = 0.f, acc4 = 0.f;
#pragma unroll 16
        for (int ii = 0; ii < 128; ++ii) { const int i = wave * 128 + ii; const float w = mw[(size_t)i * 3072 + j];
            acc0 += sv[i] * w; acc1 += sv[1024 + i] * w; acc2 += sv[2048 + i] * w; acc3 += sv[3072 + i] * w; acc4 += sv[4096 + i] * w; }
        red[(wave * 5 + 0) * 64 + lane] = acc0; red[(wave * 5 + 1) * 64 + lane] = acc1; red[(wave * 5 + 2) * 64 + lane] = acc2; red[(wave * 5 + 3) * 64 + lane] = acc3; red[(wave * 5 + 4) * 64 + lane] = acc4;
        __syncthreads();
        if (tid < 320) { const int c = tid >> 6; float s = a.in[layer ? I1_MODB : I0_MODB][j];
#pragma unroll
            for (int w = 0; w < 8; ++w) s += red[(w * 5 + c) * 64 + lane];
            ((float*)(ws + WS_MODV))[(layer * 5 + c) * 3072 + j] = s; }
    } else if (blockIdx.x == 96) {
        for (int idx = tid; idx < 1024; idx += 512) { const int pos = idx >> 4, j = idx & 15;
            const float inv = exp2f(-(float)j * (13.287712379549449f / 16.f)); const float ang = (float)pos * inv;
            ((float*)(ws + WS_ROPE))[2 * idx] = cosf(ang); ((float*)(ws + WS_ROPE))[2 * idx + 1] = sinf(ang); }
    }
}

__device__ __forceinline__ const float* xrow_ptr(const Args& a, int row) { return row < MCTX ? a.in[I_XP] + (size_t)row * 1024 : a.in[I_XS] + (size_t)(row - MCTX) * 1024; }
__device__ __forceinline__ int row_cv(int row) { return row < MCTX ? 0 : 1 + (row - MCTX) / TLAT; }
__device__ __forceinline__ float dot4(const f32x4 v) { return (v.x * v.x + v.y * v.y) + (v.z * v.z + v.w * v.w); }

struct RowPar { f32x4 c[4]; };
__device__ __forceinline__ RowPar rowpar_load(const float* p, int lane) { RowPar r;
#pragma unroll
    for (int j = 0; j < 4; ++j) r.c[j] = *(const f32x4*)(p + (64 * j + lane) * 4);
    return r; }
__device__ __forceinline__ void h0_compute(const f32x4 (&v)[4], const RowPar& g, const RowPar& sh, const RowPar& sc, bf16_t* xa_row, int lane) {
    float ss = 0.f;
#pragma unroll
    for (int j = 0; j < 4; ++j) ss += dot4(v[j]);
    const float rstd = rsqf_(wave_sum(ss) * (1.f / 1024.f) + 1e-6f);
#pragma unroll
    for (int j = 0; j < 4; ++j) { const int col = (64 * j + lane) * 4;
        const f32x4 h = v[j] * rstd * g.c[j] * (sc.c[j] + 1.f) + sh.c[j]; u32x2 w; w.x = pk2(h.x, h.y); w.y = pk2(h.z, h.w); *(u32x2*)(xa_row + col) = w; }
}
__device__ __forceinline__ void rows_h0(const Args& a, int lane, int gw, int NGW) {
    const float* modv = (const float*)(a.ws + WS_MODV); bf16_t* XA = (bf16_t*)(a.ws + WS_XA);
    const int per = (MROWS + NGW - 1) / NGW, r0 = gw * per, r1 = r0 + per < MROWS ? r0 + per : MROWS;
    const RowPar g = rowpar_load(a.in[I0_GPRE], lane); RowPar sh = g, sc = g; int cur = -1;
    for (int row = r0; row < r1; row += 2) {
        const int row2 = row + 1 < r1 ? row + 1 : row;
        const f32x4* xr = (const f32x4*)xrow_ptr(a, row) + lane; const f32x4* xr2 = (const f32x4*)xrow_ptr(a, row2) + lane;
        f32x4 v[4], w[4];
#pragma unroll
        for (int j = 0; j < 4; ++j) { v[j] = xr[64 * j]; w[j] = xr2[64 * j]; }
        if (row_cv(row) != cur) { cur = row_cv(row); sh = rowpar_load(modv + cur * 3072, lane); sc = rowpar_load(modv + cur * 3072 + 1024, lane); }
        h0_compute(v, g, sh, sc, XA + (size_t)row * 1024, lane);
        if (row2 != row) { if (row_cv(row2) != cur) { cur = row_cv(row2); sh = rowpar_load(modv + cur * 3072, lane); sc = rowpar_load(modv + cur * 3072 + 1024, lane); }
            h0_compute(w, g, sh, sc, XA + (size_t)row2 * 1024, lane); }
    }
}

__device__ __forceinline__ void rows_attn_prep(const Args& a, int lane, int gw, int NGW, int r0 = 0, int r1 = MROWS, int k0 = 0, int k1 = NLAT * PAST) {
    const bf16_t* PROJ = (const bf16_t*)(a.ws + WS_PROJ); const float* rope = (const float*)(a.ws + WS_ROPE);
    bf16_t* Qb = (bf16_t*)a.out; bf16_t* KC = (bf16_t*)(a.ws + WS_KC); bf16_t* VC = (bf16_t*)(a.ws + WS_VC); bf16_t* KL = (bf16_t*)(a.ws + WS_KL); bf16_t* VL = (bf16_t*)(a.ws + WS_VL);
    const BufRes qres = make_buf(Qb), kcres = make_buf(KC), vcres = make_buf(VC), klres = make_buf(KL), vlres = make_buf(VL);
    const int i8 = lane & 7;
    float gq[8], gk[8];
#pragma unroll
    for (int e = 0; e < 8; ++e) { gq[e] = a.in[I0_GQ][8 * i8 + e]; gk[e] = a.in[I0_GK][8 * i8 + e]; }
    for (int row = r0 + gw; row < r1; row += NGW) {
        const bf16_t* pr = PROJ + (size_t)row * L0_LD; const bool lat = row >= MCTX; const int t = lat ? (row - MCTX) % TLAT : 0; const int bl = lat ? (row - MCTX) / TLAT : 0;
        const int pos = (i8 < 4) ? (t >> 6) : (t & 63);
        float cs[8], sn[8];
#pragma unroll
        for (int e = 0; e < 8; ++e) { const int f = 8 * (i8 & 1) + e; cs[e] = lat ? rope[(pos * 16 + f) * 2] : 1.f; sn[e] = lat ? rope[(pos * 16 + f) * 2 + 1] : 0.f; }
        const float sgn = (i8 & 2) ? 1.f : -1.f;
        {
            float x[8]; ld8(pr + C0_Q + 8 * lane, x); float ss = 0.f;
#pragma unroll
            for (int e = 0; e < 8; ++e) ss += x[e] * x[e];
            const float rstd = rsqf_(sum8(ss) * (1.f / 64.f) + 1e-6f);
            float y[8];
#pragma unroll
            for (int e = 0; e < 8; ++e) { const float v = x[e] * rstd * gq[e]; const float p = __shfl_xor(v, 2); y[e] = (v * cs[e] + sgn * p * sn[e]) * attn_body::C2; }
            bst16(qres, (unsigned)(row * 512 + 8 * lane) * 2u, pack8(y));
        }
        {
            const int l5 = lane & 31; const bool isv = l5 >= 16; const int l4 = l5 & 15;
            float x[8]; ld8(pr + (isv ? C0_AV : C0_AK) + 8 * l4, x); float ss = 0.f;
#pragma unroll
            for (int e = 0; e < 8; ++e) ss += x[e] * x[e];
            const float rstd = rsqf_(sum8(ss) * (1.f / 64.f) + 1e-6f);
            float y[8], z[8];
#pragma unroll
            for (int e = 0; e < 8; ++e) { const float v = x[e] * rstd * gk[e]; const float p = __shfl_xor(v, 2); y[e] = v; z[e] = v * cs[e] + sgn * p * sn[e]; }
            if (lane < 32) {
                if (!lat) {
                    float* o32 = a.out + (isv ? O_NV : O_NK) + (size_t)row * 128 + 8 * l4;
                    if (isv) { *(f32x4*)o32 = (f32x4){x[0], x[1], x[2], x[3]}; *(f32x4*)(o32 + 4) = (f32x4){x[4], x[5], x[6], x[7]}; bst16(vcres, (unsigned)(row * 128 + 8 * l4) * 2u, pack8(x)); }
                    else     { *(f32x4*)o32 = (f32x4){y[0], y[1], y[2], y[3]}; *(f32x4*)(o32 + 4) = (f32x4){y[4], y[5], y[6], y[7]}; bst16(kcres, (unsigned)(row * 128 + 8 * l4) * 2u, pack8(y)); }
                } else {
                    const unsigned kr = (unsigned)((bl * TKL + PAST + t) * 128 + 8 * l4) * 2u;
                    if (isv) bst16(vlres, kr, pack8(x)); else bst16(klres, kr, pack8(z));
                }
            }
        }
    }
    for (int r = k0 + gw; r < k1; r += NGW) {
        if (lane < 32) { const bool isv = lane >= 16; const int l4 = lane & 15; const int b = r / PAST, p = r % PAST;
            const float* src = a.in[isv ? I_CV : I_CK] + (size_t)r * 128 + 8 * l4; const f32x4 u0 = *(const f32x4*)src, u1 = *(const f32x4*)(src + 4);
            float x[8] = {u0.x, u0.y, u0.z, u0.w, u1.x, u1.y, u1.z, u1.w};
            const unsigned kr = (unsigned)((b * TKL + p) * 128 + 8 * l4) * 2u; const u32x4 pk = pack8(x);
            if (isv) bst16(vlres, kr, pk); else bst16(klres, kr, pk); }
    }
}

struct Fin0Row { u32x4 f, b, vc, vp, vn, g, oa, ga; float cr, mp, mn; };
__device__ __forceinline__ Fin0Row fin0_load(const bf16_t* PROJ, const bf16_t* OF, const bf16_t* OBk, const bf16_t* Oat, const float* corr, int row, int c0, int hd) {
    const bool lat = row >= MCTX; const int T = lat ? TLAT : TCTX; const int t = lat ? (row - MCTX) % TLAT : row % TCTX;
    const bf16_t* pr = PROJ + (size_t)row * L0_LD; Fin0Row r;
    r.f = *(const u32x4*)(OF + (size_t)row * 512 + c0); r.b = *(const u32x4*)(OBk + (size_t)row * 512 + c0);
    r.vc = *(const u32x4*)(pr + C0_V + c0); r.vp = *(const u32x4*)(pr + (t > 0 ? -L0_LD : 0) + C0_V + c0); r.vn = *(const u32x4*)(pr + (t < T - 1 ? L0_LD : 0) + C0_V + c0);
    r.g = *(const u32x4*)(pr + C0_RWG + c0); r.oa = *(const u32x4*)(Oat + (size_t)row * 512 + c0); r.ga = *(const u32x4*)(pr + C0_ATG + c0);
    r.cr = corr[(size_t)row * 8 + hd]; r.mp = t > 0 ? 1.f : 0.f; r.mn = t < T - 1 ? 1.f : 0.f; return r;
}
__device__ __forceinline__ void fin0_compute(const Fin0Row& r, bf16_t* xrow, int c0, const float (&gng)[8], const float (&gnb)[8], const float (&muv)[8]) {
    float f[8], b[8], s[8]; unpack8(r.f, f); unpack8(r.b, b);
    float sm = 0.f;
#pragma unroll
    for (int e = 0; e < 8; ++e) { s[e] = f[e] + b[e]; sm += s[e]; }
    const float mean = sum8(sm) * (1.f / 64.f); float q = 0.f;
#pragma unroll
    for (int e = 0; e < 8; ++e) { s[e] -= mean; q += s[e] * s[e]; }
    const float rstd = rsqf_(sum8(q) * (1.f / 64.f) + 64e-5f);
    float vc[8], vp[8], vn[8], g[8], o[8]; unpack8(r.vc, vc); unpack8(r.vp, vp); unpack8(r.vn, vn); unpack8(r.g, g);
#pragma unroll
    for (int e = 0; e < 8; ++e) { const float vs = vc[e] + muv[e] * (0.5f * (r.mp * vp[e] + r.mn * vn[e]) - vc[e]); o[e] = (s[e] * rstd * gng[e] + gnb[e] + r.cr * vs) * siluf_(g[e]); }
    st8(xrow + c0, o);
    float oa[8], ga[8]; unpack8(r.oa, oa); unpack8(r.ga, ga);
#pragma unroll
    for (int e = 0; e < 8; ++e) o[e] = oa[e] * siluf_(ga[e]);
    st8(xrow + 512 + c0, o);
}
__device__ __forceinline__ void rows_fin0(const Args& a, int lane, int gw, int NGW) {
    const bf16_t* PROJ = (const bf16_t*)(a.ws + WS_PROJ); const bf16_t* OF = (const bf16_t*)(a.ws + WS_XB); const bf16_t* OBk = OF + (size_t)MROWS * 512;
    const bf16_t* Oat = (const bf16_t*)a.out; const float* corr = (const float*)(a.ws + WS_CORR); bf16_t* XA = (bf16_t*)(a.ws + WS_XA);
    const int c0 = 8 * lane, hd = lane >> 3;
    float gng[8], gnb[8], muv[8];
#pragma unroll
    for (int e = 0; e < 8; ++e) { gng[e] = a.in[I0_GNG][c0 + e]; gnb[e] = a.in[I0_GNB][c0 + e]; muv[e] = a.in[I0_MU][C0_V + c0 + e]; }
    for (int row = gw; row < MROWS; row += 2 * NGW) {
        const int row2 = row + NGW < MROWS ? row + NGW : row;
        const Fin0Row r0 = fin0_load(PROJ, OF, OBk, Oat, corr, row, c0, hd), r1 = fin0_load(PROJ, OF, OBk, Oat, corr, row2, c0, hd);
        fin0_compute(r0, XA + (size_t)row * 1024, c0, gng, gnb, muv);
        if (row2 != row) fin0_compute(r1, XA + (size_t)row2 * 1024, c0, gng, gnb, muv);
    }
}

struct MidPar { RowPar gate, shift, scale; };
__device__ __forceinline__ MidPar midpar_load(const Args& a, int cv, int lane) { const float* modv0 = (const float*)(a.ws + WS_MODV); const float* modv1 = modv0 + 5 * 3072;
    MidPar m; m.gate = rowpar_load(modv0 + cv * 3072 + 2048, lane); m.shift = rowpar_load(modv1 + cv * 3072, lane); m.scale = rowpar_load(modv1 + cv * 3072 + 1024, lane); return m; }
__device__ __forceinline__ void mid_compute(const Args& a, const u32x2 (&ow)[4], const f32x4 (&xv)[4], int row, int lane, const RowPar& gpost, const RowPar& gpre, const MidPar& m) {
    bf16_t* XB = (bf16_t*)(a.ws + WS_XB);
    f32x4* orow = (f32x4*)(a.out + (size_t)row * 1024) + lane;
    f32x4 v[4]; float ss = 0.f;
#pragma unroll
    for (int j = 0; j < 4; ++j) { v[j] = (f32x4){__uint_as_float(ow[j].x << 16), __uint_as_float(ow[j].x & 0xffff0000u), __uint_as_float(ow[j].y << 16), __uint_as_float(ow[j].y & 0xffff0000u)}; ss += dot4(v[j]); }
    const float rstd = rsqf_(wave_sum(ss) * (1.f / 1024.f) + 1e-6f);
    float s1 = 0.f;
#pragma unroll
    for (int j = 0; j < 4; ++j) { v[j] = xv[j] + m.gate.c[j] * (v[j] * rstd * gpost.c[j]); orow[64 * j] = v[j]; s1 += dot4(v[j]); }
    const float rstd1 = rsqf_(wave_sum(s1) * (1.f / 1024.f) + 1e-6f);
#pragma unroll
    for (int j = 0; j < 4; ++j) { const int col = (64 * j + lane) * 4;
        const f32x4 h = v[j] * rstd1 * gpre.c[j] * (m.scale.c[j] + 1.f) + m.shift.c[j]; u32x2 w; w.x = pk2(h.x, h.y); w.y = pk2(h.z, h.w); *(u32x2*)(XB + (size_t)row * 1024 + col) = w; }
}
__device__ __forceinline__ void rows_mid(const Args& a, int lane, int gw, int NGW) {
    const bf16_t* XB = (const bf16_t*)(a.ws + WS_XB);
    const int per = (MROWS + NGW - 1) / NGW, r0 = gw * per, r1 = r0 + per < MROWS ? r0 + per : MROWS;
    const RowPar gpost = rowpar_load(a.in[I0_GPOST], lane), gpre = rowpar_load(a.in[I1_GPRE], lane); MidPar m; m.gate = gpost; m.shift = gpost; m.scale = gpost; int cur = -1;
    for (int row = r0; row < r1; row += 2) {
        const int row2 = row + 1 < r1 ? row + 1 : row;
        const f32x4* xr = (const f32x4*)xrow_ptr(a, row) + lane; const f32x4* xr2 = (const f32x4*)xrow_ptr(a, row2) + lane;
        u32x2 o0[4], o1[4]; f32x4 x0[4], x1[4];
#pragma unroll
        for (int j = 0; j < 4; ++j) { o0[j] = *(const u32x2*)(XB + (size_t)row * 1024 + (64 * j + lane) * 4); o1[j] = *(const u32x2*)(XB + (size_t)row2 * 1024 + (64 * j + lane) * 4); x0[j] = xr[64 * j]; x1[j] = xr2[64 * j]; }
        if (row_cv(row) != cur) { cur = row_cv(row); m = midpar_load(a, cur, lane); }
        mid_compute(a, o0, x0, row, lane, gpost, gpre, m);
        if (row2 != row) { if (row_cv(row2) != cur) { cur = row_cv(row2); m = midpar_load(a, cur, lane); }
            mid_compute(a, o1, x1, row2, lane, gpost, gpre, m); }
    }
}

struct Fin1Row { u32x4 f0, f1, g0; u32x2 g1a, g1b; };
__device__ __forceinline__ Fin1Row fin1_load(const bf16_t* PROJ, const bf16_t* O4, int row, int c0) {
    const bf16_t* pr = PROJ + (size_t)row * L1_LD; const bf16_t* orow = O4 + (size_t)row * 1024; Fin1Row r;
    r.f0 = *(const u32x4*)(orow + c0); r.f1 = *(const u32x4*)(orow + 512 + c0); r.g0 = *(const u32x4*)(pr + C1_GLG + c0);
    r.g1a = *(const u32x2*)(pr + C1_GDG + c0); r.g1b = *(const u32x2*)(pr + C1_GDG + c0 + 4); return r;
}
__device__ __forceinline__ void fin1_compute(const Fin1Row& r, bf16_t* orow, int c0, const float (&gl)[8], const float (&gd)[8]) {
#pragma unroll
    for (int br = 0; br < 2; ++br) {
        float f[8], g[8], o[8]; unpack8(br == 0 ? r.f0 : r.f1, f); unpack8(br == 0 ? r.g0 : (u32x4){r.g1a.x, r.g1a.y, r.g1b.x, r.g1b.y}, g);
        float ss = 0.f;
#pragma unroll
        for (int e = 0; e < 8; ++e) ss += f[e] * f[e];
        const float rstd = rsqf_(sum16(ss) * (1.f / 128.f) + 1e-6f);
#pragma unroll
        for (int e = 0; e < 8; ++e) o[e] = f[e] * rstd * (br == 0 ? gl[e] : gd[e]) * siluf_(g[e]);
        st8(orow + br * 512 + c0, o);
    }
}
__device__ __forceinline__ void rows_fin1(const Args& a, int lane, int gw, int NGW) {
    const bf16_t* PROJ = (const bf16_t*)(a.ws + WS_PROJ); bf16_t* O4 = (bf16_t*)(a.ws + WS_XA);
    const int c0 = 8 * lane, d0 = c0 & 127;
    float gl[8], gd[8];
#pragma unroll
    for (int e = 0; e < 8; ++e) { gl[e] = a.in[I1_GLN][d0 + e]; gd[e] = a.in[I1_GDN][d0 + e]; }
    for (int row = gw; row < MROWS; row += 2 * NGW) {
        const int row2 = row + NGW < MROWS ? row + NGW : row;
        const Fin1Row r0 = fin1_load(PROJ, O4, row, c0), r1 = fin1_load(PROJ, O4, row2, c0);
        fin1_compute(r0, O4 + (size_t)row * 1024, c0, gl, gd);
        if (row2 != row) fin1_compute(r1, O4 + (size_t)row2 * 1024, c0, gl, gd);
    }
}

__device__ __forceinline__ void final_compute(const u32x2 (&ow)[4], const f32x4 (&xv)[4], f32x4* yrow, const RowPar& gate, const RowPar& gpost) {
    f32x4 v[4]; float ss = 0.f;
#pragma unroll
    for (int j = 0; j < 4; ++j) { v[j] = (f32x4){__uint_as_float(ow[j].x << 16), __uint_as_float(ow[j].x & 0xffff0000u), __uint_as_float(ow[j].y << 16), __uint_as_float(ow[j].y & 0xffff0000u)}; ss += dot4(v[j]); }
    const float rstd = rsqf_(wave_sum(ss) * (1.f / 1024.f) + 1e-6f);
#pragma unroll
    for (int j = 0; j < 4; ++j) yrow[64 * j] = xv[j] + gate.c[j] * (v[j] * rstd * gpost.c[j]);
}
__device__ __forceinline__ void rows_final(const Args& a, int lane, int gw, int NGW) {
    const float* modv1 = (const float*)(a.ws + WS_MODV) + 5 * 3072; const bf16_t* out2 = (const bf16_t*)(a.ws + WS_XB);
    const int per = (MROWS + NGW - 1) / NGW, r0 = gw * per, r1 = r0 + per < MROWS ? r0 + per : MROWS;
    const RowPar gpost = rowpar_load(a.in[I1_GPOST], lane); RowPar gate = gpost; int cur = -1;
    for (int row = r0; row < r1; row += 2) {
        const int row2 = row + 1 < r1 ? row + 1 : row;
        f32x4* y0 = (f32x4*)(a.out + (size_t)row * 1024) + lane; f32x4* y1 = (f32x4*)(a.out + (size_t)row2 * 1024) + lane;
        u32x2 o0[4], o1[4]; f32x4 x0[4], x1[4];
#pragma unroll
        for (int j = 0; j < 4; ++j) { o0[j] = *(const u32x2*)(out2 + (size_t)row * 1024 + (64 * j + lane) * 4); o1[j] = *(const u32x2*)(out2 + (size_t)row2 * 1024 + (64 * j + lane) * 4); x0[j] = y0[64 * j]; x1[j] = y1[64 * j]; }
        if (row_cv(row) != cur) { cur = row_cv(row); gate = rowpar_load(modv1 + cur * 3072 + 2048, lane); }
        final_compute(o0, x0, y0, gate, gpost);
        if (row2 != row) { if (row_cv(row2) != cur) { cur = row_cv(row2); gate = rowpar_load(modv1 + cur * 3072 + 2048, lane); }
            final_compute(o1, x1, y1, gate, gpost); }
    }
}
DEV int chain_row(int rbase, int T, int dir, int n) { return rbase + (dir ? T - 1 - n : n); }

constexpr int GL_QT = 0, GL_KT = 9216, GL_KD = 18432, GL_VT = 27648, GL_ATT = 46080, GL_DEC = 55296, GL_SEG = 55552, GL_GIN = 57600, GL_END = 61696;
DEV void gla_chunk_chain(const Args& a, LAS unsigned char* lds, int tid, int lane, int wave, int T, int rbase, const float* s0, float* sout, int h, int dir) {
    const bf16_t* PROJ = (const bf16_t*)(a.ws + WS_PROJ);
    LAS bf16_t* QT = (LAS bf16_t*)(lds + GL_QT);
    LAS bf16_t* KT = (LAS bf16_t*)(lds + GL_KT);
    LAS bf16_t* KD = (LAS bf16_t*)(lds + GL_KD);
    LAS bf16_t* VT = (LAS bf16_t*)(lds + GL_VT);
    LAS bf16_t* ATT = (LAS bf16_t*)(lds + GL_ATT);
    LAS float* DEC = (LAS float*)(lds + GL_DEC);
    LAS float* SEG = (LAS float*)(lds + GL_SEG);
    LAS float* GIN = (LAS float*)(lds + GL_GIN);
    const int d = lane, seg = wave, hc = h * 64 + d, NC = T / 64;
    const float* g2 = a.in[dir ? I1_G2B : I1_G2F];
    float g2c[16];
#pragma unroll
    for (int i = 0; i < 16; ++i) g2c[i] = g2[i * 256 + hc];
    const float gb = a.in[dir ? I1_GBB : I1_GBF][hc];
    const int cgin = dir ? C1_GB : C1_GF;
    const int li = lane & 15, g = lane >> 4, v0 = 16 * wave;
    const float* sp0 = s0 ? s0 : a.in[I_GLF];
    f32x4 S[4];
#pragma unroll
    for (int dt = 0; dt < 4; ++dt)
#pragma unroll
        for (int r = 0; r < 4; ++r) { const float sv_ = sp0[(size_t)(16 * dt + 4 * g + r) * 128 + v0 + li]; S[dt][r] = s0 ? sv_ : 0.f; }
    bf16_t* O4 = (bf16_t*)(a.ws + WS_XA) + (dir ? 1024 : 0) + h * 128;
    const int ltt = tid >> 3, lp = tid & 7;
    unsigned graw; u32x4 vraw0, vraw1; unsigned short qraw[8], kraw[8];
#define GLA_LOAD(c_) do { const bf16_t* pr_ = PROJ + chain_row(rbase, T, dir, (c_) * 64 + ltt) * L1_LD; graw = *(const unsigned*)(pr_ + cgin + 2 * lp); \
        vraw0 = *(const u32x4*)(pr_ + C1_GV + h * 128 + 16 * lp); vraw1 = *(const u32x4*)(pr_ + C1_GV + h * 128 + 16 * lp + 8); \
        _Pragma("unroll") for (int e = 0; e < 8; ++e) { const bf16_t* pq_ = PROJ + chain_row(rbase, T, dir, (c_) * 64 + 8 * seg + e) * L1_LD; qraw[e] = pq_[C1_GQ + hc]; kraw[e] = pq_[C1_GK + hc]; } } while (0)
    GLA_LOAD(0);
    for (int c = 0; c < NC; ++c) {
        GIN[ltt * 16 + 2 * lp] = bf2f(graw & 0xffffu); GIN[ltt * 16 + 2 * lp + 1] = bf2f(graw >> 16);
        {
            const unsigned vw[8] = {vraw0.x, vraw0.y, vraw0.z, vraw0.w, vraw1.x, vraw1.y, vraw1.z, vraw1.w};
#pragma unroll
            for (int jj = 0; jj < 8; ++jj) { VT[(16 * lp + 2 * jj) * 72 + ltt] = (bf16_t)(vw[jj] & 0xffffu); VT[(16 * lp + 2 * jj + 1) * 72 + ltt] = (bf16_t)(vw[jj] >> 16); }
        }
        float qf[8], kf[8];
#pragma unroll
        for (int e = 0; e < 8; ++e) { qf[e] = bf2f(qraw[e]); kf[e] = bf2f(kraw[e]); }
        BAR_LDS();
        GLA_LOAD(c + 1 < NC ? c + 1 : c);
        float cl[8];
        {
            float run = 0.f;
#pragma unroll
            for (int e = 0; e < 8; ++e) {
                const LAS f32x4* g4 = (const LAS f32x4*)(GIN + (8 * seg + e) * 16); float x = gb;
#pragma unroll
                for (int i = 0; i < 4; ++i) { const f32x4 y = g4[i]; x += y[0] * g2c[4 * i] + y[1] * g2c[4 * i + 1] + y[2] * g2c[4 * i + 2] + y[3] * g2c[4 * i + 3]; }
                run += log_sigmoidf_(x) * (1.f / 16.f); cl[e] = run;
            }
            SEG[seg * 64 + d] = run;
        }
        BAR_LDS();
        {
            float off = 0.f, tot = 0.f;
#pragma unroll
            for (int s2 = 0; s2 < 8; ++s2) { const float sv = SEG[s2 * 64 + d]; tot += sv; off += (s2 < seg) ? sv : 0.f; }
            float kd[8];
#pragma unroll
            for (int e = 0; e < 8; ++e) { const float cum = off + cl[e]; const int tt = 8 * seg + e; const float eq = __expf(cum);
                QT[tt * 72 + d] = (bf16_t)f2bf(qf[e] * 0.125f * eq); KT[tt * 72 + d] = (bf16_t)f2bf(kf[e] * __expf(-cum)); kd[e] = kf[e] * __expf(tot - cum); }
            *(LAS u32x4*)(KD + d * 72 + 8 * seg) = pack8(kd);
            if (seg == 0) DEC[d] = __expf(tot);
        }
        BAR_LDS();
#pragma unroll
        for (int q2 = 0; q2 < 2; ++q2) {
            const int idx = 2 * wave + q2, tm = idx >> 2, tn = idx & 3; f32x4 acc = {0.f, 0.f, 0.f, 0.f};
            if (tn <= tm) {
#pragma unroll
                for (int ks = 0; ks < 2; ++ks) acc = mfma16(ldfrag(QT + (16 * tm + li) * 72 + 32 * ks + 8 * g), ldfrag(KT + (16 * tn + li) * 72 + 32 * ks + 8 * g), acc);
            }
#pragma unroll
            for (int r = 0; r < 4; ++r) { const int t = 16 * tm + 4 * g + r, s = 16 * tn + li; ATT[t * 72 + s] = (bf16_t)f2bf((s <= t) ? acc[r] : 0.f); }
        }
        BAR_LDS();
        {
            bf16x8 bv[2], sb[2];
#pragma unroll
            for (int ks = 0; ks < 2; ++ks) { bv[ks] = ldfrag(VT + (v0 + li) * 72 + 32 * ks + 8 * g); sb[ks] = acc2b(S[2 * ks], S[2 * ks + 1]); }
#pragma unroll
            for (int mt = 0; mt < 4; ++mt) {
                f32x4 o = {0.f, 0.f, 0.f, 0.f};
#pragma unroll
                for (int ks = 0; ks < 2; ++ks) o = mfma16(ldfrag(ATT + (16 * mt + li) * 72 + 32 * ks + 8 * g), bv[ks], o);
#pragma unroll
                for (int ks = 0; ks < 2; ++ks) o = mfma16(ldperm(QT + (16 * mt + li) * 72 + 32 * ks + 4 * g), sb[ks], o);
#pragma unroll
                for (int r = 0; r < 4; ++r) O4[chain_row(rbase, T, dir, c * 64 + 16 * mt + 4 * g + r) * 2048 + v0 + li] = (bf16_t)f2bf(o[r]);
            }
#pragma unroll
            for (int dt = 0; dt < 4; ++dt) {
                const f32x4 dec = *(const LAS f32x4*)(DEC + 16 * dt + 4 * g); f32x4 acc = S[dt] * dec;
#pragma unroll
                for (int ks = 0; ks < 2; ++ks) acc = mfma16(ldfrag(KD + (16 * dt + li) * 72 + 32 * ks + 8 * g), bv[ks], acc);
                S[dt] = acc;
            }
        }
        BAR_LDS();
    }
#undef GLA_LOAD
    if (sout) {
#pragma unroll
        for (int dt = 0; dt < 4; ++dt)
#pragma unroll
            for (int r = 0; r < 4; ++r) sout[(size_t)(16 * dt + 4 * g + r) * 128 + v0 + li] = S[dt][r];
    }
}

typedef float f32x2 __attribute__((ext_vector_type(2)));
template <int NS> DEV void fwd_subst(const LAS float* A  , const float (&rhs_own)[64 / NS], float (&x)[64 / NS], int q) {
    f32x2 xv[32 / NS];
#pragma unroll
    for (int i = 0; i < 32 / NS; ++i) xv[i] = (f32x2){0.f, 0.f};
#pragma unroll
    for (int t = 0; t < 64; ++t) {
        const int own = (t >> 2) % NS, xi = 4 * (t / (4 * NS)) + (t & 3);
        f32x2 acc2 = {(q == own) ? rhs_own[xi] : 0.f, 0.f};
        const int nblk = (t + 4 * NS - 1) / (4 * NS);
#pragma unroll
        for (int m = 0; m < nblk; ++m) { const f32x4 a4 = *(const LAS f32x4*)(A + t * 68 + 4 * NS * m + 4 * q);
            acc2 -= (f32x2){a4[0], a4[1]} * xv[2 * m]; acc2 -= (f32x2){a4[2], a4[3]} * xv[2 * m + 1]; }
        float acc = acc2[0] + acc2[1];
        acc += dpp<0xB1>(acc);
        if (NS == 4) acc += dpp<0x4E>(acc);
        const float keep = xv[xi >> 1][xi & 1];
        xv[xi >> 1][xi & 1] = (q == own) ? acc : keep;
    }
#pragma unroll
    for (int i = 0; i < 64 / NS; ++i) x[i] = xv[i >> 1][i & 1];
}

template <int DS> DEV void diag16_inverse(const LAS float* A  , LAS bf16_t* DBF, int I, int lane) {
    const int c = lane & 15; float x[16];
#pragma unroll
    for (int i = 0; i < 16; ++i) x[i] = 0.f;
#pragma unroll
    for (int t = 0; t < 16; ++t) { float acc = (t == c) ? 1.f : 0.f; const LAS f32x4* ar = (const LAS f32x4*)(A + (16 * I + t) * 68 + 16 * I);
#pragma unroll
        for (int s4 = 0; s4 < (t + 3) / 4; ++s4) { const f32x4 a4 = ar[s4]; acc -= a4[0] * x[4 * s4] + a4[1] * x[4 * s4 + 1] + a4[2] * x[4 * s4 + 2] + a4[3] * x[4 * s4 + 3]; }
        x[t] = acc; }
    if (lane < 16) {
#pragma unroll
        for (int t = 0; t < 16; ++t) { DBF[(16 * I + t) * DS + c] = (bf16_t)f2bf(x[t]); DBF[(16 * I + t) * DS + 16 + c] = (bf16_t)0; }
    }
}
template <int DS, class RHS> DEV void block_solve16(const LAS bf16_t* ABF  , const LAS bf16_t* DBF, const RHS& rhs, f32x4 (&X)[4], int li, int g) {
    const f32x4 z = {0.f, 0.f, 0.f, 0.f};
    X[0] = mfma16(ldperm(DBF + li * DS + 4 * g), acc2b(rhs(0), z), z);
    f32x4 y = mfma16(ldperm(ABF + (16 + li) * 72 + 4 * g), acc2b(X[0], z), -rhs(1));
    X[1] = mfma16(ldperm(DBF + (16 + li) * DS + 4 * g), acc2b(-y, z), z);
    const bf16x8 b01 = acc2b(X[0], X[1]);
    y = mfma16(ldperm(ABF + (32 + li) * 72 + 4 * g), b01, -rhs(2));
    X[2] = mfma16(ldperm(DBF + (32 + li) * DS + 4 * g), acc2b(-y, z), z);
    y = mfma16(ldperm(ABF + (48 + li) * 72 + 4 * g), b01, -rhs(3));
    y = mfma16(ldperm(ABF + (48 + li) * 72 + 32 + 4 * g), acc2b(X[2], z), y);
    X[3] = mfma16(ldperm(DBF + (48 + li) * DS + 4 * g), acc2b(-y, z), z);
}

constexpr int GD_Q = 0, GD_K = 17408, GD_V = 34816, GD_U0T = 17408, GD_KT = 52224, GD_W = 70656, GD_AQK = 88064, GD_A = 97280, GD_SC = 114688, GD_CW = 116480, GD_END = 121088;
DEV void gdn_chunk_chain(const Args& a, LAS unsigned char* lds, int tid, int lane_in, int wave, int T, int rbase, const float* s0, float* sout, int h, int dir) {
    const bf16_t* PROJ = (const bf16_t*)(a.ws + WS_PROJ);
    LAS bf16_t* Q = (LAS bf16_t*)(lds + GD_Q);
    LAS bf16_t* K = (LAS bf16_t*)(lds + GD_K);
    LAS bf16_t* V = (LAS bf16_t*)(lds + GD_V);
    LAS float* U0T = (LAS float*)(lds + GD_U0T);
    LAS bf16_t* KT = (LAS bf16_t*)(lds + GD_KT);
    LAS bf16_t* W = (LAS bf16_t*)(lds + GD_W);
    LAS bf16_t* AQK = (LAS bf16_t*)(lds + GD_AQK);
    LAS float* A = (LAS float*)(lds + GD_A);
    LAS float* SC = (LAS float*)(lds + GD_SC);
    LAS float* LOGA = SC, *BETA = SC + 64, *GC = SC + 128, *GAM = SC + 192, *EE = SC + 256, *BG = SC + 320, *GLs = SC + 384;
    LAS float* CW = (LAS float*)(lds + GD_CW);
    const int NC = T / 64;
    const float nA = -__expf(a.in[dir ? I1_ALB : I1_ALF][h]), dtb = a.in[dir ? I1_DTB : I1_DTF][h];
    const int ca = dir ? C1_AB : C1_AF;
    for (int u = tid; u < 3 * 384; u += 512) { const int tap = u / 384, rem = u % 384, arr = rem >> 7, dd = rem & 127; CW[u] = a.in[I1_CONV][tap * 1536 + arr * 512 + h * 128 + dd]; }
    const int li0 = lane_in & 15, g0 = lane_in >> 4, v0 = 16 * wave;
    const float* sp0 = s0 ? s0 : a.in[I_GDF];
    f32x4 S[8];
#pragma unroll
    for (int dt = 0; dt < 8; ++dt)
#pragma unroll
        for (int r = 0; r < 4; ++r) { const float sv_ = sp0[(size_t)(16 * dt + 4 * g0 + r) * 128 + v0 + li0]; S[dt][r] = s0 ? sv_ : 0.f; }
    bf16_t* O4 = (bf16_t*)(a.ws + WS_XA) + (dir ? 1536 : 512) + h * 128;
    unsigned pf_acc = 0u;
    BAR_LDS();
    for (int c = 0; c < NC; ++c) {
        int tv = tid; OPAQUE(tv);
        const int lane = tv & 63, li = lane & 15, g = lane >> 4, tt = tv >> 3, part = tv & 7;
        unsigned pfv = 0u;
        { const int tq = tv < 396 ? tv : tv - 396, cn = c + 1 < NC ? c + 1 : c; const int ri = tq / 6, s6 = tq % 6; const long lo = (long)(dir ? chain_row(rbase, T, dir, cn * 64 + 63) : chain_row(rbase, T, dir, cn * 64)) - 1 + ri;
            const long rr = lo < rbase ? rbase : (lo > rbase + T - 1 ? rbase + T - 1 : lo);
            pfv = *(const volatile unsigned*)(PROJ + (size_t)rr * L1_LD + C1_DQKV + (s6 >> 1) * 512 + h * 128 + 64 * (s6 & 1)); }
        {
            const size_t row = chain_row(rbase, T, dir, c * 64 + tt); const int tact = (int)(row - rbase); const bool hp = tact > 0, hn = tact < T - 1;
            const bf16_t* pc = PROJ + row * L1_LD + C1_DQKV + h * 128 + 16 * part;
            const int op = hp ? -L1_LD : 0, on = hn ? L1_LD : 0; const float mp = hp ? 1.f : 0.f, mn = hn ? 1.f : 0.f;
            u32x4 ra[2][3], rb[2][3];
#define GDN_LD(dst, arr) do { _Pragma("unroll") for (int hf = 0; hf < 2; ++hf) { const bf16_t* p_ = pc + (arr) * 512 + 8 * hf; dst[hf][0] = *(const u32x4*)(p_ + op); dst[hf][1] = *(const u32x4*)p_; dst[hf][2] = *(const u32x4*)(p_ + on); } } while (0)
#define GDN_CONV(y, src, arr) do { _Pragma("unroll") for (int hf = 0; hf < 2; ++hf) { float cur[8], prv[8], nxt[8]; unpack8(src[hf][0], prv); unpack8(src[hf][1], cur); unpack8(src[hf][2], nxt); \
                _Pragma("unroll") for (int e4 = 0; e4 < 2; ++e4) { const int cb = (arr) * 128 + 16 * part + 8 * hf + 4 * e4; \
                    const f32x4 w0 = *(const LAS f32x4*)(CW + cb) * mp, w1 = *(const LAS f32x4*)(CW + 384 + cb), w2 = *(const LAS f32x4*)(CW + 768 + cb) * mn; \
                    _Pragma("unroll") for (int e = 0; e < 4; ++e) y[8 * hf + 4 * e4 + e] = siluf_(w0[e] * prv[4 * e4 + e] + w1[e] * cur[4 * e4 + e] + w2[e] * nxt[4 * e4 + e]); } } } while (0)
#define GDN_ST(dst, y) do { _Pragma("unroll") for (int hf = 0; hf < 2; ++hf) { float t8[8]; _Pragma("unroll") for (int e = 0; e < 8; ++e) t8[e] = y[8 * hf + e]; *(LAS u32x4*)(dst + tt * 136 + 16 * part + 8 * hf) = pack8(t8); } } while (0)
            GDN_LD(ra, 0); GDN_LD(rb, 1);
            SCHED_BARRIER();
            {
                float y[16]; GDN_CONV(y, ra, 0); float sq = 0.f;
#pragma unroll
                for (int e = 0; e < 16; ++e) sq += y[e] * y[e];
                const float qn = rsqf_(sum8(sq) + 1e-6f) * 0.08838834764831845f;
#pragma unroll
                for (int e = 0; e < 16; ++e) y[e] *= qn;
                GDN_ST(Q, y);
            }
            SCHED_BARRIER();
            GDN_LD(ra, 2);
            SCHED_BARRIER();
            {
                float y[16]; GDN_CONV(y, rb, 1); float sk = 0.f;
#pragma unroll
                for (int e = 0; e < 16; ++e) sk += y[e] * y[e];
                const float kn = rsqf_(sum8(sk) + 1e-6f);
#pragma unroll
                for (int e = 0; e < 16; ++e) y[e] *= kn;
                GDN_ST(K, y);
#pragma unroll
                for (int e = 0; e < 16; ++e) KT[(16 * part + e) * 72 + tt] = (bf16_t)f2bf(y[e]);
            }
            SCHED_BARRIER();
            {
                float y[16]; GDN_CONV(y, ra, 2); GDN_ST(V, y);
            }
#undef GDN_LD
#undef GDN_CONV
#undef GDN_ST
            if (part == 0) { const bf16_t* ps = PROJ + row * L1_LD; LOGA[tt] = nA * softplusf_(bf2f(ps[ca + h]) + dtb); BETA[tt] = sigmoidf_(bf2f(ps[C1_BETA + h])); }
        }
        BAR_LDS();
        if (wave == 0) {
            float x = LOGA[lane];
#pragma unroll
            for (int off = 1; off < 64; off <<= 1) { const float y2 = __shfl_up(x, off); x += (lane >= off) ? y2 : 0.f; }
            const float gl = __shfl(x, 63);
            GC[lane] = x; const float gm = __expf(x); GAM[lane] = gm; EE[lane] = __expf(gl - x); BG[lane] = BETA[lane] * gm;
            if (lane == 63) GLs[0] = __expf(gl);
        }
        BAR_LDS();
#pragma unroll
        for (int q2 = 0; q2 < 2; ++q2) {
            const int idx = 2 * wave + q2, tm = idx >> 2, tn = idx & 3; f32x4 ak = {0.f, 0.f, 0.f, 0.f}, aq = {0.f, 0.f, 0.f, 0.f};
            if (tn <= tm) {
#pragma unroll
                for (int ks = 0; ks < 4; ++ks) { const bf16x8 kb = ldfrag(K + (16 * tn + li) * 136 + 32 * ks + 8 * g);
                    ak = mfma16(ldfrag(K + (16 * tm + li) * 136 + 32 * ks + 8 * g), kb, ak); aq = mfma16(ldfrag(Q + (16 * tm + li) * 136 + 32 * ks + 8 * g), kb, aq); }
            }
            const int s = 16 * tn + li; const float gs = GC[s];
#pragma unroll
            for (int r = 0; r < 4; ++r) { const int t = 16 * tm + 4 * g + r; const float dec = __expf(fminf(GC[t] - gs, 0.f));
                A[t * 68 + s] = (s < t) ? BETA[t] * dec * ak[r] : 0.f; AQK[t * 72 + s] = (bf16_t)f2bf((s <= t) ? dec * aq[r] : 0.f); }
        }
        BAR_LDS();
        {
            const int col = tv >> 1, hq = tv & 1;
            const LAS bf16_t* rsrc = (col < 128) ? K + col : V + (col - 128); const LAS float* rsc = (col < 128) ? BG : BETA;
            float x[32], rh[32];
#pragma unroll
            for (int m = 0; m < 8; ++m) { const f32x4 sc4 = *(const LAS f32x4*)(rsc + 8 * m + 4 * hq);
#pragma unroll
                for (int e = 0; e < 4; ++e) rh[4 * m + e] = sc4[e] * bf2f(rsrc[(8 * m + 4 * hq + e) * 136]); }
            fwd_subst<2>(A, rh, x, hq);
            BAR_LDS();
            if (col < 128) {
#pragma unroll
                for (int m = 0; m < 8; ++m)
#pragma unroll
                    for (int e = 0; e < 4; ++e) W[(8 * m + 4 * hq + e) * 136 + col] = (bf16_t)f2bf(x[4 * m + e]);
            } else {
#pragma unroll
                for (int m = 0; m < 8; ++m) *(LAS f32x4*)(U0T + (col - 128) * 68 + 8 * m + 4 * hq) = (f32x4){x[4 * m], x[4 * m + 1], x[4 * m + 2], x[4 * m + 3]};
            }
        }
        BAR_LDS();
        {
            bf16x8 sb[4];
#pragma unroll
            for (int ks = 0; ks < 4; ++ks) sb[ks] = acc2b(S[2 * ks], S[2 * ks + 1]);
            f32x4 u[4];
#pragma unroll
            for (int mt = 0; mt < 4; ++mt) { f32x4 p = {0.f, 0.f, 0.f, 0.f};
#pragma unroll
                for (int ks = 0; ks < 4; ++ks) p = mfma16(ldperm(W + (16 * mt + li) * 136 + 32 * ks + 4 * g), sb[ks], p);
                u[mt] = *(const LAS f32x4*)(U0T + (v0 + li) * 68 + 16 * mt + 4 * g) - p; }
            bf16x8 ub[2], ueb[2];
#pragma unroll
            for (int k2 = 0; k2 < 2; ++k2) { ub[k2] = acc2b(u[2 * k2], u[2 * k2 + 1]);
                ueb[k2] = acc2b(u[2 * k2] * *(const LAS f32x4*)(EE + 32 * k2 + 4 * g), u[2 * k2 + 1] * *(const LAS f32x4*)(EE + 32 * k2 + 16 + 4 * g)); }
#pragma unroll
            for (int mt = 0; mt < 4; ++mt) { f32x4 o = {0.f, 0.f, 0.f, 0.f};
#pragma unroll
                for (int ks = 0; ks < 4; ++ks) o = mfma16(ldperm(Q + (16 * mt + li) * 136 + 32 * ks + 4 * g), sb[ks], o);
                o = o * *(const LAS f32x4*)(GAM + 16 * mt + 4 * g);
#pragma unroll
                for (int k2 = 0; k2 < 2; ++k2) o = mfma16(ldperm(AQK + (16 * mt + li) * 72 + 32 * k2 + 4 * g), ub[k2], o);
#pragma unroll
                for (int r = 0; r < 4; ++r) O4[chain_row(rbase, T, dir, c * 64 + 16 * mt + 4 * g + r) * 2048 + v0 + li] = (bf16_t)f2bf(o[r]); }
            const float gl = GLs[0];
#pragma unroll
            for (int dt = 0; dt < 8; ++dt) { f32x4 acc = S[dt] * gl;
#pragma unroll
                for (int k2 = 0; k2 < 2; ++k2) acc = mfma16(ldperm(KT + (16 * dt + li) * 72 + 32 * k2 + 4 * g), ueb[k2], acc);
                S[dt] = acc; }
        }
        pf_acc ^= pfv;
        BAR_LDS();
    }
    if (pf_acc == 0x9e3779b9u) LOGA[0] = 1.f;
    if (sout) {
        int sidx = 4 * g0 * 128 + v0 + li0; OPAQUE(sidx);
#pragma unroll
        for (int dt = 0; dt < 8; ++dt)
#pragma unroll
            for (int r = 0; r < 4; ++r) sout[(size_t)((16 * dt + r) * 128 + sidx)] = S[dt][r];
    }
}

constexpr int RW_RT = 0, RW_KKT = 9216, RW_BT = 18432, RW_KT = 27648, RW_KDT = 36864, RW_BDT = 46080, RW_VT = 55296, RW_AAB = 64512, RW_AKV = 81920, RW_AAK = 99328, RW_ARB = 108544, RW_ARK = 117760,
              RW_SEG = 126976, RW_GL = 129024, RW_END = 129280;
DEV float wave_sum_f(float v) { v = sum16(v); v = dpp_bcast_add<0x142, 0xa>(v); v = dpp_bcast_add<0x143, 0xc>(v); return readlane63(v); }
DEV void rwkv_chunk_chain(const Args& a, LAS unsigned char* lds, int tid, int lane_in, int wave, int T, int rbase, const float* s0, float* sout, int h, int dir) {
    const bf16_t* PROJ = (const bf16_t*)(a.ws + WS_PROJ);
    LAS bf16_t* RT = (LAS bf16_t*)(lds + RW_RT);
    LAS bf16_t* KKT = (LAS bf16_t*)(lds + RW_KKT);
    LAS bf16_t* BT = (LAS bf16_t*)(lds + RW_BT);
    LAS bf16_t* KT = (LAS bf16_t*)(lds + RW_KT);
    LAS bf16_t* KDT = (LAS bf16_t*)(lds + RW_KDT);
    LAS bf16_t* BDT = (LAS bf16_t*)(lds + RW_BDT);
    LAS bf16_t* VT = (LAS bf16_t*)(lds + RW_VT);
    LAS float* AAB = (LAS float*)(lds + RW_AAB);
    LAS float* AKV = (LAS float*)(lds + RW_AKV);
    LAS bf16_t* AAK = (LAS bf16_t*)(lds + RW_AAK);
    LAS bf16_t* ARB = (LAS bf16_t*)(lds + RW_ARB);
    LAS bf16_t* ARK = (LAS bf16_t*)(lds + RW_ARK);
    LAS float* SEG = (LAS float*)(lds + RW_SEG);
    LAS float* GL = (LAS float*)(lds + RW_GL);
    const int NC = T / 64, seg = wave, cw = dir ? C0_WB : C0_WF;
    const float* mu = a.in[I0_MU];
    float* corr = (float*)(a.ws + WS_CORR);
    bf16_t* Oout = (bf16_t*)(a.ws + WS_XB) + (dir ? (size_t)MROWS * 512 : 0) + h * 64;
    const int li0 = lane_in & 15, g0 = lane_in >> 4, v0 = 16 * wave;
    bf16x8 w2f[2], a2f[2];
    {
        const float* w2 = a.in[dir ? I0_W2B : I0_W2F]; const float* a2 = a.in[I0_A2]; const int dc = h * 64 + 16 * (wave & 3) + li0;
#pragma unroll
        for (int ks = 0; ks < 2; ++ks) { float tw[8], ta[8];
#pragma unroll
            for (int j = 0; j < 8; ++j) { tw[j] = w2[(32 * ks + 8 * g0 + j) * 512 + dc]; ta[j] = a2[(32 * ks + 8 * g0 + j) * 512 + dc]; }
            w2f[ks] = __builtin_bit_cast(bf16x8, pack8(tw)); a2f[ks] = __builtin_bit_cast(bf16x8, pack8(ta)); }
    }
    const float* sp0 = s0 ? s0 : a.in[I_RWF];
    f32x4 S[4];
#pragma unroll
    for (int dt = 0; dt < 4; ++dt) { const f32x4 sv_ = *(const f32x4*)(sp0 + (size_t)((v0 & 63) + li0) * 64 + 16 * dt + 4 * g0); S[dt] = (s0 && wave < 4) ? sv_ : (f32x4){0.f, 0.f, 0.f, 0.f}; }
    unsigned pf_acc = 0u;
    for (int c = 0; c < NC; ++c) {
        int tv = tid; OPAQUE(tv);
        const int lane = tv & 63, li = lane & 15, g = lane >> 4, d = lane, hc = h * 64 + d;
        unsigned pfv = 0u;
        { const int tq = tv < 330 ? tv : tv - 330, cn = c + 1 < NC ? c + 1 : c; const int ri = tq / 5, s5 = tq % 5; int n = cn * 64 - 1 + ri; n = n > T - 1 ? T - 1 : n;
            const int colp = (s5 < 3) ? (s5 * 512 + h * 64) : (s5 == 3 ? cw : C0_A);
            pfv = *(const volatile unsigned*)(PROJ + chain_row(rbase, T, dir, n) * L0_LD + colp); }
        float rr[8], ks_[8], vv[8];
        {
            const int n0 = c * 64 + 8 * seg;
            const float mu_r = mu[C0_R + hc], mu_k = mu[C0_K + hc], mu_v = mu[C0_V + hc], mu_w = mu[cw + d], mu_a = mu[C0_A + d];
            float xr[10], xk[10], xv[10], xw[10], xa[10];
            unsigned short qr_[10], qk_[10], qv_[10], qw_[10], qa_[10];
#pragma unroll
            for (int i = 0; i < 10; ++i) { const int n = n0 - 1 + i; const int nc = n < 0 ? 0 : (n > T - 1 ? T - 1 : n);
                const bf16_t* p = PROJ + chain_row(rbase, T, dir, nc) * L0_LD;
                qr_[i] = p[C0_R + hc]; qk_[i] = p[C0_K + hc]; qv_[i] = p[C0_V + hc]; qw_[i] = p[cw + d]; qa_[i] = p[C0_A + d]; }
            SCHED_BARRIER();
#pragma unroll
            for (int i = 0; i < 10; ++i) { const int n = n0 - 1 + i; const bool ok = n >= 0 && n <= T - 1; const float m = ok ? 1.f : 0.f;
                xr[i] = bf2f(qr_[i]) * m; xk[i] = bf2f(qk_[i]) * m; xv[i] = bf2f(qv_[i]) * m; xw[i] = bf2f(qw_[i]) * m; xa[i] = bf2f(qa_[i]) * m; }
#pragma unroll
            for (int e = 0; e < 8; ++e) { const int tt = 8 * seg + e;
                rr[e] = xr[e + 1] + mu_r * (0.5f * (xr[e] + xr[e + 2]) - xr[e + 1]); ks_[e] = xk[e + 1] + mu_k * (0.5f * (xk[e] + xk[e + 2]) - xk[e + 1]); vv[e] = xv[e + 1] + mu_v * (0.5f * (xv[e] + xv[e + 2]) - xv[e + 1]);
                AAK[tt * 72 + d] = (bf16_t)f2bf(tanhf_(xw[e + 1] + mu_w * (0.5f * (xw[e] + xw[e + 2]) - xw[e + 1]))); ARB[tt * 72 + d] = (bf16_t)f2bf(xa[e + 1] + mu_a * (0.5f * (xa[e] + xa[e + 2]) - xa[e + 1])); }
        }
        BAR_LDS();
        {
            const int tn = wave & 3;
#pragma unroll
            for (int t2 = 0; t2 < 2; ++t2) { const int tm = 2 * (wave >> 2) + t2; f32x4 aw = {0.f, 0.f, 0.f, 0.f}, aa = {0.f, 0.f, 0.f, 0.f};
#pragma unroll
                for (int ks = 0; ks < 2; ++ks) { aw = mfma16(ldfrag(AAK + (16 * tm + li) * 72 + 32 * ks + 8 * g), w2f[ks], aw); aa = mfma16(ldfrag(ARB + (16 * tm + li) * 72 + 32 * ks + 8 * g), a2f[ks], aa); }
#pragma unroll
                for (int r = 0; r < 4; ++r) { AAB[(16 * tm + 4 * g + r) * 68 + 16 * tn + li] = aw[r]; AKV[(16 * tm + 4 * g + r) * 68 + 16 * tn + li] = aa[r]; } }
        }
        BAR_LDS();
        float kk[8], bb[8], lw[8], cl[8];
        {
            const float w0 = a.in[dir ? I0_W0B : I0_W0F][hc], a0v = a.in[I0_A0][hc], kkc = a.in[I0_KK][hc], kac = a.in[I0_KA][hc], rkc = a.in[I0_RK][hc];
            float run = 0.f;
#pragma unroll
            for (int e = 0; e < 8; ++e) { const int tt = 8 * seg + e;
                lw[e] = -0.6065306597126334f * sigmoidf_(AAB[tt * 68 + d] + w0); const float av = sigmoidf_(AKV[tt * 68 + d] + a0v);
                const float kkp = ks_[e] * kkc; kk[e] = kkp * rsqf_(wave_sum_f(kkp * kkp) + 1e-6f);
                ks_[e] = ks_[e] * (1.f + (av - 1.f) * kac); bb[e] = kk[e] * av;
                const float cr = wave_sum_f(rr[e] * ks_[e] * rkc);
                if (dir == 0 && lane == 0) corr[chain_row(rbase, T, dir, c * 64 + tt) * 8 + h] = cr;
                run += lw[e]; cl[e] = run; }
            SEG[seg * 64 + d] = run;
        }
        BAR_LDS();
        {
            float off = 0.f, tot = 0.f;
#pragma unroll
            for (int s2 = 0; s2 < 8; ++s2) { const float sv = SEG[s2 * 64 + d]; tot += sv; off += (s2 < seg) ? sv : 0.f; }
            float kd[8], bd[8];
#pragma unroll
            for (int e = 0; e < 8; ++e) { const int tt = 8 * seg + e; const float lwi = off + cl[e], lwx = lwi - lw[e]; const float ei = __expf(-lwi), ed = __expf(tot - lwi);
                RT[tt * 72 + d] = (bf16_t)f2bf(rr[e] * __expf(lwi)); KKT[tt * 72 + d] = (bf16_t)f2bf(kk[e] * __expf(lwx)); BT[tt * 72 + d] = (bf16_t)f2bf(bb[e] * ei); KT[tt * 72 + d] = (bf16_t)f2bf(ks_[e] * ei);
                kd[e] = ks_[e] * ed; bd[e] = bb[e] * ed; }
            *(LAS u32x4*)(KDT + d * 72 + 8 * seg) = pack8(kd); *(LAS u32x4*)(BDT + d * 72 + 8 * seg) = pack8(bd); *(LAS u32x4*)(VT + d * 72 + 8 * seg) = pack8(vv);
            if (seg == 0) GL[d] = __expf(tot);
        }
        BAR_LDS();
#pragma unroll
        for (int q2 = 0; q2 < 2; ++q2) {
            const int idx = 2 * wave + q2, tm = idx >> 2, tn = idx & 3; f32x4 ab = {0.f, 0.f, 0.f, 0.f}, ak = ab, rb = ab, rk = ab;
            if (tn <= tm) {
#pragma unroll
                for (int ks = 0; ks < 2; ++ks) { const bf16x8 fa = ldfrag(KKT + (16 * tm + li) * 72 + 32 * ks + 8 * g), fr = ldfrag(RT + (16 * tm + li) * 72 + 32 * ks + 8 * g);
                    const bf16x8 fb = ldfrag(BT + (16 * tn + li) * 72 + 32 * ks + 8 * g), fk = ldfrag(KT + (16 * tn + li) * 72 + 32 * ks + 8 * g);
                    ab = mfma16(fa, fb, ab); ak = mfma16(fa, fk, ak); rb = mfma16(fr, fb, rb); rk = mfma16(fr, fk, rk); }
            }
#pragma unroll
            for (int r = 0; r < 4; ++r) { const int t = 16 * tm + 4 * g + r, s = 16 * tn + li; const bool st = s < t, in = s <= t;
                AAB[t * 68 + s] = st ? ab[r] : 0.f; AAK[t * 72 + s] = (bf16_t)f2bf(st ? ak[r] : 0.f); ARB[t * 72 + s] = (bf16_t)f2bf(in ? rb[r] : 0.f); ARK[t * 72 + s] = (bf16_t)f2bf(in ? rk[r] : 0.f); }
        }
        BAR_LDS();
#pragma unroll
        for (int q2 = 0; q2 < 2; ++q2) {
            const int idx = 2 * wave + q2, tm = idx >> 2, tn = idx & 3; f32x4 acc = {0.f, 0.f, 0.f, 0.f};
#pragma unroll
            for (int ks = 0; ks < 2; ++ks) acc = mfma16(ldfrag(AAK + (16 * tm + li) * 72 + 32 * ks + 8 * g), ldfrag(VT + (16 * tn + li) * 72 + 32 * ks + 8 * g), acc);
#pragma unroll
            for (int r = 0; r < 4; ++r) AKV[(16 * tm + 4 * g + r) * 68 + 16 * tn + li] = acc[r];
        }
        BAR_LDS();
        {
            const int col = tv >> 2, q = tv & 3, cl6 = col & 63; const bool first = col < 64;
            float x[16], rh[16];
#pragma unroll
            for (int m = 0; m < 4; ++m)
#pragma unroll
                for (int e = 0; e < 4; ++e) { const int t = 16 * m + 4 * q + e; const float r1 = bf2f(KKT[t * 72 + cl6]), r2 = AKV[t * 68 + cl6]; rh[4 * m + e] = first ? r1 : r2; }
            fwd_subst<4>(AAB, rh, x, q);
            BAR_LDS();
            if (first) {
#pragma unroll
                for (int m = 0; m < 4; ++m)
#pragma unroll
                    for (int e = 0; e < 4; ++e) KKT[(16 * m + 4 * q + e) * 72 + cl6] = (bf16_t)f2bf(x[4 * m + e]);
            } else {
#pragma unroll
                for (int m = 0; m < 4; ++m) *(LAS f32x4*)(AKV + cl6 * 68 + 16 * m + 4 * q) = (f32x4){x[4 * m], x[4 * m + 1], x[4 * m + 2], x[4 * m + 3]};
            }
        }
        BAR_LDS();
        if (wave < 4) {
            bf16x8 sb[2], vf[2];
#pragma unroll
            for (int ks = 0; ks < 2; ++ks) { sb[ks] = acc2b(S[2 * ks], S[2 * ks + 1]); vf[ks] = ldfrag(VT + (v0 + li) * 72 + 32 * ks + 8 * g); }
            f32x4 U[4];
#pragma unroll
            for (int mt = 0; mt < 4; ++mt) { f32x4 p = *(const LAS f32x4*)(AKV + (v0 + li) * 68 + 16 * mt + 4 * g);
#pragma unroll
                for (int ks = 0; ks < 2; ++ks) p = mfma16(ldperm(KKT + (16 * mt + li) * 72 + 32 * ks + 4 * g), sb[ks], p);
                U[mt] = -p; }
            bf16x8 ub[2];
#pragma unroll
            for (int k2 = 0; k2 < 2; ++k2) ub[k2] = acc2b(U[2 * k2], U[2 * k2 + 1]);
#pragma unroll
            for (int mt = 0; mt < 4; ++mt) { f32x4 o = {0.f, 0.f, 0.f, 0.f};
#pragma unroll
                for (int ks = 0; ks < 2; ++ks) { o = mfma16(ldperm(RT + (16 * mt + li) * 72 + 32 * ks + 4 * g), sb[ks], o); o = mfma16(ldperm(ARB + (16 * mt + li) * 72 + 32 * ks + 4 * g), ub[ks], o);
                    o = mfma16(ldfrag(ARK + (16 * mt + li) * 72 + 32 * ks + 8 * g), vf[ks], o); }
#pragma unroll
                for (int r = 0; r < 4; ++r) Oout[chain_row(rbase, T, dir, c * 64 + 16 * mt + 4 * g + r) * 512 + v0 + li] = (bf16_t)f2bf(o[r]); }
#pragma unroll
            for (int dt = 0; dt < 4; ++dt) { f32x4 acc = S[dt] * *(const LAS f32x4*)(GL + 16 * dt + 4 * g);
#pragma unroll
                for (int ks = 0; ks < 2; ++ks) { acc = mfma16(ldperm(BDT + (16 * dt + li) * 72 + 32 * ks + 4 * g), ub[ks], acc); acc = mfma16(ldfrag(KDT + (16 * dt + li) * 72 + 32 * ks + 8 * g), vf[ks], acc); }
                S[dt] = acc; }
        }
        pf_acc ^= pfv;
        BAR_LDS();
    }
    if (pf_acc == 0x9e3779b9u) GL[0] = 1.f;
    if (sout && wave < 4) {
        int sidx = (v0 + li0) * 64 + 4 * g0; OPAQUE(sidx);
#pragma unroll
        for (int dt = 0; dt < 4; ++dt) *(f32x4*)(sout + sidx + 16 * dt) = S[dt];
    }
}


constexpr int RWR_BYTES = 65536;
DEV void rwkv_prep_item(const Args& a, LAS unsigned char* lds, int tid, int lane_in, int wave, int T, int rbase, int h, int dir, int c, unsigned char* rec_in) {
    const BufRes rec = make_buf(rec_in);
    const int pfl = a.flags;
    if (pfl & 64) return;
    const bf16_t* PROJ = (const bf16_t*)(a.ws + WS_PROJ);
    LAS bf16_t* RT = (LAS bf16_t*)(lds + RW_RT);
    LAS bf16_t* KKT = (LAS bf16_t*)(lds + RW_KKT);
    LAS bf16_t* BT = (LAS bf16_t*)(lds + RW_BT);
    LAS bf16_t* KT = (LAS bf16_t*)(lds + RW_KT);
    LAS bf16_t* KDT = (LAS bf16_t*)(lds + RW_KDT);
    LAS bf16_t* BDT = (LAS bf16_t*)(lds + RW_BDT);
    LAS bf16_t* VT = (LAS bf16_t*)(lds + RW_VT);
    LAS float* AAB = (LAS float*)(lds + RW_AAB);
    LAS float* AKV = (LAS float*)(lds + RW_AKV);
    LAS bf16_t* AAK = (LAS bf16_t*)(lds + RW_AAK);
    LAS bf16_t* ARB = (LAS bf16_t*)(lds + RW_ARB);
    LAS bf16_t* ARK = (LAS bf16_t*)(lds + RW_ARK);
    LAS float* SEG = (LAS float*)(lds + RW_SEG);
    LAS float* GL = (LAS float*)(lds + RW_GL);
    const int seg = wave, cw = dir ? C0_WB : C0_WF;
    const float* mu = a.in[I0_MU];
    float* corr = (float*)(a.ws + WS_CORR);
    const int li0 = lane_in & 15, g0 = lane_in >> 4;
    bf16x8 w2f[2], a2f[2];
#if !defined(EMU)
    {
        const u32x4* tb = (const u32x4*)(a.ws + WS_LORA);
#pragma unroll
        for (int ks = 0; ks < 2; ++ks) { w2f[ks] = __builtin_bit_cast(bf16x8, tb[(size_t)((((dir ? 1 : 0) * 8 + h) * 4 + (wave & 3)) * 2 + ks) * 64 + lane_in]);
            a2f[ks] = __builtin_bit_cast(bf16x8, tb[(size_t)(((2 * 8 + h) * 4 + (wave & 3)) * 2 + ks) * 64 + lane_in]); }
    }
#else
    {
        const float* w2 = a.in[dir ? I0_W2B : I0_W2F]; const float* a2 = a.in[I0_A2]; const int dc = h * 64 + 16 * (wave & 3) + li0;
#pragma unroll
        for (int ks = 0; ks < 2; ++ks) { float tw[8], ta[8];
#pragma unroll
            for (int j = 0; j < 8; ++j) { tw[j] = w2[(32 * ks + 8 * g0 + j) * 512 + dc]; ta[j] = a2[(32 * ks + 8 * g0 + j) * 512 + dc]; }
            w2f[ks] = __builtin_bit_cast(bf16x8, pack8(tw)); a2f[ks] = __builtin_bit_cast(bf16x8, pack8(ta)); }
    }
#endif
    {
        int tv = tid; OPAQUE(tv);
        const int lane = tv & 63, li = lane & 15, g = lane >> 4, d = lane, hc = h * 64 + d;
        float rr[8], ks_[8], vv[8];
        {
            const int n0 = c * 64 + 8 * seg;
            const float mu_r = mu[C0_R + hc], mu_k = mu[C0_K + hc], mu_v = mu[C0_V + hc], mu_w = mu[cw + d], mu_a = mu[C0_A + d];
            float xr[10], xk[10], xv[10], xw[10], xa[10];
            unsigned short qr_[10], qk_[10], qv_[10], qw_[10], qa_[10];
#pragma unroll
            for (int i = 0; i < 10; ++i) { const int n = n0 - 1 + i; const int nc = n < 0 ? 0 : (n > T - 1 ? T - 1 : n);
                const bf16_t* p = PROJ + chain_row(rbase, T, dir, nc) * L0_LD;
                qr_[i] = p[C0_R + hc]; qk_[i] = p[C0_K + hc]; qv_[i] = p[C0_V + hc]; qw_[i] = p[cw + d]; qa_[i] = p[C0_A + d]; }
            SCHED_BARRIER();
#pragma unroll
            for (int i = 0; i < 10; ++i) { const int n = n0 - 1 + i; const bool ok = n >= 0 && n <= T - 1; const float m = ok ? 1.f : 0.f;
                xr[i] = bf2f(qr_[i]) * m; xk[i] = bf2f(qk_[i]) * m; xv[i] = bf2f(qv_[i]) * m; xw[i] = bf2f(qw_[i]) * m; xa[i] = bf2f(qa_[i]) * m; }
#pragma unroll
            for (int e = 0; e < 8; ++e) { const int tt = 8 * seg + e;
                rr[e] = xr[e + 1] + mu_r * (0.5f * (xr[e] + xr[e + 2]) - xr[e + 1]); ks_[e] = xk[e + 1] + mu_k * (0.5f * (xk[e] + xk[e + 2]) - xk[e + 1]); vv[e] = xv[e + 1] + mu_v * (0.5f * (xv[e] + xv[e + 2]) - xv[e + 1]);
                AAK[tt * 72 + d] = (bf16_t)f2bf(tanhf_(xw[e + 1] + mu_w * (0.5f * (xw[e] + xw[e + 2]) - xw[e + 1]))); ARB[tt * 72 + d] = (bf16_t)f2bf(xa[e + 1] + mu_a * (0.5f * (xa[e] + xa[e + 2]) - xa[e + 1])); }
        }
        BAR_LDS();
        {
            const int tn = wave & 3;
#pragma unroll
            for (int t2 = 0; t2 < 2; ++t2) { const int tm = 2 * (wave >> 2) + t2; f32x4 aw = {0.f, 0.f, 0.f, 0.f}, aa = {0.f, 0.f, 0.f, 0.f};
#pragma unroll
                for (int ks = 0; ks < 2; ++ks) { aw = mfma16(ldfrag(AAK + (16 * tm + li) * 72 + 32 * ks + 8 * g), w2f[ks], aw); aa = mfma16(ldfrag(ARB + (16 * tm + li) * 72 + 32 * ks + 8 * g), a2f[ks], aa); }
#pragma unroll
                for (int r = 0; r < 4; ++r) { AAB[(16 * tm + 4 * g + r) * 68 + 16 * tn + li] = aw[r]; AKV[(16 * tm + 4 * g + r) * 68 + 16 * tn + li] = aa[r]; } }
        }
        BAR_LDS();
        float kk[8], bb[8], lw[8], cl[8];
        {
            const float w0 = a.in[dir ? I0_W0B : I0_W0F][hc], a0v = a.in[I0_A0][hc], kkc = a.in[I0_KK][hc], kac = a.in[I0_KA][hc], rkc = a.in[I0_RK][hc];
            float run = 0.f;
#pragma unroll
            for (int e = 0; e < 8; ++e) { const int tt = 8 * seg + e;
                lw[e] = -0.6065306597126334f * sigmoidf_(AAB[tt * 68 + d] + w0); const float av = sigmoidf_(AKV[tt * 68 + d] + a0v);
                const float kkp = ks_[e] * kkc; kk[e] = kkp * rsqf_(wave_sum_f(kkp * kkp) + 1e-6f);
                ks_[e] = ks_[e] * (1.f + (av - 1.f) * kac); bb[e] = kk[e] * av;
                const float cr = wave_sum_f(rr[e] * ks_[e] * rkc);
                if (dir == 0 && lane == 0) corr[chain_row(rbase, T, dir, c * 64 + tt) * 8 + h] = cr;
                run += lw[e]; cl[e] = run; }
            SEG[seg * 64 + d] = run;
        }
        BAR_LDS();
        {
            float off = 0.f, tot = 0.f;
#pragma unroll
            for (int s2 = 0; s2 < 8; ++s2) { const float sv = SEG[s2 * 64 + d]; tot += sv; off += (s2 < seg) ? sv : 0.f; }
            float kd[8], bd[8];
#pragma unroll
            for (int e = 0; e < 8; ++e) { const int tt = 8 * seg + e; const float lwi = off + cl[e], lwx = lwi - lw[e]; const float ei = __expf(-lwi), ed = __expf(tot - lwi);
                RT[tt * 72 + d] = (bf16_t)f2bf(rr[e] * __expf(lwi)); KKT[tt * 72 + d] = (bf16_t)f2bf(kk[e] * __expf(lwx)); BT[tt * 72 + d] = (bf16_t)f2bf(bb[e] * ei); KT[tt * 72 + d] = (bf16_t)f2bf(ks_[e] * ei);
                kd[e] = ks_[e] * ed; bd[e] = bb[e] * ed; }
            *(LAS u32x4*)(KDT + d * 72 + 8 * seg) = pack8(kd); *(LAS u32x4*)(BDT + d * 72 + 8 * seg) = pack8(bd); *(LAS u32x4*)(VT + d * 72 + 8 * seg) = pack8(vv);
            if (seg == 0) GL[d] = __expf(tot);
        }
        BAR_LDS();
#pragma unroll
        for (int q2 = 0; q2 < 2; ++q2) {
            const int idx = 2 * wave + q2, tm = idx >> 2, tn = idx & 3; f32x4 ab = {0.f, 0.f, 0.f, 0.f}, ak = ab, rb = ab, rk = ab;
            if (tn <= tm) {
#pragma unroll
                for (int ks = 0; ks < 2; ++ks) { const bf16x8 fa = ldfrag(KKT + (16 * tm + li) * 72 + 32 * ks + 8 * g), fr = ldfrag(RT + (16 * tm + li) * 72 + 32 * ks + 8 * g);
                    const bf16x8 fb = ldfrag(BT + (16 * tn + li) * 72 + 32 * ks + 8 * g), fk = ldfrag(KT + (16 * tn + li) * 72 + 32 * ks + 8 * g);
                    ab = mfma16(fa, fb, ab); ak = mfma16(fa, fk, ak); rb = mfma16(fr, fb, rb); rk = mfma16(fr, fk, rk); }
            }
#pragma unroll
            for (int r = 0; r < 4; ++r) { const int t = 16 * tm + 4 * g + r, s = 16 * tn + li; const bool st = s < t, in = s <= t;
                AAB[t * 68 + s] = st ? ab[r] : 0.f; AAK[t * 72 + s] = (bf16_t)f2bf(st ? ak[r] : 0.f); ARB[t * 72 + s] = (bf16_t)f2bf(in ? rb[r] : 0.f); ARK[t * 72 + s] = (bf16_t)f2bf(in ? rk[r] : 0.f); }
        }
        BAR_LDS();
#pragma unroll
        for (int q2 = 0; q2 < 2; ++q2) {
            const int idx = 2 * wave + q2, tm = idx >> 2, tn = idx & 3; f32x4 acc = {0.f, 0.f, 0.f, 0.f};
#pragma unroll
            for (int ks = 0; ks < 2; ++ks) acc = mfma16(ldfrag(AAK + (16 * tm + li) * 72 + 32 * ks + 8 * g), ldfrag(VT + (16 * tn + li) * 72 + 32 * ks + 8 * g), acc);
#pragma unroll
            for (int r = 0; r < 4; ++r) AKV[(16 * tm + 4 * g + r) * 68 + 16 * tn + li] = acc[r];
            f32x4 ork = {0.f, 0.f, 0.f, 0.f}, skv = {0.f, 0.f, 0.f, 0.f};
#pragma unroll
            for (int ks = 0; ks < 2; ++ks) { const bf16x8 vb = ldfrag(VT + (16 * tn + li) * 72 + 32 * ks + 8 * g);
                ork = mfma16(ldfrag(ARK + (16 * tm + li) * 72 + 32 * ks + 8 * g), vb, ork); skv = mfma16(ldfrag(KDT + (16 * tm + li) * 72 + 32 * ks + 8 * g), vb, skv); }
            bst8(rec, 40960 + ((16 * tn + li) * 64 + 16 * tm + 4 * g) * 2, (u32x2){pk2(ork[0], ork[1]), pk2(ork[2], ork[3])});
            bst8(rec, 49152 + ((16 * tn + li) * 64 + 16 * tm + 4 * g) * 2, (u32x2){pk2(skv[0], skv[1]), pk2(skv[2], skv[3])});
        }
        {
            const int row = tv >> 3, cc = tv & 7; const f32x4 u0 = *(const LAS f32x4*)(AAB + row * 68 + 8 * cc), u1 = *(const LAS f32x4*)(AAB + row * 68 + 8 * cc + 4);
            const float u8[8] = {u0[0], u0[1], u0[2], u0[3], u1[0], u1[1], u1[2], u1[3]}; *(LAS u32x4*)(BT + row * 72 + 8 * cc) = pack8(u8);
        }
        BAR_LDS();
        {
            LAS bf16_t* ABF = BT; LAS bf16_t* DBF = KT;
            if (wave < 4) { if (!(pfl & 128)) diag16_inverse<40>(AAB, DBF, wave, lane); }
            else {
                const int tq = tv - 256;
#pragma unroll
                for (int jj = 0; jj < 2; ++jj) { const int l = tq + 256 * jj, row = l >> 3, cc = l & 7;
                    bst16(rec, 0 * 8192 + l * 16, *(const LAS u32x4*)(RT + row * 72 + 8 * cc));
                    bst16(rec, 2 * 8192 + l * 16, *(const LAS u32x4*)(ARB + row * 72 + 8 * cc));
                    bst16(rec, 3 * 8192 + l * 16, *(const LAS u32x4*)(BDT + row * 72 + 8 * cc)); }
                if (tq < 16) bst16(rec, 7 * 8192 + tq * 16, __builtin_bit_cast(u32x4, *(const LAS f32x4*)(GL + 4 * tq)));
            }
            BAR_LDS();
            f32x4 X[4];
            if (wave < 4) {
                const int col = 16 * wave + li;
                block_solve16<40>(ABF, DBF, [&](int I) { const LAS bf16_t* q_ = KKT + (16 * I + 4 * g) * 72 + col; return (f32x4){bf2f(q_[0]), bf2f(q_[72]), bf2f(q_[144]), bf2f(q_[216])}; }, X, li, g);
#pragma unroll
                for (int I = 0; I < 4; ++I)
#pragma unroll
                    for (int r = 0; r < 4; ++r) KKT[(16 * I + 4 * g + r) * 72 + col] = (bf16_t)f2bf(X[I][r]);
            } else {
                const int col = 16 * (wave - 4) + li;
                block_solve16<40>(ABF, DBF, [&](int I) { const LAS float* q_ = AKV + (16 * I + 4 * g) * 68 + col; return (f32x4){q_[0], q_[68], q_[136], q_[204]}; }, X, li, g);
#pragma unroll
                for (int I = 0; I < 4; ++I) bst8(rec, 4 * 8192 + (col * 64 + 16 * I + 4 * g) * 2, (u32x2){pk2(X[I][0], X[I][1]), pk2(X[I][2], X[I][3])});
            }
        }
        BAR_LDS();
        bst16(rec, 1 * 8192 + tv * 16, *(const LAS u32x4*)(KKT + (tv >> 3) * 72 + 8 * (tv & 7)));
    }
    BAR_LDS();
}

constexpr int RWE_RT = 0, RWE_WM = 9216, RWE_ARB = 18432, RWE_BDT = 27648, RWE_ULT = 36864, RWE_ORKT = 46080, RWE_SKVT = 55296, RWE_GL = 64512, RWE_END = 64768;
DEV f32x4 ld4bf(const LAS bf16_t* p) { const u32x2 v = *(const LAS u32x2*)p; return (f32x4){__uint_as_float(v.x << 16), __uint_as_float(v.x & 0xffff0000u), __uint_as_float(v.y << 16), __uint_as_float(v.y & 0xffff0000u)}; }
DEV void rwkv_esteps(const Args& a, LAS unsigned char* lds, int tid_in, int lane_in, int wave, int T, int rbase, int h, int dir, int c0, int n, const unsigned char* recs_in, f32x4 (&S)[4]) {
    const BufRes recs = make_buf(recs_in);
    int tid = tid_in; OPAQUE(tid); const int lane = tid & 63;
    LAS bf16_t* ERT = (LAS bf16_t*)(lds + RWE_RT); LAS bf16_t* EWM = (LAS bf16_t*)(lds + RWE_WM); LAS bf16_t* EARB = (LAS bf16_t*)(lds + RWE_ARB); LAS bf16_t* EBDT = (LAS bf16_t*)(lds + RWE_BDT);
    LAS bf16_t* EULT = (LAS bf16_t*)(lds + RWE_ULT); LAS bf16_t* EORKT = (LAS bf16_t*)(lds + RWE_ORKT); LAS bf16_t* ESKVT = (LAS bf16_t*)(lds + RWE_SKVT); LAS float* EGL = (LAS float*)(lds + RWE_GL);
    bf16_t* Oout = (bf16_t*)(a.ws + WS_XB) + (dir ? (size_t)MROWS * 512 : 0) + h * 64;
    const int li = lane & 15, g = lane >> 4, v0 = 16 * (wave & 3);
    u32x4 rg[8], rh[8];
#pragma unroll
    for (int j = 0; j < 8; ++j) { rg[j] = bld16(recs, j * 8192 + tid * 16, 0); rh[j] = bld16(recs, j * 8192 + tid * 16, (n > 1 ? 1 : 0) * RWR_BYTES); }
    for (int i = 0; i < n; ++i) {
        {
            const int row = tid >> 3, cc = tid & 7;
#pragma unroll
            for (int j = 0; j < 7; ++j) *(LAS u32x4*)(lds + j * 9216 + row * 144 + cc * 16) = rg[j];
            if (tid < 16) *(LAS u32x4*)(lds + RWE_GL + tid * 16) = rg[7];
        }
        BAR_LDS();
        {
            const unsigned nx = (unsigned)(i + 2 < n ? i + 2 : n - 1) * RWR_BYTES;
#pragma unroll
            for (int j = 0; j < 8; ++j) { rg[j] = rh[j]; rh[j] = bld16(recs, j * 8192 + tid * 16, nx); }
        }
        if (wave < 4) {
            bf16x8 sb[2];
#pragma unroll
            for (int ks = 0; ks < 2; ++ks) sb[ks] = acc2b(S[2 * ks], S[2 * ks + 1]);
            f32x4 U[4];
#pragma unroll
            for (int mt = 0; mt < 4; ++mt) { f32x4 p = ld4bf(EULT + (v0 + li) * 72 + 16 * mt + 4 * g);
#pragma unroll
                for (int ks = 0; ks < 2; ++ks) p = mfma16(ldperm(EWM + (16 * mt + li) * 72 + 32 * ks + 4 * g), sb[ks], p);
                U[mt] = -p; }
            bf16x8 ub[2];
#pragma unroll
            for (int k2 = 0; k2 < 2; ++k2) ub[k2] = acc2b(U[2 * k2], U[2 * k2 + 1]);
#pragma unroll
            for (int mt = 0; mt < 4; ++mt) { f32x4 o = ld4bf(EORKT + (v0 + li) * 72 + 16 * mt + 4 * g);
#pragma unroll
                for (int ks = 0; ks < 2; ++ks) { o = mfma16(ldperm(ERT + (16 * mt + li) * 72 + 32 * ks + 4 * g), sb[ks], o); o = mfma16(ldperm(EARB + (16 * mt + li) * 72 + 32 * ks + 4 * g), ub[ks], o); }
#pragma unroll
                for (int r = 0; r < 4; ++r) Oout[chain_row(rbase, T, dir, (c0 + i) * 64 + 16 * mt + 4 * g + r) * 512 + v0 + li] = (bf16_t)f2bf(o[r]); }
#pragma unroll
            for (int dt = 0; dt < 4; ++dt) { f32x4 acc = S[dt] * *(const LAS f32x4*)(EGL + 16 * dt + 4 * g) + ld4bf(ESKVT + (v0 + li) * 72 + 16 * dt + 4 * g);
#pragma unroll
                for (int ks = 0; ks < 2; ++ks) acc = mfma16(ldperm(EBDT + (16 * dt + li) * 72 + 32 * ks + 4 * g), ub[ks], acc);
                S[dt] = acc; }
        }
        BAR_LDS();
    }
}

constexpr int GLR_BYTES = 49152;
DEV void gla_prep_item(const Args& a, LAS unsigned char* lds, int tid_in, int lane_in, int wave, int T, int rbase, int h, int dir, int c, unsigned char* rec_in) {
    const BufRes rec = make_buf(rec_in);
    if (a.flags & 4096) return;
    int tid = tid_in; OPAQUE(tid); const int lane = tid & 63;
    const bf16_t* PROJ = (const bf16_t*)(a.ws + WS_PROJ);
    LAS bf16_t* QT = (LAS bf16_t*)(lds + GL_QT);
    LAS bf16_t* KT = (LAS bf16_t*)(lds + GL_KT);
    LAS bf16_t* KD = (LAS bf16_t*)(lds + GL_KD);
    LAS bf16_t* VT = (LAS bf16_t*)(lds + GL_VT);
    LAS bf16_t* ATT = (LAS bf16_t*)(lds + GL_ATT);
    LAS float* DEC = (LAS float*)(lds + GL_DEC);
    LAS float* SEG = (LAS float*)(lds + GL_SEG);
    LAS float* GIN = (LAS float*)(lds + GL_GIN);
    const int d = lane, seg = wave, hc = h * 64 + d;
    const float* g2 = a.in[dir ? I1_G2B : I1_G2F];
    float g2c[16];
#pragma unroll
    for (int i = 0; i < 16; ++i) g2c[i] = g2[i * 256 + hc];
    const float gb = a.in[dir ? I1_GBB : I1_GBF][hc];
    const int cgin = dir ? C1_GB : C1_GF;
    const int li = lane & 15, g = lane >> 4;
    const int ltt = tid >> 3, lp = tid & 7;
    unsigned graw; u32x4 vraw0, vraw1; unsigned short qraw[8], kraw[8];
    { const bf16_t* pr_ = PROJ + chain_row(rbase, T, dir, c * 64 + ltt) * L1_LD; graw = *(const unsigned*)(pr_ + cgin + 2 * lp);
      vraw0 = *(const u32x4*)(pr_ + C1_GV + h * 128 + 16 * lp); vraw1 = *(const u32x4*)(pr_ + C1_GV + h * 128 + 16 * lp + 8);
#pragma unroll
      for (int e = 0; e < 8; ++e) { const bf16_t* pq_ = PROJ + chain_row(rbase, T, dir, c * 64 + 8 * seg + e) * L1_LD; qraw[e] = pq_[C1_GQ + hc]; kraw[e] = pq_[C1_GK + hc]; } }
    {
        GIN[ltt * 16 + 2 * lp] = bf2f(graw & 0xffffu); GIN[ltt * 16 + 2 * lp + 1] = bf2f(graw >> 16);
        {
            const unsigned vw[8] = {vraw0.x, vraw0.y, vraw0.z, vraw0.w, vraw1.x, vraw1.y, vraw1.z, vraw1.w};
#pragma unroll
            for (int jj = 0; jj < 8; ++jj) { VT[(16 * lp + 2 * jj) * 72 + ltt] = (bf16_t)(vw[jj] & 0xffffu); VT[(16 * lp + 2 * jj + 1) * 72 + ltt] = (bf16_t)(vw[jj] >> 16); }
        }
        float qf[8], kf[8];
#pragma unroll
        for (int e = 0; e < 8; ++e) { qf[e] = bf2f(qraw[e]); kf[e] = bf2f(kraw[e]); }
        BAR_LDS();
        float cl[8];
        {
            float run = 0.f;
#pragma unroll
            for (int e = 0; e < 8; ++e) {
                const LAS f32x4* g4 = (const LAS f32x4*)(GIN + (8 * seg + e) * 16); float x = gb;
#pragma unroll
                for (int i = 0; i < 4; ++i) { const f32x4 y = g4[i]; x += y[0] * g2c[4 * i] + y[1] * g2c[4 * i + 1] + y[2] * g2c[4 * i + 2] + y[3] * g2c[4 * i + 3]; }
                run += log_sigmoidf_(x) * (1.f / 16.f); cl[e] = run;
            }
            SEG[seg * 64 + d] = run;
        }
        BAR_LDS();
        {
            float off = 0.f, tot = 0.f;
#pragma unroll
            for (int s2 = 0; s2 < 8; ++s2) { const float sv = SEG[s2 * 64 + d]; tot += sv; off += (s2 < seg) ? sv : 0.f; }
            float kd[8];
#pragma unroll
            for (int e = 0; e < 8; ++e) { const float cum = off + cl[e]; const int tt = 8 * seg + e; const float eq = __expf(cum);
                QT[tt * 72 + d] = (bf16_t)f2bf(qf[e] * 0.125f * eq); KT[tt * 72 + d] = (bf16_t)f2bf(kf[e] * __expf(-cum)); kd[e] = kf[e] * __expf(tot - cum); }
            *(LAS u32x4*)(KD + d * 72 + 8 * seg) = pack8(kd);
            if (seg == 0) DEC[d] = __expf(tot);
        }
        BAR_LDS();
#pragma unroll
        for (int q2 = 0; q2 < 2; ++q2) {
            const int idx = 2 * wave + q2, tm = idx >> 2, tn = idx & 3; f32x4 acc = {0.f, 0.f, 0.f, 0.f};
            if (tn <= tm) {
#pragma unroll
                for (int ks = 0; ks < 2; ++ks) acc = mfma16(ldfrag(QT + (16 * tm + li) * 72 + 32 * ks + 8 * g), ldfrag(KT + (16 * tn + li) * 72 + 32 * ks + 8 * g), acc);
            }
#pragma unroll
            for (int r = 0; r < 4; ++r) { const int t = 16 * tm + 4 * g + r, s = 16 * tn + li; ATT[t * 72 + s] = (bf16_t)f2bf((s <= t) ? acc[r] : 0.f); }
        }
        BAR_LDS();
#pragma unroll
        for (int q4 = 0; q4 < 4; ++q4) {
            const int idx = 4 * wave + q4, tm = idx >> 3, tn = idx & 7; f32x4 oa = {0.f, 0.f, 0.f, 0.f}, sk = {0.f, 0.f, 0.f, 0.f};
#pragma unroll
            for (int ks = 0; ks < 2; ++ks) { const bf16x8 vb = ldfrag(VT + (16 * tn + li) * 72 + 32 * ks + 8 * g);
                oa = mfma16(ldfrag(ATT + (16 * tm + li) * 72 + 32 * ks + 8 * g), vb, oa); sk = mfma16(ldfrag(KD + (16 * tm + li) * 72 + 32 * ks + 8 * g), vb, sk); }
            bst8(rec, 8192 + ((16 * tn + li) * 64 + 16 * tm + 4 * g) * 2, (u32x2){pk2(oa[0], oa[1]), pk2(oa[2], oa[3])});
            bst8(rec, 24576 + ((16 * tn + li) * 64 + 16 * tm + 4 * g) * 2, (u32x2){pk2(sk[0], sk[1]), pk2(sk[2], sk[3])});
        }
        bst16(rec, tid * 16, *(const LAS u32x4*)(QT + (tid >> 3) * 72 + 8 * (tid & 7)));
        if (tid < 16) bst16(rec, 40960 + tid * 16, __builtin_bit_cast(u32x4, *(const LAS f32x4*)(DEC + 4 * tid)));
    }
    BAR_LDS();
}
constexpr int GLE_QT = 0, GLE_OAVT = 9216, GLE_SKVT = 27648, GLE_DEC = 46080, GLE_END = 46336;
DEV void gla_esteps(const Args& a, LAS unsigned char* lds, int tid_in, int lane_in, int wave, int T, int rbase, int h, int dir, int c0, int n, int acc_from, const unsigned char* recs_in, f32x4 (&S)[8]) {
    const BufRes recs = make_buf(recs_in);
    int tid = tid_in; OPAQUE(tid); const int lane = tid & 63;
    LAS bf16_t* EQT = (LAS bf16_t*)(lds + GLE_QT); LAS bf16_t* EOAVT = (LAS bf16_t*)(lds + GLE_OAVT); LAS bf16_t* ESKVT = (LAS bf16_t*)(lds + GLE_SKVT); LAS float* EDEC = (LAS float*)(lds + GLE_DEC);
    bf16_t* O4 = (bf16_t*)(a.ws + WS_XA) + h * 128;
    const int li = lane & 15, g = lane >> 4, v0 = 16 * wave;
    u32x4 rg[6], rh[6];
#pragma unroll
    for (int j = 0; j < 6; ++j) { rg[j] = bld16(recs, j * 8192 + tid * 16, 0); rh[j] = bld16(recs, j * 8192 + tid * 16, (n > 1 ? 1 : 0) * GLR_BYTES); }
    for (int i = 0; i < n; ++i) {
        {
            const int row = tid >> 3, cc = tid & 7;
            *(LAS u32x4*)(lds + GLE_QT + row * 144 + cc * 16) = rg[0];
            *(LAS u32x4*)(lds + GLE_OAVT + row * 144 + cc * 16) = rg[1]; *(LAS u32x4*)(lds + GLE_OAVT + (row + 64) * 144 + cc * 16) = rg[2];
            *(LAS u32x4*)(lds + GLE_SKVT + row * 144 + cc * 16) = rg[3]; *(LAS u32x4*)(lds + GLE_SKVT + (row + 64) * 144 + cc * 16) = rg[4];
            if (tid < 16) *(LAS u32x4*)(lds + GLE_DEC + tid * 16) = rg[5];
        }
        BAR_LDS();
        {
            const unsigned nx = (unsigned)(i + 2 < n ? i + 2 : n - 1) * GLR_BYTES;
#pragma unroll
            for (int j = 0; j < 6; ++j) { rg[j] = rh[j]; rh[j] = bld16(recs, j * 8192 + tid * 16, nx); }
        }
        {
            const bool accum = (c0 + i) >= acc_from;
            unsigned short pv[4][4];
#pragma unroll
            for (int mt = 0; mt < 4; ++mt)
#pragma unroll
                for (int r = 0; r < 4; ++r) pv[mt][r] = O4[chain_row(rbase, T, dir, (c0 + i) * 64 + 16 * mt + 4 * g + r) * 1024 + v0 + li];
            bf16x8 sb[2];
#pragma unroll
            for (int ks = 0; ks < 2; ++ks) sb[ks] = acc2b(S[2 * ks], S[2 * ks + 1]);
#pragma unroll
            for (int mt = 0; mt < 4; ++mt) { f32x4 o = ld4bf(EOAVT + (v0 + li) * 72 + 16 * mt + 4 * g);
#pragma unroll
                for (int ks = 0; ks < 2; ++ks) o = mfma16(ldperm(EQT + (16 * mt + li) * 72 + 32 * ks + 4 * g), sb[ks], o);
#pragma unroll
                for (int r = 0; r < 4; ++r) { bf16_t* po = O4 + chain_row(rbase, T, dir, (c0 + i) * 64 + 16 * mt + 4 * g + r) * 1024 + v0 + li; const float prev = bf2f(pv[mt][r]); *po = (bf16_t)f2bf(accum ? o[r] + prev : o[r]); } }
#pragma unroll
            for (int dt = 0; dt < 4; ++dt) S[dt] = S[dt] * *(const LAS f32x4*)(EDEC + 16 * dt + 4 * g) + ld4bf(ESKVT + (v0 + li) * 72 + 16 * dt + 4 * g);
        }
        BAR_LDS();
    }
}

constexpr int GDR_BYTES = 81920;
DEV void gdn_prep_item(const Args& a, LAS unsigned char* lds, int tid, int lane_in, int wave, int T, int rbase, int h, int dir, int c, unsigned char* rec_in) {
    const BufRes rec = make_buf(rec_in);
    const int pfl = a.flags;
    if (pfl & 1024) return;
    const bf16_t* PROJ = (const bf16_t*)(a.ws + WS_PROJ);
    LAS bf16_t* Q = (LAS bf16_t*)(lds + GD_Q);
    LAS bf16_t* K = (LAS bf16_t*)(lds + GD_K);
    LAS bf16_t* V = (LAS bf16_t*)(lds + GD_V);
    LAS float* U0T = (LAS float*)(lds + GD_U0T);
    LAS bf16_t* KT = (LAS bf16_t*)(lds + GD_KT);
    LAS bf16_t* W = (LAS bf16_t*)(lds + GD_W);
    LAS bf16_t* AQK = (LAS bf16_t*)(lds + GD_AQK);
    LAS float* A = (LAS float*)(lds + GD_A);
    LAS float* SC = (LAS float*)(lds + GD_SC);
    LAS float* LOGA = SC, *BETA = SC + 64, *GC = SC + 128, *GAM = SC + 192, *EE = SC + 256, *BG = SC + 320, *GLs = SC + 384;
    LAS float* CW = (LAS float*)(lds + GD_CW);
    LAS bf16_t* ABF = (LAS bf16_t*)(lds + GD_END);
    LAS bf16_t* DBF = (LAS bf16_t*)(lds + GD_CW);
    const float nA = -__expf(a.in[dir ? I1_ALB : I1_ALF][h]), dtb = a.in[dir ? I1_DTB : I1_DTF][h];
    const int ca = dir ? C1_AB : C1_AF;
    for (int u = tid; u < 3 * 384; u += 512) { const int tap = u / 384, rem = u % 384, arr = rem >> 7, dd = rem & 127; CW[u] = a.in[I1_CONV][tap * 1536 + arr * 512 + h * 128 + dd]; }
    BAR_LDS();
    {
        int tv = tid; OPAQUE(tv);
        const int lane = tv & 63, li = lane & 15, g = lane >> 4, tt = tv >> 3, part = tv & 7;
        {
            const size_t row = chain_row(rbase, T, dir, c * 64 + tt); const int tact = (int)(row - rbase); const bool hp = tact > 0, hn = tact < T - 1;
            const bf16_t* pc = PROJ + row * L1_LD + C1_DQKV + h * 128 + 16 * part;
            const int op = hp ? -L1_LD : 0, on = hn ? L1_LD : 0; const float mp = hp ? 1.f : 0.f, mn = hn ? 1.f : 0.f;
            u32x4 ra[2][3], rb[2][3];
#define GDN_LD(dst, arr) do { _Pragma("unroll") for (int hf = 0; hf < 2; ++hf) { const bf16_t* p_ = pc + (arr) * 512 + 8 * hf; dst[hf][0] = *(const u32x4*)(p_ + op); dst[hf][1] = *(const u32x4*)p_; dst[hf][2] = *(const u32x4*)(p_ + on); } } while (0)
#define GDN_CONV(y, src, arr) do { _Pragma("unroll") for (int hf = 0; hf < 2; ++hf) { float cur[8], prv[8], nxt[8]; unpack8(src[hf][0], prv); unpack8(src[hf][1], cur); unpack8(src[hf][2], nxt); \
                _Pragma("unroll") for (int e4 = 0; e4 < 2; ++e4) { const int cb = (arr) * 128 + 16 * part + 8 * hf + 4 * e4; \
                    const f32x4 w0 = *(const LAS f32x4*)(CW + cb) * mp, w1 = *(const LAS f32x4*)(CW + 384 + cb), w2 = *(const LAS f32x4*)(CW + 768 + cb) * mn; \
                    _Pragma("unroll") for (int e = 0; e < 4; ++e) y[8 * hf + 4 * e4 + e] = siluf_(w0[e] * prv[4 * e4 + e] + w1[e] * cur[4 * e4 + e] + w2[e] * nxt[4 * e4 + e]); } } } while (0)
#define GDN_ST(dst, y) do { _Pragma("unroll") for (int hf = 0; hf < 2; ++hf) { float t8[8]; _Pragma("unroll") for (int e = 0; e < 8; ++e) t8[e] = y[8 * hf + e]; *(LAS u32x4*)(dst + tt * 136 + 16 * part + 8 * hf) = pack8(t8); } } while (0)
            GDN_LD(ra, 0); GDN_LD(rb, 1);
            SCHED_BARRIER();
            {
                float y[16]; GDN_CONV(y, ra, 0); float sq = 0.f;
#pragma unroll
                for (int e = 0; e < 16; ++e) sq += y[e] * y[e];
                const float qn = rsqf_(sum8(sq) + 1e-6f) * 0.08838834764831845f;
#pragma unroll
                for (int e = 0; e < 16; ++e) y[e] *= qn;
                GDN_ST(Q, y);
            }
            SCHED_BARRIER();
            GDN_LD(ra, 2);
            SCHED_BARRIER();
            {
                float y[16]; GDN_CONV(y, rb, 1); float sk = 0.f;
#pragma unroll
                for (int e = 0; e < 16; ++e) sk += y[e] * y[e];
                const float kn = rsqf_(sum8(sk) + 1e-6f);
#pragma unroll
                for (int e = 0; e < 16; ++e) y[e] *= kn;
                GDN_ST(K, y);
#pragma unroll
                for (int e = 0; e < 16; ++e) KT[(16 * part + e) * 72 + tt] = (bf16_t)f2bf(y[e]);
            }
            SCHED_BARRIER();
            {
                float y[16]; GDN_CONV(y, ra, 2); GDN_ST(V, y);
            }
#undef GDN_LD
#undef GDN_CONV
#undef GDN_ST
            if (part == 0) { const bf16_t* ps = PROJ + row * L1_LD; LOGA[tt] = nA * softplusf_(bf2f(ps[ca + h]) + dtb); BETA[tt] = sigmoidf_(bf2f(ps[C1_BETA + h])); }
        }
        BAR_LDS();
        if (wave == 0) {
            float x = LOGA[lane];
#pragma unroll
            for (int off = 1; off < 64; off <<= 1) { const float y2 = __shfl_up(x, off); x += (lane >= off) ? y2 : 0.f; }
            const float gl = __shfl(x, 63);
            GC[lane] = x; const float gm = __expf(x); GAM[lane] = gm; EE[lane] = __expf(gl - x); BG[lane] = BETA[lane] * gm;
            if (lane == 63) GLs[0] = __expf(gl);
        }
        BAR_LDS();
#pragma unroll
        for (int q2 = 0; q2 < 2; ++q2) {
            const int idx = 2 * wave + q2, tm = idx >> 2, tn = idx & 3; f32x4 ak = {0.f, 0.f, 0.f, 0.f}, aq = {0.f, 0.f, 0.f, 0.f};
            if (tn <= tm) {
#pragma unroll
                for (int ks = 0; ks < 4; ++ks) { const bf16x8 kb = ldfrag(K + (16 * tn + li) * 136 + 32 * ks + 8 * g);
                    ak = mfma16(ldfrag(K + (16 * tm + li) * 136 + 32 * ks + 8 * g), kb, ak); aq = mfma16(ldfrag(Q + (16 * tm + li) * 136 + 32 * ks + 8 * g), kb, aq); }
            }
            const int s = 16 * tn + li; const float gs = GC[s];
#pragma unroll
            for (int r = 0; r < 4; ++r) { const int t = 16 * tm + 4 * g + r; const float dec = __expf(fminf(GC[t] - gs, 0.f));
                const float av_ = (s < t) ? BETA[t] * dec * ak[r] : 0.f; A[t * 68 + s] = av_; ABF[t * 72 + s] = (bf16_t)f2bf(av_); AQK[t * 72 + s] = (bf16_t)f2bf((s <= t) ? dec * aq[r] : 0.f); }
        }
        BAR_LDS();
        {
            if (wave < 4) { if (!(pfl & 2048)) diag16_inverse<36>(A, DBF, wave, lane); }
            else {
                const int tq = tv - 256;
#pragma unroll
                for (int jj = 0; jj < 4; ++jj) { const int l = tq + 256 * jj;
                    bst16(rec, 16384 + l * 16, *(const LAS u32x4*)(Q + (l >> 4) * 136 + 8 * (l & 15)));
                    bst16(rec, 32768 + l * 16, *(const LAS u32x4*)(KT + (l >> 3) * 72 + 8 * (l & 7))); }
#pragma unroll
                for (int jj = 0; jj < 2; ++jj) { const int l = tq + 256 * jj; bst16(rec, 65536 + l * 16, *(const LAS u32x4*)(AQK + (l >> 3) * 72 + 8 * (l & 7))); }
                if (tq < 16) bst16(rec, 73728 + tq * 16, __builtin_bit_cast(u32x4, *(const LAS f32x4*)(GAM + 4 * tq)));
                else if (tq < 32) bst16(rec, 73728 + tq * 16, __builtin_bit_cast(u32x4, *(const LAS f32x4*)(EE + 4 * (tq - 16))));
                else if (tq == 32) bst16(rec, 73728 + 512, __builtin_bit_cast(u32x4, (f32x4){GLs[0], 0.f, 0.f, 0.f}));
            }
            BAR_LDS();
            const int col = 16 * wave + li; f32x4 X[4];
            block_solve16<36>(ABF, DBF, [&](int I) { const LAS bf16_t* q_ = K + (16 * I + 4 * g) * 136 + col; const f32x4 sc = *(const LAS f32x4*)(BG + 16 * I + 4 * g);
                return (f32x4){sc[0] * bf2f(q_[0]), sc[1] * bf2f(q_[136]), sc[2] * bf2f(q_[272]), sc[3] * bf2f(q_[408])}; }, X, li, g);
#pragma unroll
            for (int I = 0; I < 4; ++I)
#pragma unroll
                for (int r = 0; r < 4; ++r) W[(16 * I + 4 * g + r) * 136 + col] = (bf16_t)f2bf(X[I][r]);
            block_solve16<36>(ABF, DBF, [&](int I) { const LAS bf16_t* q_ = V + (16 * I + 4 * g) * 136 + col; const f32x4 sc = *(const LAS f32x4*)(BETA + 16 * I + 4 * g);
                return (f32x4){sc[0] * bf2f(q_[0]), sc[1] * bf2f(q_[136]), sc[2] * bf2f(q_[272]), sc[3] * bf2f(q_[408])}; }, X, li, g);
#pragma unroll
            for (int I = 0; I < 4; ++I) bst8(rec, 49152 + (col * 64 + 16 * I + 4 * g) * 2, (u32x2){pk2(X[I][0], X[I][1]), pk2(X[I][2], X[I][3])});
        }
        BAR_LDS();
#pragma unroll
        for (int jj = 0; jj < 2; ++jj) { const int l = tv + 512 * jj; bst16(rec, l * 16, *(const LAS u32x4*)(W + (l >> 4) * 136 + 8 * (l & 15))); }
    }
    BAR_LDS();
}
constexpr int GDE_W = 0, GDE_Q = 17408, GDE_KT = 34816, GDE_AQK = 53248, GDE_SC = 62464, GDE_IMG = 63488, GDE_END = 2 * GDE_IMG;
DEV void gdn_esteps(const Args& a, LAS unsigned char* lds, int tid_in, int lane_in, int wave, int T, int rbase, int h, int dir, int c0, int n, int acc_from, const unsigned char* recs_in, f32x4 (&S)[8]) {
    const BufRes recs = make_buf(recs_in);
    int tid = tid_in; OPAQUE(tid); const int lane = tid & 63;
    bf16_t* O4 = (bf16_t*)(a.ws + WS_XA) + 512 + h * 128;
    const int li = lane & 15, g = lane >> 4, v0 = 16 * wave;
    const int u0off = 49152 + ((v0 + li) * 64 + 4 * g) * 2;
    u32x4 rg[8]; u32x2 u0n[4];
#define GDE_LOAD(k) do { const unsigned so_ = (unsigned)(k) * GDR_BYTES; _Pragma("unroll") for (int j = 0; j < 6; ++j) rg[j] = bld16(recs, j * 8192 + tid * 16, so_); \
        rg[6] = bld16(recs, 65536 + tid * 16, so_); rg[7] = bld16(recs, 73728 + (tid < 33 ? tid : 0) * 16, so_); } while (0)
#define GDE_LOADU(k) do { const unsigned so_ = (unsigned)(k) * GDR_BYTES; _Pragma("unroll") for (int mt = 0; mt < 4; ++mt) u0n[mt] = bld8(recs, u0off + mt * 32, so_); } while (0)
#define GDE_STAGE(img) do { LAS unsigned char* im_ = (img); _Pragma("unroll") for (int j = 0; j < 2; ++j) { const int l = tid + 512 * j; \
        *(LAS u32x4*)(im_ + GDE_W + (l >> 4) * 272 + (l & 15) * 16) = rg[j]; *(LAS u32x4*)(im_ + GDE_Q + (l >> 4) * 272 + (l & 15) * 16) = rg[2 + j]; \
        *(LAS u32x4*)(im_ + GDE_KT + (l >> 3) * 144 + (l & 7) * 16) = rg[4 + j]; } \
        *(LAS u32x4*)(im_ + GDE_AQK + (tid >> 3) * 144 + (tid & 7) * 16) = rg[6]; if (tid < 33) *(LAS u32x4*)(im_ + GDE_SC + tid * 16) = rg[7]; } while (0)
    GDE_LOAD(0); GDE_LOADU(0);
    GDE_STAGE(lds);
    BAR_LDS();
    GDE_LOAD(n > 1 ? 1 : 0);
    for (int i = 0; i < n; ++i) {
        LAS unsigned char* im = lds + (i & 1) * GDE_IMG;
        LAS bf16_t* EW = (LAS bf16_t*)(im + GDE_W); LAS bf16_t* EQ = (LAS bf16_t*)(im + GDE_Q); LAS bf16_t* EKT = (LAS bf16_t*)(im + GDE_KT);
        LAS bf16_t* EAQK = (LAS bf16_t*)(im + GDE_AQK); LAS float* EGAM = (LAS float*)(im + GDE_SC); LAS float* EEE = EGAM + 64; LAS float* EGL = EGAM + 128;
        {
            const bool accum = (c0 + i) >= acc_from;
            unsigned short pv[4][4];
#pragma unroll
            for (int mt = 0; mt < 4; ++mt)
#pragma unroll
                for (int r = 0; r < 4; ++r) pv[mt][r] = O4[chain_row(rbase, T, dir, (c0 + i) * 64 + 16 * mt + 4 * g + r) * 1024 + v0 + li];
            const LAS bf16_t* pW = EW + li * 136 + 4 * g; const LAS bf16_t* pQ = EQ + li * 136 + 4 * g; const LAS bf16_t* pA = EAQK + li * 72 + 4 * g; const LAS bf16_t* pK = EKT + li * 72 + 4 * g;
#define LD4(F, P, MT) do { _Pragma("unroll") for (int ks = 0; ks < 4; ++ks) F[ks] = ldperm((P) + (MT) * 16 * 136 + 32 * ks); } while (0)
#define LD22(F, P, M2) do { F[0] = ldperm((P) + (2 * (M2)) * 16 * 72); F[1] = ldperm((P) + (2 * (M2)) * 16 * 72 + 32); F[2] = ldperm((P) + (2 * (M2) + 1) * 16 * 72); F[3] = ldperm((P) + (2 * (M2) + 1) * 16 * 72 + 32); } while (0)
#define CH4(ACC, F, B) do { _Pragma("unroll") for (int ks = 0; ks < 4; ++ks) ACC = mfma16(F[ks], B[ks], ACC); } while (0)
#define UFROM(MT) do { u[MT] = -u[MT]; } while (0)
#define UB(K2) do { ub[K2] = acc2b(u[2 * (K2)], u[2 * (K2) + 1]); ueb[K2] = acc2b(u[2 * (K2)] * *(const LAS f32x4*)(EEE + 32 * (K2) + 4 * g), u[2 * (K2) + 1] * *(const LAS f32x4*)(EEE + 32 * (K2) + 16 + 4 * g)); } while (0)
#define OST(MT) do { _Pragma("unroll") for (int r = 0; r < 4; ++r) { bf16_t* po = O4 + chain_row(rbase, T, dir, (c0 + i) * 64 + 16 * (MT) + 4 * g + r) * 1024 + v0 + li; const float prev = bf2f(pv[MT][r]); *po = (bf16_t)f2bf(accum ? o[MT][r] + prev : o[MT][r]); } } while (0)
            bf16x8 fa[4], fb[4], sb[4], ub[2], ueb[2];
            f32x4 u[4], o[4];
            LD4(fa, pW, 0);
#pragma unroll
            for (int ks = 0; ks < 4; ++ks) sb[ks] = acc2b(S[2 * ks], S[2 * ks + 1]);
#pragma unroll
            for (int mt = 0; mt < 4; ++mt) { const u32x2 uw = u0n[mt]; o[mt] = (f32x4){0.f, 0.f, 0.f, 0.f};
                u[mt] = -(f32x4){__uint_as_float(uw.x << 16), __uint_as_float(uw.x & 0xffff0000u), __uint_as_float(uw.y << 16), __uint_as_float(uw.y & 0xffff0000u)}; }
            GDE_LOADU(i + 1 < n ? i + 1 : n - 1);
            SCHED_BARRIER();
            LD4(fb, pW, 1); SCHED_BARRIER(); CH4(u[0], fa, sb); SCHED_BARRIER();
            LD4(fa, pW, 2); SCHED_BARRIER(); CH4(u[1], fb, sb); SCHED_BARRIER();
            LD4(fb, pW, 3); SCHED_BARRIER(); CH4(u[2], fa, sb); SCHED_BARRIER();
            LD4(fa, pQ, 0); SCHED_BARRIER(); CH4(u[3], fb, sb); UFROM(0); UFROM(1); SCHED_BARRIER();
            LD4(fb, pQ, 1); SCHED_BARRIER(); CH4(o[0], fa, sb); UFROM(2); UB(0); SCHED_BARRIER();
            LD4(fa, pQ, 2); SCHED_BARRIER(); CH4(o[1], fb, sb); UFROM(3); SCHED_BARRIER();
            LD4(fb, pQ, 3); SCHED_BARRIER(); CH4(o[2], fa, sb); UB(1); SCHED_BARRIER();
            LD22(fa, pA, 0); SCHED_BARRIER(); CH4(o[3], fb, sb); o[0] = o[0] * *(const LAS f32x4*)(EGAM + 4 * g); o[1] = o[1] * *(const LAS f32x4*)(EGAM + 16 + 4 * g); SCHED_BARRIER();
            LD22(fb, pA, 1); SCHED_BARRIER();
            o[0] = mfma16(fa[0], ub[0], o[0]); o[1] = mfma16(fa[2], ub[0], o[1]); o[0] = mfma16(fa[1], ub[1], o[0]); o[1] = mfma16(fa[3], ub[1], o[1]);
            o[2] = o[2] * *(const LAS f32x4*)(EGAM + 32 + 4 * g); o[3] = o[3] * *(const LAS f32x4*)(EGAM + 48 + 4 * g); SCHED_BARRIER();
            LD22(fa, pK, 0); SCHED_BARRIER();
            o[2] = mfma16(fb[0], ub[0], o[2]); o[3] = mfma16(fb[2], ub[0], o[3]); o[2] = mfma16(fb[1], ub[1], o[2]); o[3] = mfma16(fb[3], ub[1], o[3]);
            const float gl = EGL[0];
#pragma unroll
            for (int dt = 0; dt < 8; ++dt) S[dt] = S[dt] * gl;
            SCHED_BARRIER();
            LD22(fb, pK, 1); SCHED_BARRIER();
            S[0] = mfma16(fa[0], ueb[0], S[0]); S[1] = mfma16(fa[2], ueb[0], S[1]); S[0] = mfma16(fa[1], ueb[1], S[0]); S[1] = mfma16(fa[3], ueb[1], S[1]); OST(0); OST(1); SCHED_BARRIER();
            LD22(fa, pK, 2); SCHED_BARRIER();
            S[2] = mfma16(fb[0], ueb[0], S[2]); S[3] = mfma16(fb[2], ueb[0], S[3]); S[2] = mfma16(fb[1], ueb[1], S[2]); S[3] = mfma16(fb[3], ueb[1], S[3]); OST(2); OST(3); SCHED_BARRIER();
            LD22(fb, pK, 3); SCHED_BARRIER();
            S[4] = mfma16(fa[0], ueb[0], S[4]); S[5] = mfma16(fa[2], ueb[0], S[5]); S[4] = mfma16(fa[1], ueb[1], S[4]); S[5] = mfma16(fa[3], ueb[1], S[5]); SCHED_BARRIER();
            S[6] = mfma16(fb[0], ueb[0], S[6]); S[7] = mfma16(fb[2], ueb[0], S[7]); S[6] = mfma16(fb[1], ueb[1], S[6]); S[7] = mfma16(fb[3], ueb[1], S[7]);
#undef LD4
#undef LD22
#undef CH4
#undef UFROM
#undef UB
#undef OST
        }
        GDE_STAGE(lds + ((i + 1) & 1) * GDE_IMG);
        GDE_LOAD(i + 2 < n ? i + 2 : n - 1);
        BAR_LDS();
    }
#undef GDE_LOAD
#undef GDE_LOADU
#undef GDE_STAGE
}

template <class CFG>
DEV void gdn_stream(const Args& a, LAS unsigned char* lds, int tid_in, int wave, int n, const unsigned char* recs_in, const CFG& cfg, f32x4 (&S)[8]) {
    const BufRes recs = make_buf(recs_in);
    int tid = tid_in; OPAQUE(tid); const int lane = tid & 63;
    const int li = lane & 15, g = lane >> 4, v0 = 16 * wave;
    const int u0off = 49152 + ((v0 + li) * 64 + 4 * g) * 2;
    u32x4 rg[8]; u32x2 u0n[4];
#define GDE_LOAD(k) do { const unsigned so_ = cfg.rec_off(k); _Pragma("unroll") for (int j = 0; j < 6; ++j) rg[j] = bld16(recs, j * 8192 + tid * 16, so_); \
        rg[6] = bld16(recs, 65536 + tid * 16, so_); rg[7] = bld16(recs, 73728 + (tid < 33 ? tid : 0) * 16, so_); } while (0)
#define GDE_LOADU(k) do { const unsigned so_ = cfg.rec_off(k); _Pragma("unroll") for (int mt = 0; mt < 4; ++mt) u0n[mt] = bld8(recs, u0off + mt * 32, so_); } while (0)
#define GDE_STAGE(img) do { LAS unsigned char* im_ = (img); _Pragma("unroll") for (int j = 0; j < 2; ++j) { const int l = tid + 512 * j; \
        *(LAS u32x4*)(im_ + GDE_W + (l >> 4) * 272 + (l & 15) * 16) = rg[j]; *(LAS u32x4*)(im_ + GDE_Q + (l >> 4) * 272 + (l & 15) * 16) = rg[2 + j]; \
        *(LAS u32x4*)(im_ + GDE_KT + (l >> 3) * 144 + (l & 7) * 16) = rg[4 + j]; } \
        *(LAS u32x4*)(im_ + GDE_AQK + (tid >> 3) * 144 + (tid & 7) * 16) = rg[6]; if (tid < 33) *(LAS u32x4*)(im_ + GDE_SC + tid * 16) = rg[7]; } while (0)
    { const unsigned f0 = cfg.flag_issue(0, wave), f1 = cfg.flag_issue(n > 1 ? 1 : 0, wave); cfg.flag_wait(0, f0, wave); cfg.flag_wait(n > 1 ? 1 : 0, f1, wave); }
    __syncthreads();
    GDE_LOAD(0); GDE_LOADU(0);
    GDE_STAGE(lds);
    BAR_LDS();
    cfg.post(-1, S, tid);
    GDE_LOAD(n > 1 ? 1 : 0);
    for (int i = 0; i < n; ++i) {
        const int kf = i + 2 < n ? i + 2 : n - 1;
        const unsigned fl = cfg.flag_issue(kf, wave);
        int T, rbase, h, dir, cc; bool accum_; cfg.chunk(i, T, rbase, h, dir, cc, accum_);
        bf16_t* O4 = (bf16_t*)(a.ws + WS_XA) + 512 + h * 128;
        cfg.pre(i, S, tid, wave);
        LAS unsigned char* im = lds + (i & 1) * GDE_IMG;
        LAS bf16_t* EW = (LAS bf16_t*)(im + GDE_W); LAS bf16_t* EQ = (LAS bf16_t*)(im + GDE_Q); LAS bf16_t* EKT = (LAS bf16_t*)(im + GDE_KT);
        LAS bf16_t* EAQK = (LAS bf16_t*)(im + GDE_AQK); LAS float* EGAM = (LAS float*)(im + GDE_SC); LAS float* EEE = EGAM + 64; LAS float* EGL = EGAM + 128;
        {
            const bool accum = accum_;
            f32x4 u[4];
#pragma unroll
            for (int mt = 0; mt < 4; ++mt) { const u32x2 uw = u0n[mt];
                u[mt] = -(f32x4){__uint_as_float(uw.x << 16), __uint_as_float(uw.x & 0xffff0000u), __uint_as_float(uw.y << 16), __uint_as_float(uw.y & 0xffff0000u)}; }
            GDE_LOADU(i + 1 < n ? i + 1 : n - 1);
            unsigned short pv[4][4];
#pragma unroll
            for (int mt = 0; mt < 4; ++mt)
#pragma unroll
                for (int r = 0; r < 4; ++r) pv[mt][r] = O4[chain_row(rbase, T, dir, cc * 64 + 16 * mt + 4 * g + r) * 1024 + v0 + li];
            const LAS bf16_t* pW = EW + li * 136 + 4 * g; const LAS bf16_t* pQ = EQ + li * 136 + 4 * g; const LAS bf16_t* pA = EAQK + li * 72 + 4 * g; const LAS bf16_t* pK = EKT + li * 72 + 4 * g;
#define LD4(F, P, MT) do { _Pragma("unroll") for (int ks = 0; ks < 4; ++ks) F[ks] = ldperm((P) + (MT) * 16 * 136 + 32 * ks); } while (0)
#define LD22(F, P, M2) do { F[0] = ldperm((P) + (2 * (M2)) * 16 * 72); F[1] = ldperm((P) + (2 * (M2)) * 16 * 72 + 32); F[2] = ldperm((P) + (2 * (M2) + 1) * 16 * 72); F[3] = ldperm((P) + (2 * (M2) + 1) * 16 * 72 + 32); } while (0)
#define CH4(ACC, F, B) do { _Pragma("unroll") for (int ks = 0; ks < 4; ++ks) ACC = mfma16(F[ks], B[ks], ACC); } while (0)
#define UFROM(MT) do { u[MT] = -u[MT]; } while (0)
#define UB(K2) do { ub[K2] = acc2b(u[2 * (K2)], u[2 * (K2) + 1]); ueb[K2] = acc2b(u[2 * (K2)] * *(const LAS f32x4*)(EEE + 32 * (K2) + 4 * g), u[2 * (K2) + 1] * *(const LAS f32x4*)(EEE + 32 * (K2) + 16 + 4 * g)); } while (0)
#define OST(MT) do { _Pragma("unroll") for (int r = 0; r < 4; ++r) { bf16_t* po = O4 + chain_row(rbase, T, dir, cc * 64 + 16 * (MT) + 4 * g + r) * 1024 + v0 + li; const float prev = bf2f(pv[MT][r]); *po = (bf16_t)f2bf(accum ? o[MT][r] + prev : o[MT][r]); } } while (0)
            bf16x8 fa[4], fb[4], sb[4], ub[2], ueb[2];
            f32x4 o[4];
            LD4(fa, pW, 0);
#pragma unroll
            for (int ks = 0; ks < 4; ++ks) sb[ks] = acc2b(S[2 * ks], S[2 * ks + 1]);
#pragma unroll
            for (int mt = 0; mt < 4; ++mt) o[mt] = (f32x4){0.f, 0.f, 0.f, 0.f};
            SCHED_BARRIER();
            LD4(fb, pW, 1); SCHED_BARRIER(); CH4(u[0], fa, sb); SCHED_BARRIER();
            LD4(fa, pW, 2); SCHED_BARRIER(); CH4(u[1], fb, sb); SCHED_BARRIER();
            LD4(fb, pW, 3); SCHED_BARRIER(); CH4(u[2], fa, sb); SCHED_BARRIER();
            LD4(fa, pQ, 0); SCHED_BARRIER(); CH4(u[3], fb, sb); UFROM(0); UFROM(1); SCHED_BARRIER();
            LD4(fb, pQ, 1); SCHED_BARRIER(); CH4(o[0], fa, sb); UFROM(2); UB(0); SCHED_BARRIER();
            LD4(fa, pQ, 2); SCHED_BARRIER(); CH4(o[1], fb, sb); UFROM(3); SCHED_BARRIER();
            LD4(fb, pQ, 3); SCHED_BARRIER(); CH4(o[2], fa, sb); UB(1); SCHED_BARRIER();
            LD22(fa, pA, 0); SCHED_BARRIER(); CH4(o[3], fb, sb); o[0] = o[0] * *(const LAS f32x4*)(EGAM + 4 * g); o[1] = o[1] * *(const LAS f32x4*)(EGAM + 16 + 4 * g); SCHED_BARRIER();
            LD22(fb, pA, 1); SCHED_BARRIER();
            o[0] = mfma16(fa[0], ub[0], o[0]); o[1] = mfma16(fa[2], ub[0], o[1]); o[0] = mfma16(fa[1], ub[1], o[0]); o[1] = mfma16(fa[3], ub[1], o[1]);
            o[2] = o[2] * *(const LAS f32x4*)(EGAM + 32 + 4 * g); o[3] = o[3] * *(const LAS f32x4*)(EGAM + 48 + 4 * g); SCHED_BARRIER();
            LD22(fa, pK, 0); SCHED_BARRIER();
            o[2] = mfma16(fb[0], ub[0], o[2]); o[3] = mfma16(fb[2], ub[0], o[3]); o[2] = mfma16(fb[1], ub[1], o[2]); o[3] = mfma16(fb[3], ub[1], o[3]);
            const float gl = EGL[0];
#pragma unroll
            for (int dt = 0; dt < 8; ++dt) S[dt] = S[dt] * gl;
            SCHED_BARRIER();
            LD22(fb, pK, 1); SCHED_BARRIER();
            S[0] = mfma16(fa[0], ueb[0], S[0]); S[1] = mfma16(fa[2], ueb[0], S[1]); S[0] = mfma16(fa[1], ueb[1], S[0]); S[1] = mfma16(fa[3], ueb[1], S[1]); OST(0); OST(1); SCHED_BARRIER();
            LD22(fa, pK, 2); SCHED_BARRIER();
            S[2] = mfma16(fb[0], ueb[0], S[2]); S[3] = mfma16(fb[2], ueb[0], S[3]); S[2] = mfma16(fb[1], ueb[1], S[2]); S[3] = mfma16(fb[3], ueb[1], S[3]); OST(2); OST(3); SCHED_BARRIER();
            LD22(fb, pK, 3); SCHED_BARRIER();
            S[4] = mfma16(fa[0], ueb[0], S[4]); S[5] = mfma16(fa[2], ueb[0], S[5]); S[4] = mfma16(fa[1], ueb[1], S[4]); S[5] = mfma16(fa[3], ueb[1], S[5]); SCHED_BARRIER();
            S[6] = mfma16(fb[0], ueb[0], S[6]); S[7] = mfma16(fb[2], ueb[0], S[7]); S[6] = mfma16(fb[1], ueb[1], S[6]); S[7] = mfma16(fb[3], ueb[1], S[7]);
#undef LD4
#undef LD22
#undef CH4
#undef UFROM
#undef UB
#undef OST
        }
        GDE_STAGE(lds + ((i + 1) & 1) * GDE_IMG);
        cfg.flag_wait(kf, fl, wave);
        BAR_LDS();
        cfg.post(i, S, tid);
        GDE_LOAD(kf);
    }
#undef GDE_LOAD
#undef GDE_LOADU
#undef GDE_STAGE
}

#define XB_TMO      128
#define XB_XCNT(j)  (256  + 64 * (j))
#define XB_XSUB(j)  (1280 + 64 * (j))
#define XB_XGEN(j)  (2304 + 64 * (j))
#define XB_TOP      3328
#define XB_TOPGEN   3392
#define XCD_BAR_WORDS 3456
#define XB_SPIN_CAP (1u << 18)

__device__ __forceinline__ unsigned xb_ld(unsigned* p)              { return __hip_atomic_load(p, __ATOMIC_RELAXED, __HIP_MEMORY_SCOPE_AGENT); }
__device__ __forceinline__ unsigned xb_add(unsigned* p, unsigned v) { return __hip_atomic_fetch_add(p, v, __ATOMIC_RELAXED, __HIP_MEMORY_SCOPE_AGENT); }
__device__ __forceinline__ unsigned xb_xcc_id() { return (unsigned)__builtin_amdgcn_s_getreg((3 << 11) | 20) & 0xFu; }
#define XB_SPIN(cond, bar) do { unsigned _sp = 0; while (cond) { __builtin_amdgcn_s_sleep(1); \
    if ((++_sp & 255u) == 0u) { if (xb_ld(&(bar)[XB_TMO])) break; if (_sp > XB_SPIN_CAP) { atomicAdd(&(bar)[XB_TMO], 1u); break; } } } } while (0)

struct XcdBarrier {
    unsigned* bar; unsigned x;
    volatile LAS unsigned* st;
};

__device__ __forceinline__ XcdBarrier xcd_barrier_post(unsigned* bar, volatile LAS unsigned* st) {
    XcdBarrier b; b.bar = bar; b.x = xb_xcc_id(); b.st = st;
    if (threadIdx.x == 0) (void)xb_add(&bar[XB_XCNT(b.x)], 1u);
    return b;
}
__device__ __forceinline__ void xcd_barrier_complete(unsigned* bar, unsigned x, unsigned& nloc, unsigned& nx) {
    const unsigned G = gridDim.x * gridDim.y * gridDim.z;
    unsigned sum, cnt, mine, sp = 0u;
    for (;;) {
        sum = 0u; cnt = 0u; mine = 0u;
#pragma unroll
        for (unsigned j = 0; j < 16; ++j) { const unsigned c = xb_ld(&bar[XB_XCNT(j)]); sum += c; cnt += (c > 0u) ? 1u : 0u; mine = (j == x) ? c : mine; }
        if (sum == G) break;
        __builtin_amdgcn_s_sleep(1);
        if ((++sp & 255u) == 0u) { if (xb_ld(&bar[XB_TMO])) break; if (sp > XB_SPIN_CAP) { atomicAdd(&bar[XB_TMO], 1u); break; } }
    }
    nloc = mine > 0u ? mine : 1u; nx = cnt > 0u ? cnt : 1u;
}

__device__ __forceinline__ void xcd_barrier(const XcdBarrier& b) {
    asm volatile("s_waitcnt vmcnt(0)" ::: "memory");
    __syncthreads();
    if (threadIdx.x == 0) {
        unsigned* bar = b.bar;
        __builtin_amdgcn_s_waitcnt(0);
        unsigned nloc = b.st[0], nx = b.st[1];
        if (nloc == 0u) { xcd_barrier_complete(bar, b.x, nloc, nx); b.st[0] = nloc; b.st[1] = nx; }
        const unsigned old = xb_add(&bar[XB_XSUB(b.x)], 1u);
        const unsigned gen = old / nloc;
        if (old + 1u == (gen + 1u) * nloc) {
            __builtin_amdgcn_fence(__ATOMIC_RELEASE, "agent");
            asm volatile("s_waitcnt vmcnt(0)" ::: "memory");
            const unsigned og = xb_add(&bar[XB_TOP], 1u);
            const unsigned tg = og / nx;
            if (og + 1u == (tg + 1u) * nx) xb_add(&bar[XB_TOPGEN], 1u);
            else XB_SPIN(xb_ld(&bar[XB_TOPGEN]) == tg, bar);
            __builtin_amdgcn_fence(__ATOMIC_ACQUIRE, "agent");
            xb_add(&bar[XB_XGEN(b.x)], 1u);
            asm volatile("s_waitcnt vmcnt(0)" ::: "memory");
        } else {
            XB_SPIN(xb_ld(&bar[XB_XGEN(b.x)]) == gen, bar);
            __builtin_amdgcn_fence(__ATOMIC_ACQUIRE, "agent");
            asm volatile("s_waitcnt vmcnt(0)" ::: "memory");
        }
    }
    __syncthreads();
}

DEV bool df_giveup(unsigned& sp, GAS unsigned* tmo) {
    __builtin_amdgcn_s_sleep(1);
    if ((++sp & 255u) != 0u) return false;
    if (__builtin_amdgcn_readfirstlane((int)__hip_atomic_load(tmo, __ATOMIC_RELAXED, __HIP_MEMORY_SCOPE_AGENT))) return true;
    if (sp > (1u << 20)) { __hip_atomic_store(tmo, 1u, __ATOMIC_RELAXED, __HIP_MEMORY_SCOPE_AGENT); return true; }
    return false;
}
DEV void df_wait_ge(GAS unsigned* w, unsigned want, GAS unsigned* tmo) {
    unsigned sp = 0;
    while ((unsigned)__builtin_amdgcn_readfirstlane((int)__hip_atomic_load(w, __ATOMIC_RELAXED, __HIP_MEMORY_SCOPE_AGENT)) < want) { if (df_giveup(sp, tmo)) break; }
}
DEV void df_wait4_ge(GAS unsigned* w0, int lane, unsigned want, GAS unsigned* tmo) {
    unsigned sp = 0;
    while (!__all((int)(__hip_atomic_load(w0 + (lane & 3) * 16, __ATOMIC_RELAXED, __HIP_MEMORY_SCOPE_AGENT) >= want))) { if (df_giveup(sp, tmo)) break; }
}
struct DfWords { GAS unsigned* c2;
    DEV GAS unsigned* rdy(int buf, int slot) const { return c2 + (buf * 320 + slot) * 16; }
    DEV GAS unsigned* prog(int cons) const { return c2 + 10240 + cons * 16; }
    DEV GAS unsigned* half(int chain) const { return c2 + 11520 + chain * 16; }
    DEV GAS unsigned* queue() const { return c2 + 12544; }
    DEV GAS unsigned* tmo() const { return c2 + 12560; }
    DEV unsigned issue(GAS unsigned* f, int wave) const { return wave == 0 ? __hip_atomic_load(f, __ATOMIC_RELAXED, __HIP_MEMORY_SCOPE_AGENT) : 0u; }
    DEV void wait(GAS unsigned* f, unsigned want, unsigned v, int wave) const { if (wave == 0) { unsigned sp = 0;
        while ((unsigned)__builtin_amdgcn_readfirstlane((int)v) < want) { if (df_giveup(sp, tmo())) break; v = __hip_atomic_load(f, __ATOMIC_RELAXED, __HIP_MEMORY_SCOPE_AGENT); } } }
};
struct GdnLatCfg { DfWords w; int bid, b, h, dir;
    DEV unsigned rec_off(int k) const { return (unsigned)((k >> 2) & 1) * (20u << 20) + (unsigned)(bid * 4 + (k & 3)) * GDR_BYTES; }
    DEV unsigned flag_issue(int k, int wave) const { return w.issue(w.rdy((k >> 2) & 1, bid * 4 + (k & 3)), wave); }
    DEV void flag_wait(int k, unsigned v, int wave) const { w.wait(w.rdy((k >> 2) & 1, bid * 4 + (k & 3)), (unsigned)(k >> 2) + 1u, v, wave); }
    DEV void chunk(int k, int& T, int& rb, int& h_, int& d_, int& c_, bool& acc) const { T = TLAT; rb = MCTX + b * TLAT; h_ = h; d_ = dir; c_ = k; acc = k >= 32; }
    DEV void pre(int k, f32x4 (&)[8], int, int wave) const {
        if (k == 32) { if (wave == 0) { df_wait_ge(w.half(bid ^ 1), 1u, w.tmo()); __builtin_amdgcn_fence(__ATOMIC_ACQUIRE, "agent"); asm volatile("s_waitcnt vmcnt(0)" ::: "memory"); } __syncthreads(); } }
    DEV void post(int k, f32x4 (&)[8], int tid) const {
        if (tid == 0) __hip_atomic_store(w.prog(bid), (unsigned)(k + 2), __ATOMIC_RELAXED, __HIP_MEMORY_SCOPE_AGENT);
        if (k == 31) { asm volatile("s_waitcnt vmcnt(0)" ::: "memory"); __syncthreads();
            if (tid == 0) { __builtin_amdgcn_fence(__ATOMIC_RELEASE, "agent"); asm volatile("s_waitcnt vmcnt(0)" ::: "memory"); __hip_atomic_store(w.half(bid), 1u, __ATOMIC_RELAXED, __HIP_MEMORY_SCOPE_AGENT); } } }
};
struct GdnCtxCfg { DfWords w; int bid, j; float* out;
    DEV unsigned rec_off(int k) const { return (unsigned)((k >> 2) & 1) * (20u << 20) + (unsigned)(128 + j * 4 + (k & 3)) * GDR_BYTES; }
    DEV unsigned flag_issue(int k, int wave) const { return w.issue(w.rdy((k >> 2) & 1, 128 + j * 4 + (k & 3)), wave); }
    DEV void flag_wait(int k, unsigned v, int wave) const { w.wait(w.rdy((k >> 2) & 1, 128 + j * 4 + (k & 3)), (unsigned)(k >> 2) + 1u, v, wave); }
    DEV void chunk(int k, int& T, int& rb, int& h_, int& d_, int& c_, bool& acc) const { const int s = k >> 2, p = 8 * (s & 7) + j; T = TCTX; rb = (p >> 2) * TCTX; h_ = p & 3; d_ = s >> 3; c_ = k & 3; acc = (s >> 3) != 0; }
    DEV void pre(int k, f32x4 (&S)[8], int, int) const { if ((k & 3) == 0) {
#pragma unroll
        for (int dt = 0; dt < 8; ++dt) S[dt] = (f32x4){0.f, 0.f, 0.f, 0.f}; } }
    DEV void post(int k, f32x4 (&S)[8], int tid) const {
        if (tid == 0) __hip_atomic_store(w.prog(bid), (unsigned)(k + 2), __ATOMIC_RELAXED, __HIP_MEMORY_SCOPE_AGENT);
        if (k >= 0 && (k & 3) == 3) { const int s = k >> 2, p = 8 * (s & 7) + j, lane = tid & 63, li = lane & 15, g = lane >> 4, v0 = 16 * (tid >> 6);
            float* so = out + ((s >> 3) ? O_GDB : O_GDF) + (size_t)p * 16384;
#pragma unroll
            for (int dt = 0; dt < 8; ++dt)
#pragma unroll
                for (int r = 0; r < 4; ++r) so[(size_t)(16 * dt + 4 * g + r) * 128 + v0 + li] = S[dt][r]; } }
};
DEV int olane(int t) { OPAQUE(t); return t & 63; }
__global__ void __launch_bounds__(512, 2) fwd_megakernel(Args a) {
    extern __shared__ __attribute__((aligned(16))) unsigned char lds_raw[];
    cg::grid_group grid = cg::this_grid();
    LAS unsigned char* lds = (LAS unsigned char*)lds_raw;
    const int tid = threadIdx.x, lane = tid & 63, wave = __builtin_amdgcn_readfirstlane(tid >> 6);
    const int G = gridDim.x, bid = blockIdx.x;
    const int gw = bid * 8 + wave, NGW = G * 8;
    unsigned char* ws = a.ws;
    const int lo = a.ph_lo, hi = a.ph_hi; const bool IN4_ = lo <= 4 && 4 < hi, IN9_ = lo <= 9 && 9 < hi;
    volatile LAS unsigned* bar_st = (volatile LAS unsigned*)(lds + 131072);
    if (tid < 2) bar_st[tid] = 0u;
    __syncthreads();
    unsigned* const ctlw = (unsigned*)ws + (a.pad ? 16384 : 0);
    XcdBarrier bar; bar.bar = ctlw; bar.x = 0; bar.st = bar_st;
    if (hi - lo > 1 || IN4_ || IN9_) bar = xcd_barrier_post(ctlw, bar_st);
#define IN(k) (lo <= (k) && (k) < hi)
#define SEAM(k) do { if (IN(k) && IN((k) + 1)) xcd_barrier(bar); } while (0)
    if (a.ph_hi < 0) grid.sync();

    if (IN(0)) { p0_prologue(a, lds, tid, olane(tid), wave); } SEAM(0);
    if (IN(1)) { rows_h0(a, olane(tid), gw, NGW); } SEAM(1);
    if (IN(2)) {
        pg8::Gemm g{(const bf16_t*)(ws + WS_XA), (const bf16_t*)(ws + WS_W0IN), MROWS, L0_INP, 1024, 1024}; pg8::StaticOrder S; S.init(MROWS, L0_INP, G, bid);
        EpiStoreBf16 E{(bf16_t*)(ws + WS_PROJ), L0_LD};
        pg8::gemm_phase<EpiStoreBf16, pg8::StaticOrder, true, true>(lds, g, S, E);
    } SEAM(2);
    if (IN(4)) {
        unsigned char* rbuf[2] = {ws + WS_XA, (unsigned char*)a.out + 20 * MiB};
        unsigned* qctr = ctlw + 8192;
        GAS unsigned* c4 = (GAS unsigned*)(ctlw + 12288);
#define RW_PD(s_) (c4 + 64 * (s_))
#define RW_ED(s_) (c4 + 1024 + 64 * (s_))
#define RW_ROWS (c4 + 2048)
#define RW_TMO (c4 + 2112)
        LAS unsigned* qslot = (LAS unsigned*)(lds + 131072 + 64);
        f32x4 S[4];
        { const int b = (bid & 63) >> 4, h = (bid >> 1) & 7, dir = bid & 1, li = lane & 15, g = lane >> 4, v0 = 16 * (wave & 3);
            const float* s0 = a.in[dir ? I_RWB : I_RWF] + (size_t)(b * 8 + h) * 4096;
#pragma unroll
            for (int dt = 0; dt < 4; ++dt) S[dt] = *(const f32x4*)(s0 + (size_t)(v0 + li) * 64 + 16 * dt + 4 * g); }
        int pkind = 0, pst = 0;
        for (int s = 0; s <= 8; ++s) {
            int lv = lane; OPAQUE(lv);
            if (s >= 1 && bid < 96) {
                asm volatile("s_waitcnt vmcnt(0)" ::: "memory"); __syncthreads();
                if (tid == 0) { if (pkind == 1) __hip_atomic_fetch_add(RW_PD(pst), 1u, __ATOMIC_RELAXED, __HIP_MEMORY_SCOPE_AGENT); else if (pkind == 2) __hip_atomic_fetch_add(RW_ROWS, 1u, __ATOMIC_RELAXED, __HIP_MEMORY_SCOPE_AGENT); }
                pkind = 0;
                if (wave == 0) df_wait_ge(RW_PD(s - 1), 640u, RW_TMO);
                __syncthreads();
                if (!(a.flags & 16384)) {
                const unsigned char* rb = rbuf[(s - 1) & 1];
                if (bid < 64) { const int b = bid >> 4, h = (bid >> 1) & 7, dir = bid & 1;
                    rwkv_esteps(a, lds, tid, lv, wave, TLAT, MCTX + b * TLAT, h, dir, 8 * (s - 1), 8, rb + (size_t)(bid * 8) * RWR_BYTES, S); }
                else { const int cc = 32 * (s - 1) + (bid - 64), b = cc >> 4, h = (cc >> 1) & 7, dir = cc & 1, li = lv & 15, g = lv >> 4, v0 = 16 * (wave & 3);
                    f32x4 Sc[4];
#pragma unroll
                    for (int dt = 0; dt < 4; ++dt) Sc[dt] = (f32x4){0.f, 0.f, 0.f, 0.f};
                    rwkv_esteps(a, lds, tid, lv, wave, TCTX, b * TCTX, h, dir, 0, 4, rb + (size_t)(512 + (bid - 64) * 4) * RWR_BYTES, Sc);
                    if (wave < 4) { float* so = a.out + (dir ? O_RWB : O_RWF) + (size_t)(b * 8 + h) * 4096 + (size_t)(v0 + li) * 64 + 4 * g;
#pragma unroll
                        for (int dt = 0; dt < 4; ++dt) *(f32x4*)(so + 16 * dt) = Sc[dt]; } }
                }
                if (tid == 0) __hip_atomic_fetch_add(RW_ED(s), 1u, __ATOMIC_RELAXED, __HIP_MEMORY_SCOPE_AGENT);
            }
            if (s < 8) {
                unsigned char* wb = rbuf[s & 1];
                bool first = true;
                for (;;) {
                    unsigned t0 = 0u;
                    if (wave == 0) { if (lane == 0) t0 = __hip_atomic_fetch_add((GAS unsigned*)(qctr + 64 * s), 1u, __ATOMIC_RELAXED, __HIP_MEMORY_SCOPE_AGENT); }
                    asm volatile("s_waitcnt vmcnt(0)" ::: "memory");
                    __syncthreads();
                    if (tid == 0) { if (pkind == 1) __hip_atomic_fetch_add(RW_PD(pst), 1u, __ATOMIC_RELAXED, __HIP_MEMORY_SCOPE_AGENT); else if (pkind == 2) __hip_atomic_fetch_add(RW_ROWS, 1u, __ATOMIC_RELAXED, __HIP_MEMORY_SCOPE_AGENT); }
                    pkind = 0;
                    if (wave == 0) {
                        if (first && s >= 2) df_wait_ge(RW_ED(s - 1), 96u, RW_TMO);
                        if (lane == 0) qslot[0] = (unsigned)__builtin_amdgcn_readfirstlane((int)t0);
                    }
                    first = false;
                    __syncthreads();
                    const int item = (int)__builtin_amdgcn_readfirstlane((int)qslot[0]);
                    if (item >= 704) break;
                    if (item >= 640) { const int q = 64 * s + (item - 640); rows_attn_prep(a, lv, wave, 8, 40 * q, 40 * q + 40, 4 * q, 4 * q + 4); pkind = 2; continue; }
                    if (item < 512) { const int ch = item >> 3, b = ch >> 4, h = (ch >> 1) & 7, dir = ch & 1;
                        rwkv_prep_item(a, lds, tid, lv, wave, TLAT, MCTX + b * TLAT, h, dir, 8 * s + (item & 7), wb + (size_t)item * RWR_BYTES); }
                    else { const int it = item - 512, cc = 32 * s + (it >> 2), b = cc >> 4, h = (cc >> 1) & 7, dir = cc & 1;
                        rwkv_prep_item(a, lds, tid, lv, wave, TCTX, b * TCTX, h, dir, it & 3, wb + (size_t)item * RWR_BYTES); }
                    pkind = 1; pst = s;
                }
            }
        }
        if (wave == 0) { df_wait_ge(RW_ROWS, 512u, RW_TMO); __builtin_amdgcn_fence(__ATOMIC_ACQUIRE, "agent"); asm volatile("s_waitcnt vmcnt(0)" ::: "memory"); }
        __syncthreads();
        if (!(a.flags & 8192)) for (int u = bid; u < 640; u += G) {
            const attn_body::bf16* Qb = (const attn_body::bf16*)a.out;
            if (u < 512) { const int b = u >> 7, h = (u >> 4) & 7, qb = u & 15;
                attn_body::attn_unit<8>((long)MCTX + (long)b * TLAT, (long)b * TKL, h, qb, TKL, Qb, (const attn_body::bf16*)(ws + WS_KL), (const attn_body::bf16*)(ws + WS_VL), (attn_body::bf16*)a.out, (char*)lds_raw); }
            else { const int uc = u - 512, b = uc >> 3, h = uc & 7;
                attn_body::attn_unit<8>((long)b * TCTX, (long)b * TCTX, h, 0, TCTX, Qb, (const attn_body::bf16*)(ws + WS_KC), (const attn_body::bf16*)(ws + WS_VC), (attn_body::bf16*)a.out, (char*)lds_raw); }
        }
#undef RW_PD
#undef RW_ED
#undef RW_ROWS
#undef RW_TMO
    } SEAM(4);
    if (IN(5)) { rows_fin0(a, olane(tid), gw, NGW); } SEAM(5);
    if (IN(6)) {
        pg8::Gemm g{(const bf16_t*)(ws + WS_XA), (const bf16_t*)(ws + WS_W0OUT), MROWS, 1024, 1024, 1024}; pg8::StaticOrder S; S.init(MROWS, 1024, G, bid);
        EpiStoreBf16 E{(bf16_t*)(ws + WS_XB), 1024};
        pg8::gemm_phase<EpiStoreBf16, pg8::StaticOrder, true, true>(lds, g, S, E);
    } SEAM(6);
    if (IN(7)) { rows_mid(a, olane(tid), gw, NGW); } SEAM(7);
    if (IN(8)) {
        pg8::Gemm g{(const bf16_t*)(ws + WS_XB), (const bf16_t*)(ws + WS_W1IN), MROWS, L1_INP, 1024, 1024}; pg8::StaticOrder S; S.init(MROWS, L1_INP, G, bid);
        EpiStoreBf16 E{(bf16_t*)(ws + WS_PROJ), L1_LD};
        pg8::gemm_phase<EpiStoreBf16, pg8::StaticOrder, true, true>(lds, g, S, E);
    } SEAM(8);
    if (IN(9)) {
        unsigned char* rbuf[2] = {ws + WS_XB, ws + WS_XB + 20 * MiB};
        constexpr size_t GLA_OFF = (size_t)160 * GDR_BYTES;
        GAS unsigned* c2 = (GAS unsigned*)((unsigned*)ws + 32768 + (a.pad ? 16384 : 0));
#define DF_RDY(buf_, slot_) (c2 + ((buf_) * 320 + (slot_)) * 16)
#define DF_P(cons_) (c2 + 10240 + (cons_) * 16)
#define DF_D(chain_) (c2 + 11520 + (chain_) * 16)
#define DF_Q (c2 + 12544)
#define DF_TMO (c2 + 12560)
        LAS unsigned* qslot = (LAS unsigned*)(lds + 131072 + 64);
#define DF_WAIT_GROUP(slot0_) do { if (wave == 0) df_wait4_ge(DF_RDY(sg & 1, (slot0_)), lv, (unsigned)sg + 1u, DF_TMO); __syncthreads(); } while (0)
#define DF_DONE_GROUP() do { if (tid == 0) __hip_atomic_store(DF_P(bid), 4u * (unsigned)(sg + 1), __ATOMIC_RELAXED, __HIP_MEMORY_SCOPE_AGENT); } while (0)
#define DF_HALF_WAIT() do { if (sg == 8) { if (wave == 0) { df_wait_ge(DF_D(bid ^ 1), 1u, DF_TMO); __builtin_amdgcn_fence(__ATOMIC_ACQUIRE, "agent"); asm volatile("s_waitcnt vmcnt(0)" ::: "memory"); } __syncthreads(); } } while (0)
#define DF_HALF_MARK() do { if (sg == 7) { asm volatile("s_waitcnt vmcnt(0)" ::: "memory"); __syncthreads(); \
            if (tid == 0) { __builtin_amdgcn_fence(__ATOMIC_RELEASE, "agent"); asm volatile("s_waitcnt vmcnt(0)" ::: "memory"); __hip_atomic_store(DF_D(bid), 1u, __ATOMIC_RELAXED, __HIP_MEMORY_SCOPE_AGENT); } } } while (0)
        if (bid < 64) {
            f32x4 S[8];
            const int cb = bid & 31, b = cb >> 3, h = (cb >> 1) & 3, dir = cb & 1; const bool isgla = bid >= 32;
            {   const int li = lane & 15, g = lane >> 4, v0 = 16 * wave;
                const float* s0 = isgla ? a.in[dir ? I_GLB : I_GLF] + (size_t)(b * 4 + h) * 8192 : a.in[dir ? I_GDB : I_GDF] + (size_t)(b * 4 + h) * 16384;
#pragma unroll
                for (int dt = 0; dt < 8; ++dt)
#pragma unroll
                    for (int r = 0; r < 4; ++r) S[dt][r] = s0[(size_t)(16 * (isgla ? (dt & 3) : dt) + 4 * g + r) * 128 + v0 + li]; }
            if (!isgla) {
                const GdnLatCfg cfg{DfWords{c2}, bid, b, h, dir};
                gdn_stream(a, lds, tid, wave, 64, ws + WS_XB, cfg, S);
            } else {
                for (int sg = 0; sg < 16; ++sg) {
                    int lv = lane; OPAQUE(lv);
                    DF_WAIT_GROUP(160 + cb * 4); DF_HALF_WAIT();
                    gla_esteps(a, lds, tid, lv, wave, TLAT, MCTX + b * TLAT, h, dir, 4 * sg, 4, 32, rbuf[sg & 1] + GLA_OFF + (size_t)(cb * 4) * GLR_BYTES, S);
                    DF_DONE_GROUP(); DF_HALF_MARK();
                }
            }
        } else if (bid < 72) {
            f32x4 Sc[8];
#pragma unroll
            for (int dt = 0; dt < 8; ++dt) Sc[dt] = (f32x4){0.f, 0.f, 0.f, 0.f};
            const GdnCtxCfg cfg{DfWords{c2}, bid, bid - 64, a.out};
            gdn_stream(a, lds, tid, wave, 64, ws + WS_XB, cfg, Sc);
        } else if (bid < 80) {
            const int j = bid - 72;
            for (int sg = 0; sg < 16; ++sg) {
                int lv = lane; OPAQUE(lv);
                DF_WAIT_GROUP(160 + 128 + j * 4);
                const unsigned char* rb = rbuf[sg & 1];
                const int dir = sg >> 3, p = 8 * (sg & 7) + j, b = p >> 2, h = p & 3, li = lv & 15, g = lv >> 4, v0 = 16 * wave;
                f32x4 Sc[8];
#pragma unroll
                for (int dt = 0; dt < 8; ++dt) Sc[dt] = (f32x4){0.f, 0.f, 0.f, 0.f};
                gla_esteps(a, lds, tid, lv, wave, TCTX, b * TCTX, h, dir, 0, 4, dir ? 0 : 1000, rb + GLA_OFF + (size_t)(128 + j * 4) * GLR_BYTES, Sc);
                DF_DONE_GROUP();
                float* so = a.out + (dir ? O_GLB : O_GLF) + (size_t)(b * 4 + h) * 8192;
#pragma unroll
                for (int dt = 0; dt < 4; ++dt)
#pragma unroll
                    for (int r = 0; r < 4; ++r) so[(size_t)(16 * dt + 4 * g + r) * 128 + v0 + li] = Sc[dt][r];
            }
        } else {
            for (;;) {
                if (wave == 0) {
                    unsigned t0 = 0u; if (lane == 0) t0 = __hip_atomic_fetch_add(DF_Q, 1u, __ATOMIC_RELAXED, __HIP_MEMORY_SCOPE_AGENT);
                    t0 = (unsigned)__builtin_amdgcn_readfirstlane((int)t0);
                    if (t0 < 5120u) { const int s = (int)(t0 / 320u), item = (int)(t0 % 320u);
                        if (s >= 2) { const bool gla_ = item >= 160; const int idx_ = gla_ ? item - 160 : item; const int cons = idx_ < 128 ? (gla_ ? 32 : 0) + (idx_ >> 2) : 64 + (gla_ ? 8 : 0) + ((idx_ - 128) >> 2);
                            df_wait_ge(DF_P(cons), 4u * (unsigned)(s - 1), DF_TMO); } }
                    if (lane == 0) qslot[0] = t0;
                }
                __syncthreads();
                const unsigned t = (unsigned)__builtin_amdgcn_readfirstlane((int)qslot[0]);
                __syncthreads();
                if (t >= 5120u) break;
                const int s = (int)(t / 320u), item = (int)(t % 320u);
                int lv = lane; OPAQUE(lv);
                unsigned char* wb = rbuf[s & 1];
                const bool gla_ = item >= 160; const int idx_ = gla_ ? item - 160 : item; int T_, rb_, h_, dir_, ch_;
                if (idx_ < 128) { const int c_ = idx_ >> 2, b_ = c_ >> 3; h_ = (c_ >> 1) & 3; dir_ = c_ & 1; ch_ = 4 * s + (idx_ & 3); T_ = TLAT; rb_ = MCTX + b_ * TLAT; }
                else { const int j_ = (idx_ - 128) >> 2, p_ = 8 * (s & 7) + j_, b_ = p_ >> 2; h_ = p_ & 3; dir_ = s >> 3; ch_ = (idx_ - 128) & 3; T_ = TCTX; rb_ = b_ * TCTX; }
                if (!gla_) gdn_prep_item(a, lds, tid, lv, wave, T_, rb_, h_, dir_, ch_, wb + (size_t)idx_ * GDR_BYTES);
                else       gla_prep_item(a, lds, tid, lv, wave, T_, rb_, h_, dir_, ch_, wb + GLA_OFF + (size_t)idx_ * GLR_BYTES);
                asm volatile("s_waitcnt vmcnt(0)" ::: "memory");
                __syncthreads();
                if (tid == 0) __hip_atomic_store(DF_RDY(s & 1, item), (unsigned)s + 1u, __ATOMIC_RELAXED, __HIP_MEMORY_SCOPE_AGENT);
            }
        }
        if (IN(9) && IN(10)) xcd_barrier(bar);
#undef DF_WAIT_GROUP
#undef DF_DONE_GROUP
#undef DF_HALF_WAIT
#undef DF_HALF_MARK
#undef DF_RDY
#undef DF_P
#undef DF_D
#undef DF_Q
#undef DF_TMO
    }
    if (IN(10)) { rows_fin1(a, olane(tid), gw, NGW); } SEAM(10);
    if (IN(11)) {
        pg8::Gemm g{(const bf16_t*)(ws + WS_XA), (const bf16_t*)(ws + WS_W1OUT), MROWS, 1024, 1024, 1024}; pg8::StaticOrder S; S.init(MROWS, 1024, G, bid);
        EpiStoreBf16 E{(bf16_t*)(ws + WS_XB), 1024};
        pg8::gemm_phase<EpiStoreBf16, pg8::StaticOrder, true, true>(lds, g, S, E);
    } SEAM(11);
    if (IN(12)) { rows_final(a, olane(tid), gw, NGW); }
#undef IN
#undef SEAM
}

extern "C" void kernel_launch(void* const* d_in, const int* in_sizes, int n_in, void* d_out, int out_size, void* d_ws, size_t ws_size, hipStream_t stream) {
    static int grid = 0;
    if (grid == 0) {
        if (n_in != N_IN || out_size != (int)O_END || ws_size < 256 * MiB) { fprintf(stderr, "kernel_launch: unexpected problem (n_in %d, out %d, ws %zu); nothing launched\n", n_in, out_size, ws_size); grid = -1; return; }
        int dev = 0, cus = 0, per_cu = 0;
        if (hipGetDevice(&dev) != hipSuccess || hipDeviceGetAttribute(&cus, hipDeviceAttributeMultiprocessorCount, dev) != hipSuccess) { grid = -1; return; }
        if (hipFuncSetAttribute((const void*)fwd_megakernel, hipFuncAttributeMaxDynamicSharedMemorySize, LDS_BYTES) != hipSuccess) { fprintf(stderr, "kernel_launch: hipFuncSetAttribute failed\n"); grid = -1; return; }
        if (hipOccupancyMaxActiveBlocksPerMultiprocessor(&per_cu, (const void*)fwd_megakernel, 512, LDS_BYTES) != hipSuccess || per_cu < 1) { fprintf(stderr, "kernel_launch: occupancy query reports %d blocks per CU\n", per_cu); (void)hipGetLastError(); grid = -1; return; }
        if (cus < 128) { fprintf(stderr, "kernel_launch: %d CUs: the scan pipelines of this kernel assign fixed roles to workgroups 0..95 and need a grid of at least 128 workgroups; nothing launched\n", cus); grid = -1; return; }
        grid = cus;
    }
    if (grid < 0) return;
    Args a{};
    for (int i = 0; i < N_IN; ++i) a.in[i] = (const float*)d_in[i];
    a.out = (float*)d_out; a.ws = (unsigned char*)d_ws; a.ph_lo = 0; a.ph_hi = 13;
    void* args[] = {&a};
    if (hipMemsetAsync(d_ws, 0, 262144, stream) != hipSuccess) { fprintf(stderr, "kernel_launch: hipMemsetAsync failed\n"); return; }
#if defined(PROBE_LO)
    {
        Args p = a; p.ph_lo = PROBE_LO; p.ph_hi = PROBE_HI; p.flags = PROBE_FLAGS; p.pad = 1; void* pargs[] = {&p};
        (void)hipLaunchCooperativeKernel((const void*)fwd_megakernel, dim3(grid), dim3(512), pargs, LDS_BYTES, stream);
    }
#endif
    const hipError_t e = hipLaunchCooperativeKernel((const void*)fwd_megakernel, dim3(grid), dim3(512), args, LDS_BYTES, stream);
    if (e != hipSuccess) fprintf(stderr, "kernel_launch: cooperative launch failed: %s (grid %d)\n", hipGetErrorString(e), grid);
}
```

```cpp
#include <hip/hip_runtime.h>
#include <hip/hip_cooperative_groups.h>
#include <hip/hip_bf16.h>
#include <cstdio>
#include <cstdint>
#include <cmath>
namespace cg = cooperative_groups;

namespace pg8 {
#define PG8_LAS __attribute__((address_space(3)))
typedef unsigned short bf16_t;
typedef short bf16x8 __attribute__((ext_vector_type(8)));
typedef float f32x4 __attribute__((ext_vector_type(4)));
typedef unsigned u32x4 __attribute__((ext_vector_type(4)));
constexpr int BM = 256, BK = 64, HALF = 128, HTB = HALF * BK * 2  , STAGE_BYTES = 8 * HTB, NXCD = 8, WGM = 8;

__host__ __device__ __forceinline__ int lds_byte(int r, int c) { const int st = (r >> 4) * 2 + (c >> 5), rr = r & 15, cc = c & 31, ob = rr * 64 + cc * 2; return st * 1024 + (ob ^ (((ob >> 9) & 1) << 5)); }
__host__ __device__ __forceinline__ void stage_rc(int b, int& R, int& C) { const int st = b / 1024, sb = b % 1024, swz = sb ^ (((sb >> 9) & 1) << 5); R = (st >> 1) * 16 + swz / 64; C = (st & 1) * 32 + (swz % 64) / 2; }
__host__ __device__ __forceinline__ int perm32(int rho) { const int n = rho >> 4, i = rho & 15; return 8 * (i >> 2) + 4 * n + (i & 3); }

struct Unit { int pm, pn; };
struct Gemm { const bf16_t* A; const bf16_t* Bt; int M, N, K, lda; };

struct StaticOrder {
    int nM, nN, nwg, G, c;
    __host__ __device__ void init(int M, int N, int G_, int c_) { nM = M / BM; nN = N / BM; nwg = nM * nN; G = G_; c = c_; }
    __host__ __device__ bool next(int i, Unit& u) const {
        const long L = (long)i * G + c; if (L >= nwg) return false;
        int wgid = (int)L; { const int q = nwg / NXCD, r = nwg % NXCD, xcd = wgid % NXCD, off = wgid / NXCD; wgid = (xcd < r ? xcd * (q + 1) : r * (q + 1) + (xcd - r) * q) + off; }
        const int nig = WGM * nN, gid = wgid / nig, fm = gid * WGM, gsz = (nM - fm) < WGM ? (nM - fm) : WGM;
        u.pm = fm + ((wgid % nig) % gsz); u.pn = (wgid % nig) / gsz; return true;
    }
    __device__ __forceinline__ void a_ready(const Unit&) const {}
    __device__ __forceinline__ void done(const Unit&) const {}
};

struct MMajorOrder {
    int nM, ng, c;
    __host__ __device__ void init(int M, int G_, int c_) { nM = M / BM; ng = G_ / 32; c = c_; }
    __host__ __device__ bool next(int i, Unit& u) const {
        if (c >= ng * 32) return false;
        const int m = i * 8 * ng + (c & 7) * ng + (c >> 5); if (m >= nM) return false;
        u.pm = m; u.pn = (c >> 3) & 3; return true;
    }
    __device__ __forceinline__ void a_ready(const Unit&) const {}
    __device__ __forceinline__ void done(const Unit&) const {}
};

__device__ __forceinline__ unsigned cvt_pk_bf16(float lo, float hi) { unsigned r; asm volatile("v_cvt_pk_bf16_f32 %0, %1, %2" : "=v"(r) : "v"(lo), "v"(hi)); return r; }
template <class Epi, class Sched, bool ALIGN_EPI = false, bool SP2 = false>
__device__ __forceinline__ void gemm_phase(PG8_LAS unsigned char* lds, const Gemm g, const Sched& S, const Epi& E) {
    const int tid = threadIdx.x, wid = __builtin_amdgcn_readfirstlane(tid >> 6), lane = tid & 63, wr = wid >> 2, wc = wid & 3, fr = lane & 15, fq = lane >> 4;
    const int K = g.K, nt = K / BK;
    unsigned voffA[2], voffB[2];
#pragma unroll
    for (int i = 0; i < 2; ++i) { int R, C; stage_rc(tid * 16 + i * 8192, R, C); const int Rb = Epi::PERM ? ((R & ~31) + perm32(R & 31)) : R;
        voffA[i] = (unsigned)(R * g.lda + C) * 2u; voffB[i] = (unsigned)(Rb * K + C) * 2u; }
    const size_t kstep = (size_t)(BK * 2);
    const size_t hstepB = (size_t)HALF * K * 2, hstepA = (size_t)HALF * g.lda * 2;
    const size_t tstepA = 2 * hstepA, tstepB = 2 * hstepB;
    const unsigned ldsw = (unsigned)wid * 1024u;
    const int aoff = lds_byte(wr * 64 + fr, fq * 8), boff = lds_byte(wc * 32 + fr, fq * 8);
#define PG8_SA(b, h) (((b) * 2 + (h)) * HTB)
#define PG8_SB(b, h) ((4 + (b) * 2 + (h)) * HTB)
#define PG8_STAGE(bufoff, gbase, voff) do { _Pragma("unroll") for (int _i = 0; _i < 2; ++_i) \
        __builtin_amdgcn_global_load_lds((const unsigned*)((const char*)(gbase) + (voff)[_i]), (PG8_LAS unsigned*)(lds + (bufoff) + ldsw + _i * 8192), 16, 0, 0); } while (0)
#define PG8_LDA(dst, b, h) do { _Pragma("unroll") for (int m = 0; m < 4; ++m) _Pragma("unroll") for (int k = 0; k < 2; ++k) dst[m][k] = *(const PG8_LAS bf16x8*)(lds + PG8_SA(b, h) + aoff + m * 2048 + k * 1024); } while (0)
#define PG8_LDB(dst, b, h) do { _Pragma("unroll") for (int n = 0; n < 2; ++n) _Pragma("unroll") for (int k = 0; k < 2; ++k) dst[n][k] = *(const PG8_LAS bf16x8*)(lds + PG8_SB(b, h) + boff + n * 2048 + k * 1024); } while (0)
#define PG8_MMA(ai, bj, At, Bt) do { __builtin_amdgcn_s_setprio(1); _Pragma("unroll") for (int m = 0; m < 4; ++m) _Pragma("unroll") for (int n = 0; n < 2; ++n) _Pragma("unroll") for (int k = 0; k < 2; ++k) \
        acc[ai][bj][m][n] = __builtin_amdgcn_mfma_f32_16x16x32_bf16(Bt[n][k], At[m][k], acc[ai][bj][m][n], 0, 0, 0); __builtin_amdgcn_s_setprio(0); } while (0)
#define PG8_WAIT_V(n) asm volatile("s_waitcnt vmcnt(" #n ")" ::: "memory")
#define PG8_WAIT_L(n) asm volatile("s_waitcnt lgkmcnt(" #n ")" ::: "memory")
#define PG8_BAR __builtin_amdgcn_s_barrier()
#define PG8_SCHED __builtin_amdgcn_sched_barrier(0)
    Unit cur, nxt; int ui = 0;
    if (!S.next(0, cur)) return;
    f32x4 acc[2][2][4][2];
#pragma unroll
    for (int a = 0; a < 2; ++a)
#pragma unroll
        for (int b = 0; b < 2; ++b)
#pragma unroll
            for (int m = 0; m < 4; ++m)
#pragma unroll
                for (int n = 0; n < 2; ++n) acc[a][b][m][n] = (f32x4){0.f, 0.f, 0.f, 0.f};
    bf16x8 At[4][2], B0[2][2], B1[2][2];
    const char* cA = (const char*)g.A + (size_t)cur.pm * tstepA; const char* cB = (const char*)g.Bt + (size_t)cur.pn * tstepB;
    S.a_ready(cur);
    if constexpr (SP2) {
        PG8_STAGE(PG8_SB(0, 0), cB, voffB); PG8_STAGE(PG8_SB(0, 1), cB + hstepB, voffB); PG8_STAGE(PG8_SA(0, 0), cA, voffA); PG8_STAGE(PG8_SA(0, 1), cA + hstepA, voffA);
        if (wr == 1) PG8_BAR;
        PG8_WAIT_V(2); PG8_BAR;
        PG8_STAGE(PG8_SB(1, 0), cB + kstep, voffB); PG8_STAGE(PG8_SA(1, 0), cA + kstep, voffA); PG8_STAGE(PG8_SB(1, 1), cB + hstepB + kstep, voffB);
        PG8_WAIT_V(6); PG8_BAR;
    } else {
        PG8_STAGE(PG8_SB(0, 0), cB, voffB); PG8_STAGE(PG8_SA(0, 0), cA, voffA); PG8_STAGE(PG8_SB(0, 1), cB + hstepB, voffB); PG8_STAGE(PG8_SA(0, 1), cA + hstepA, voffA);
        if (wr == 1) PG8_BAR;
        PG8_WAIT_V(4); PG8_BAR;
        PG8_STAGE(PG8_SB(1, 0), cB + kstep, voffB); PG8_STAGE(PG8_SA(1, 0), cA + kstep, voffA); PG8_STAGE(PG8_SB(1, 1), cB + hstepB + kstep, voffB);
        PG8_WAIT_V(6); PG8_BAR;
    }
    for (;;) {
        const bool has_next = S.next(ui + 1, nxt);
        const char* nA = has_next ? (const char*)g.A + (size_t)nxt.pm * tstepA : cA; const char* nB = has_next ? (const char*)g.Bt + (size_t)nxt.pn * tstepB : cB;
        for (int t = 0; t < nt; t += 2) {
            const bool last = (t == nt - 2);
            const char* a1 = cA + (size_t)(t + 1) * kstep;
            const char* a2 = last ? nA : cA + (size_t)(t + 2) * kstep; const char* b2 = last ? nB : cB + (size_t)(t + 2) * kstep;
            const char* a3 = a2 + kstep; const char* b3 = b2 + kstep;
            if (last && has_next) S.a_ready(nxt);
            if constexpr (SP2) {
            PG8_LDB(B0, 0, 0); PG8_LDB(B1, 0, 1); PG8_SCHED; PG8_LDA(At, 0, 0); PG8_STAGE(PG8_SA(1, 1), a1 + hstepA, voffA);
            PG8_WAIT_V(8); PG8_WAIT_L(0); PG8_BAR; PG8_MMA(0, 0, At, B0); PG8_MMA(0, 1, At, B1); PG8_BAR; PG8_SCHED;
            PG8_LDA(At, 0, 1); PG8_STAGE(PG8_SB(0, 0), b2, voffB); PG8_STAGE(PG8_SB(0, 1), b2 + hstepB, voffB); PG8_STAGE(PG8_SA(0, 0), a2, voffA);
            PG8_WAIT_V(8); PG8_WAIT_L(0); PG8_BAR; PG8_MMA(1, 0, At, B0); PG8_MMA(1, 1, At, B1); PG8_BAR; PG8_SCHED;
            PG8_LDB(B0, 1, 0); PG8_LDB(B1, 1, 1); PG8_SCHED; PG8_LDA(At, 1, 0); PG8_STAGE(PG8_SA(0, 1), a2 + hstepA, voffA);
            PG8_WAIT_V(8); PG8_WAIT_L(0); PG8_BAR; PG8_MMA(0, 0, At, B0); PG8_MMA(0, 1, At, B1); PG8_BAR; PG8_SCHED;
            PG8_LDA(At, 1, 1); PG8_STAGE(PG8_SB(1, 0), b3, voffB); PG8_STAGE(PG8_SB(1, 1), b3 + hstepB, voffB); PG8_STAGE(PG8_SA(1, 0), a3, voffA);
            PG8_WAIT_V(8); PG8_WAIT_L(0); PG8_BAR; PG8_MMA(1, 0, At, B0); PG8_MMA(1, 1, At, B1); PG8_BAR; PG8_SCHED;
            } else {
            PG8_LDB(B0, 0, 0); PG8_SCHED; PG8_LDA(At, 0, 0); PG8_STAGE(PG8_SA(1, 1), a1 + hstepA, voffA);
            PG8_WAIT_L(8); PG8_BAR; PG8_WAIT_L(0); PG8_MMA(0, 0, At, B0); PG8_BAR; PG8_SCHED;
            PG8_LDB(B1, 0, 1); PG8_STAGE(PG8_SB(0, 0), b2, voffB);
            PG8_BAR; PG8_WAIT_L(0); PG8_MMA(0, 1, At, B1); PG8_BAR;
            PG8_LDA(At, 0, 1); PG8_STAGE(PG8_SA(0, 0), a2, voffA);
            PG8_BAR; PG8_WAIT_L(0); PG8_MMA(1, 0, At, B0); PG8_BAR; PG8_SCHED;
            PG8_STAGE(PG8_SB(0, 1), b2 + hstepB, voffB);
            PG8_WAIT_V(6); PG8_BAR; PG8_MMA(1, 1, At, B1); PG8_BAR;
            PG8_LDB(B0, 1, 0); PG8_SCHED; PG8_LDA(At, 1, 0); PG8_STAGE(PG8_SA(0, 1), a2 + hstepA, voffA);
            PG8_WAIT_L(8); PG8_BAR; PG8_WAIT_L(0); PG8_MMA(0, 0, At, B0); PG8_BAR; PG8_SCHED;
            PG8_LDB(B1, 1, 1); PG8_STAGE(PG8_SB(1, 0), b3, voffB);
            PG8_BAR; PG8_WAIT_L(0); PG8_MMA(0, 1, At, B1); PG8_BAR;
            PG8_LDA(At, 1, 1); PG8_STAGE(PG8_SA(1, 0), a3, voffA);
            PG8_BAR; PG8_WAIT_L(0); PG8_MMA(1, 0, At, B0); PG8_BAR; PG8_SCHED;
            PG8_STAGE(PG8_SB(1, 1), b3 + hstepB, voffB);
            PG8_WAIT_V(6); PG8_BAR; PG8_MMA(1, 1, At, B1); PG8_BAR;
            }
        }
        if constexpr (ALIGN_EPI) { if (wr == 0) PG8_BAR; }
        if constexpr (!Epi::AFTER_DRAIN) { E(acc, cur, wr, wc, fr, fq); S.done(cur); }
        if (!has_next) break;
#pragma unroll
        for (int a = 0; a < 2; ++a)
#pragma unroll
            for (int b = 0; b < 2; ++b)
#pragma unroll
                for (int m = 0; m < 4; ++m)
#pragma unroll
                    for (int n = 0; n < 2; ++n) acc[a][b][m][n] = (f32x4){0.f, 0.f, 0.f, 0.f};
        cur = nxt; cA = nA; cB = nB; ++ui;
        if constexpr (ALIGN_EPI) { if (wr == 1) PG8_BAR; }
    }
    PG8_WAIT_V(0);
    if constexpr (!ALIGN_EPI) { if (wr == 0) PG8_BAR; }
    PG8_BAR;
    if constexpr (Epi::AFTER_DRAIN) { E.fused(acc, cur, wr, wc, fr, fq, lds, wid, lane); S.done(cur); }
#undef PG8_SA
#undef PG8_SB
#undef PG8_STAGE
#undef PG8_LDA
#undef PG8_LDB
#undef PG8_MMA
#undef PG8_WAIT_V
#undef PG8_WAIT_L
#undef PG8_BAR
#undef PG8_SCHED
}
}

#include <hip/hip_bf16.h>
#include <cmath>
namespace attn_body {
using bf16=__hip_bfloat16;
using bf16x8=__attribute__((ext_vector_type(8)))short;
using s16x4=__attribute__((ext_vector_type(4)))short;
using f32x16=__attribute__((ext_vector_type(16)))float;
using u32x4=__attribute__((ext_vector_type(4)))unsigned;
constexpr int D=64,QP=512,KP=128;
constexpr int NW=8,QBLK=32,QB=QBLK*NW,KVBLK=64;
__device__ __forceinline__ int crow(int r,int hi){return (r&3)+8*(r>>2)+4*hi;}
#define SBAR() __builtin_amdgcn_sched_barrier(0)
constexpr int NSLOT=3, SLOTB=8192;
constexpr int LDS_K=0, LDS_V=NSLOT*SLOTB, LDS_WS=2*NSLOT*SLOTB, LDS_OST=LDS_WS+NW*64*4, LDS_BYTES=LDS_OST+NW*4096;
constexpr float C2=0.125f*1.4426950408889634f;
__device__ __forceinline__ void glds16(const void*gsrc,unsigned lds_dst){unsigned keep;
  asm volatile("s_mov_b32 %0, m0\n\ts_mov_b32 m0, %2\n\ts_nop 0\n\tglobal_load_lds_dwordx4 %1, off\n\ts_mov_b32 m0, %0":"=&s"(keep):"v"(gsrc),"s"(lds_dst):"memory");}
__device__ __forceinline__ float max3f(float a,float b,float c){float r;asm("v_max3_f32 %0, %1, %2, %3":"=v"(r):"v"(a),"v"(b),"v"(c));return r;}
__device__ __forceinline__ float max2f(float a,float b){float r;asm("v_max_f32_e32 %0, %1, %2":"=v"(r):"v"(a),"v"(b));return r;}
__device__ __forceinline__ float fadd_s(float a,float b){float r;asm("v_add_f32_e32 %0, %1, %2":"=v"(r):"v"(a),"v"(b));return r;}
__device__ __forceinline__ float fsub_s(float a,float b){float r;asm("v_sub_f32_e32 %0, %1, %2":"=v"(r):"v"(a),"v"(b));return r;}
typedef float f32x2_t __attribute__((ext_vector_type(2))); typedef __bf16 bf16x2_t __attribute__((ext_vector_type(2)));
__device__ __forceinline__ unsigned cvtpk_s(float lo,float hi){f32x2_t v={lo,hi};bf16x2_t b=__builtin_convertvector(v,bf16x2_t);return __builtin_bit_cast(unsigned,b);}
#define WAIT_BAR(N) asm volatile("s_waitcnt vmcnt(" #N ") lgkmcnt(0)\n\ts_barrier":::"memory")

__device__ __forceinline__ void qkt(f32x16&p0,f32x16&p1,const char*Kslot,const bf16x8*qr,const f32x16&negm,int r32,int hi){
  const char*kb=Kslot+hi*1024+r32*16;
  #pragma unroll
  for(int d0=0;d0<4;++d0){
    const bf16x8 b0=*reinterpret_cast<const bf16x8*>(kb+d0*2048);
    const bf16x8 b1=*reinterpret_cast<const bf16x8*>(kb+d0*2048+512);
    if(d0==0){p0=__builtin_amdgcn_mfma_f32_32x32x16_bf16(b0,qr[0],negm,0,0,0);p1=__builtin_amdgcn_mfma_f32_32x32x16_bf16(b1,qr[0],negm,0,0,0);}
    else{p0=__builtin_amdgcn_mfma_f32_32x32x16_bf16(b0,qr[d0],p0,0,0,0);p1=__builtin_amdgcn_mfma_f32_32x32x16_bf16(b1,qr[d0],p1,0,0,0);}}
}
typedef __attribute__((address_space(3))) const char* lds_cptr;
typedef short v4i16_t __attribute__((ext_vector_type(4)));
__device__ __forceinline__ void kload8(bf16x8*kf,lds_cptr kp){
  kf[0]=*(const __attribute__((address_space(3))) bf16x8*)(kp);      kf[1]=*(const __attribute__((address_space(3))) bf16x8*)(kp+512);
  kf[2]=*(const __attribute__((address_space(3))) bf16x8*)(kp+2048); kf[3]=*(const __attribute__((address_space(3))) bf16x8*)(kp+2560);
  kf[4]=*(const __attribute__((address_space(3))) bf16x8*)(kp+4096); kf[5]=*(const __attribute__((address_space(3))) bf16x8*)(kp+4608);
  kf[6]=*(const __attribute__((address_space(3))) bf16x8*)(kp+6144); kf[7]=*(const __attribute__((address_space(3))) bf16x8*)(kp+6656);
}
__device__ __forceinline__ void kload2(bf16x8*kf,lds_cptr kp,int j){ kf[2*j]=*(const __attribute__((address_space(3))) bf16x8*)(kp+j*2048); kf[2*j+1]=*(const __attribute__((address_space(3))) bf16x8*)(kp+j*2048+512); }
__device__ __forceinline__ s16x4 vtr(lds_cptr p){ return __builtin_bit_cast(s16x4,__builtin_amdgcn_ds_read_tr16_b64_v4i16((__attribute__((address_space(3))) v4i16_t*)p)); }
__device__ __forceinline__ float rowmax(const f32x16&p0,const f32x16&p1){
  float a=max3f(p0[0],p0[1],p1[0]),b=max3f(p0[2],p0[3],p1[1]);a=max3f(a,p1[2],p1[3]);
  #pragma unroll
  for(int r=4;r<16;r+=4){a=max3f(a,p0[r],p0[r+1]);b=max3f(b,p0[r+2],p0[r+3]);a=max3f(a,p1[r],p1[r+1]);b=max3f(b,p1[r+2],p1[r+3]);}
  const float m=max2f(a,b);
  auto rr=__builtin_amdgcn_permlane32_swap(__float_as_uint(m),__float_as_uint(m),false,false);
  return max2f(__uint_as_float(rr[0]),__uint_as_float(rr[1]));
}
__device__ __forceinline__ void pv(f32x16*o,int vb,bf16x8 pa0,bf16x8 pa1,bf16x8 pa2,bf16x8 pa3){
  #pragma unroll
  for(int d0=0;d0<2;++d0){s16x4 lo[4],hi[4];
    #pragma unroll
    for(int ks=0;ks<4;++ks){
      asm volatile("ds_read_b64_tr_b16 %0,%1 offset:%c2":"=&v"(lo[ks]):"v"(vb),"i"(d0*4096+ks*1024):"memory");
      asm volatile("ds_read_b64_tr_b16 %0,%1 offset:%c2":"=&v"(hi[ks]):"v"(vb),"i"(d0*4096+ks*1024+512):"memory");}
    asm volatile("s_waitcnt lgkmcnt(0)":::"memory");SBAR();
    #define PK(k) (bf16x8){lo[k][0],lo[k][1],lo[k][2],lo[k][3],hi[k][0],hi[k][1],hi[k][2],hi[k][3]}
    o[d0]=__builtin_amdgcn_mfma_f32_32x32x16_bf16(pa0,PK(0),o[d0],0,0,0);
    o[d0]=__builtin_amdgcn_mfma_f32_32x32x16_bf16(pa1,PK(1),o[d0],0,0,0);
    o[d0]=__builtin_amdgcn_mfma_f32_32x32x16_bf16(pa2,PK(2),o[d0],0,0,0);
    o[d0]=__builtin_amdgcn_mfma_f32_32x32x16_bf16(pa3,PK(3),o[d0],0,0,0);
    #undef PK
  }
}

#ifndef ATTN_STORE16
#define ATTN_STORE16(p,v) (*(u32x4*)(p)=(v))
#endif
template<int THRL> __device__ __forceinline__ void attn_unit(long qrow0,long kvrow0,int h,int qb,int Tk,const bf16*Q,const bf16*__restrict__ K,const bf16*__restrict__ V,bf16*O,char*shm){
  const int tid=threadIdx.x,lane=tid&63,r32=lane&31,hi=lane>>5; const int wid=__builtin_amdgcn_readfirstlane(tid>>6);
  const int q0=qb*QB;
  const bf16*Qw=Q+(qrow0+q0+wid*QBLK)*QP+h*D;
  const bf16*Kh=K+kvrow0*KP+(h>>2)*D,*Vh=V+kvrow0*KP+(h>>2)*D;
  const unsigned lds0=(unsigned)(uintptr_t)shm;
  float*wsf=(float*)(shm+LDS_WS)+wid*64;
  const bf16*ksrc=Kh+(long)lane*KP+wid*8;
  const bf16*vsrc=Vh+(long)(16*(wid&3)+(lane>>2))*KP+(wid>>2)*32+(lane&3)*8;
  const unsigned kdst=lds0+LDS_K+wid*1024, vdst=lds0+LDS_V+wid*1024;
  #define DMA_K(t,slot) glds16(ksrc+(long)(t)*KVBLK*KP,(unsigned)__builtin_amdgcn_readfirstlane(kdst+(slot)))
  #define DMA_V(t,slot) glds16(vsrc+(long)(t)*KVBLK*KP,(unsigned)__builtin_amdgcn_readfirstlane(vdst+(slot)))
  const int vb0=(int)(lds0+LDS_V)+((lane>>4)&1)*32+(lane&3)*8+(4*hi+((lane&15)>>2))*64;
  const char*Kbase=shm+LDS_K; bf16x8 kf[8];
  const lds_cptr shm3=(lds_cptr)shm; const lds_cptr kp0=shm3+LDS_K+hi*1024+r32*16; const lds_cptr vp0=shm3+LDS_V+((lane>>4)&1)*32+(lane&3)*8+(4*hi+((lane&15)>>2))*64;
  const int NT=Tk/KVBLK;
  DMA_K(0,0);DMA_V(0,0);DMA_K(1,SLOTB);
  bf16x8 qr[4];
  #pragma unroll
  for(int d0=0;d0<4;++d0)qr[d0]=*reinterpret_cast<const bf16x8*>(&Qw[(long)r32*QP+d0*16+hi*8]);
  float mhat=0.f,l_reg=0.f;f32x16 o[2];o[0]=f32x16{};o[1]=f32x16{};f32x16 negm=f32x16{};asm volatile("":"+v"(negm));
  #define CMASK(P0,P1,t) do{}while(0)
  bool resc=false;
  #define START(P0,P1) do{ const float rm=rowmax(P0,P1); resc=false; \
    { const float dl=rm; mhat=fadd_s(mhat,dl); \
      _Pragma("unroll") for(int r=0;r<16;++r){P0[r]=fsub_s(P0[r],dl);P1[r]=fsub_s(P1[r],dl);} \
      _Pragma("unroll") for(int r=0;r<16;++r)negm[r]=-mhat; asm volatile("":"+v"(negm)); } \
    _Pragma("unroll") for(int r=0;r<16;++r)P0[r]=__builtin_amdgcn_exp2f(P0[r]); }while(0)
  #define RESC() do{ if(resc){ asm volatile("s_waitcnt lgkmcnt(0)":::"memory"); \
      _Pragma("unroll") for(int d_=0;d_<2;++d_) _Pragma("unroll") for(int r=0;r<16;++r)o[d_][r]*=wsf[crow(r,hi)]; } }while(0)
  f32x16 pA0,pA1,pB0,pB1;
  int sl_prev=0,sl_cur=0,sl_next=SLOTB;
  #define ROT() do{sl_prev=sl_cur;sl_cur=sl_next;sl_next=(sl_next==(NSLOT-1)*SLOTB)?0:sl_next+SLOTB;}while(0)
  DMA_K(2,2*SLOTB);
  WAIT_BAR(3);
  qkt(pA0,pA1,Kbase,qr,negm,r32,hi);asm volatile("s_nop 15\n\ts_nop 7":"+v"(pA0),"+v"(pA1));CMASK(pA0,pA1,0);
  START(pA0,pA1);
  _Pragma("unroll") for(int r=0;r<16;++r)pA1[r]=__builtin_amdgcn_exp2f(pA1[r]);
  WAIT_BAR(0);
  DMA_K(3,0);DMA_V(1,SLOTB);
  ROT();
  kload8(kf,kp0+sl_cur);
  WAIT_BAR(2);
  s16x4 vlo[8],vhi[8]; u32x4 pw0,pw1,pw2,pw3;
  #define PKW(P,B) cvtpk_s(P[B],P[B+1])
  #define PAF(k) __builtin_bit_cast(bf16x8,pw##k)
  #define VFR(i) (bf16x8){vlo[i][0],vlo[i][1],vlo[i][2],vlo[i][3],vhi[i][0],vhi[i][1],vhi[i][2],vhi[i][3]}
  #define PIN(x) asm volatile("":"+v"(x))
  #define MX3(a,b,c) __builtin_fmaxf(__builtin_fmaxf((a),(b)),(c))
  #define GAPA(MF,A0,A1,A2,A3,W0,W1,PW) do{ MF; sacc+=A0; sacc+=A1; sacc+=A2; sacc+=A3; PIN(sacc); W0; W1; PIN(PW); SBAR(); }while(0)
  #define EX(v) __builtin_amdgcn_exp2f(v)
  #define GAPB(MF,X,B) do{ MF; X[B]=EX(X[B]); X[B+1]=EX(X[B+1]); X[B+2]=EX(X[B+2]); X[B+3]=EX(X[B+3]); PIN(X); SBAR(); }while(0)
  #define VRD(i) do{ vlo[i]=vtr(vp_+(((i)>>2)*4096+((i)&3)*1024)); vhi[i]=vtr(vp_+(((i)>>2)*4096+((i)&3)*1024+512)); }while(0)
  #define KRD(G,j) do{ if(G){ kload2(kf,kp0+sl_next,j); SBAR(); } }while(0)
  #define STEP(C0,C1,P0,P1,t,GK,GV,GL) do{ SBAR(); \
    const lds_cptr vp_=vp0+sl_prev; \
    VRD(0); SBAR(); float sacc=(P0[0]+P0[1]); \
    GAPA(C0=__builtin_amdgcn_mfma_f32_32x32x16_bf16(kf[0],qr[0],negm,0,0,0), P0[2],P0[3],P0[4],P0[5],     pw0[0]=PKW(P0,0), pw0[1]=PKW(P0,2), pw0); \
    VRD(4); SBAR(); GAPA(C1=__builtin_amdgcn_mfma_f32_32x32x16_bf16(kf[1],qr[0],negm,0,0,0), P0[6],P0[7],P0[8],P0[9],     pw0[2]=PKW(P0,4), pw0[3]=PKW(P0,6), pw0); \
    VRD(1); SBAR(); GAPA(C0=__builtin_amdgcn_mfma_f32_32x32x16_bf16(kf[2],qr[1],C0,0,0,0),   P0[10],P0[11],P0[12],P0[13], pw1[0]=PKW(P0,8), pw1[1]=PKW(P0,10), pw1); \
    VRD(5); SBAR(); GAPA(C1=__builtin_amdgcn_mfma_f32_32x32x16_bf16(kf[3],qr[1],C1,0,0,0),   P0[14],P0[15],P1[0],P1[1],   pw1[2]=PKW(P0,12),pw1[3]=PKW(P0,14), pw1); \
    VRD(2); SBAR(); GAPA(C0=__builtin_amdgcn_mfma_f32_32x32x16_bf16(kf[4],qr[2],C0,0,0,0),   P1[2],P1[3],P1[4],P1[5],     pw2[0]=PKW(P1,0), pw2[1]=PKW(P1,2), pw2); \
    VRD(6); SBAR(); GAPA(C1=__builtin_amdgcn_mfma_f32_32x32x16_bf16(kf[5],qr[2],C1,0,0,0),   P1[6],P1[7],P1[8],P1[9],     pw2[2]=PKW(P1,4), pw2[3]=PKW(P1,6), pw2); \
    VRD(3); SBAR(); GAPA(C0=__builtin_amdgcn_mfma_f32_32x32x16_bf16(kf[6],qr[3],C0,0,0,0),   P1[10],P1[11],P1[12],P1[13], pw3[0]=PKW(P1,8), pw3[1]=PKW(P1,10), pw3); \
    VRD(7); SBAR(); GAPA(C1=__builtin_amdgcn_mfma_f32_32x32x16_bf16(kf[7],qr[3],C1,0,0,0),   P1[14],P1[15],0.f,0.f,       pw3[2]=PKW(P1,12),pw3[3]=PKW(P1,14), pw3); \
    l_reg+=sacc; \
    if(GK){DMA_K((t)+3,sl_cur);} if(GV){DMA_V((t)+1,sl_next);} \
    CMASK(C0,C1,t); \
    { float a=MX3(C0[0],C0[1],C1[0]),b=MX3(C0[2],C0[3],C1[1]); a=MX3(a,C1[2],C1[3]); \
      _Pragma("unroll") for(int r=4;r<16;r+=4){a=MX3(a,C0[r],C0[r+1]);b=MX3(b,C0[r+2],C0[r+3]);a=MX3(a,C1[r],C1[r+1]);b=MX3(b,C1[r+2],C1[r+3]);} \
      float rm=__builtin_fmaxf(a,b); { auto rr=__builtin_amdgcn_permlane32_swap(__float_as_uint(rm),__float_as_uint(rm),false,false); rm=__builtin_fmaxf(__uint_as_float(rr[0]),__uint_as_float(rr[1])); } \
      resc=false; \
      if(__builtin_expect(__any(rm>(float)THRL),0)){ const float dl=__builtin_fmaxf(rm,0.f); mhat+=dl; \
        _Pragma("unroll") for(int r=0;r<16;++r){C0[r]-=dl;C1[r]-=dl;} \
        _Pragma("unroll") for(int r=0;r<16;++r)negm[r]=-mhat; asm volatile("":"+v"(negm)); \
        const float f=__builtin_amdgcn_exp2f(-dl); l_reg*=f; if(hi==0)wsf[r32]=f; resc=true; } } \
    SBAR(); \
    GAPB(o[0]=__builtin_amdgcn_mfma_f32_32x32x16_bf16(PAF(0),VFR(0),o[0],0,0,0), C0,0); \
    GAPB(o[1]=__builtin_amdgcn_mfma_f32_32x32x16_bf16(PAF(0),VFR(4),o[1],0,0,0), C0,4); \
    KRD(GL,0); GAPB(o[0]=__builtin_amdgcn_mfma_f32_32x32x16_bf16(PAF(1),VFR(1),o[0],0,0,0), C0,8); \
    KRD(GL,1); GAPB(o[1]=__builtin_amdgcn_mfma_f32_32x32x16_bf16(PAF(1),VFR(5),o[1],0,0,0), C0,12); \
    KRD(GL,2); GAPB(o[0]=__builtin_amdgcn_mfma_f32_32x32x16_bf16(PAF(2),VFR(2),o[0],0,0,0), C1,0); \
    KRD(GL,3); GAPB(o[1]=__builtin_amdgcn_mfma_f32_32x32x16_bf16(PAF(2),VFR(6),o[1],0,0,0), C1,4); \
    GAPB(o[0]=__builtin_amdgcn_mfma_f32_32x32x16_bf16(PAF(3),VFR(3),o[0],0,0,0), C1,8); \
    GAPB(o[1]=__builtin_amdgcn_mfma_f32_32x32x16_bf16(PAF(3),VFR(7),o[1],0,0,0), C1,12); \
    }while(0)
  int t=1;
  for(;t+5<NT;t+=2){
    STEP(pB0,pB1,pA0,pA1,t,true,true,true);     WAIT_BAR(2); RESC(); ROT();
    STEP(pA0,pA1,pB0,pB1,t+1,true,true,true);   WAIT_BAR(2); RESC(); ROT();
  }
  #define ENDW(tt) do{ if((tt)+3<NT){WAIT_BAR(2);} else if((tt)+2<NT){WAIT_BAR(1);} else {WAIT_BAR(0);} }while(0)
  for(;t+1<NT;t+=2){
    STEP(pB0,pB1,pA0,pA1,t,(t+3<NT),(t+1<NT),(t+1<NT));       ENDW(t);   RESC(); ROT();
    STEP(pA0,pA1,pB0,pB1,t+1,(t+4<NT),(t+2<NT),(t+2<NT));     ENDW(t+1); RESC(); ROT();
  }
  STEP(pB0,pB1,pA0,pA1,NT-1,false,false,false); RESC();
  { float sacc=pB0[0]+pB0[1]; _Pragma("unroll") for(int r=2;r<16;++r)sacc+=pB0[r]; _Pragma("unroll") for(int r=0;r<16;++r)sacc+=pB1[r]; l_reg+=sacc;
    pw0=(u32x4){PKW(pB0,0),PKW(pB0,2),PKW(pB0,4),PKW(pB0,6)};pw1=(u32x4){PKW(pB0,8),PKW(pB0,10),PKW(pB0,12),PKW(pB0,14)};pw2=(u32x4){PKW(pB1,0),PKW(pB1,2),PKW(pB1,4),PKW(pB1,6)};pw3=(u32x4){PKW(pB1,8),PKW(pB1,10),PKW(pB1,12),PKW(pB1,14)};
    SBAR(); pv(o,vb0+sl_cur,PAF(0),PAF(1),PAF(2),PAF(3)); }
  #undef PKW
  #undef PAF
  #undef VFR
  #undef PIN
  #undef MX3
  #undef GAPA
  #undef GAPB
  #undef EX
  #undef VRD
  #undef KRD
  #undef STEP
  #undef ENDW
  {auto rr=__builtin_amdgcn_permlane32_swap(__float_as_uint(l_reg),__float_as_uint(l_reg),false,false);l_reg=__uint_as_float(rr[0])+__uint_as_float(rr[1]);}
  if(hi==0)wsf[32+r32]=l_reg;asm volatile("s_waitcnt lgkmcnt(0)":::"memory");
  float rli[16];
  #pragma unroll
  for(int r=0;r<16;++r)rli[r]=__builtin_amdgcn_rcpf(wsf[32+crow(r,hi)]);
  bf16*Ow=O+(qrow0+q0+wid*QBLK)*QP+h*D;
  { bf16*stg=(bf16*)(shm+LDS_OST)+wid*2048;
    #pragma unroll
    for(int r=0;r<16;++r){const int orow=crow(r,hi);
      #pragma unroll
      for(int d0=0;d0<2;++d0)stg[orow*64+d0*32+r32]=__float2bfloat16(o[d0][r]*rli[r]);}
    asm volatile("s_waitcnt lgkmcnt(0)":::"memory");
    #pragma unroll
    for(int i=0;i<4;++i){const int row=i*8+(lane>>3),ch=lane&7; const u32x4 v=*(const u32x4*)(stg+row*64+ch*8); ATTN_STORE16(Ow+(long)row*QP+ch*8,v);} }
  asm volatile("s_waitcnt lgkmcnt(0)\n\ts_barrier":::"memory");
  #undef DMA_K
  #undef DMA_V
  #undef CMASK
  #undef START
  #undef RESC
  #undef ROT
}
constexpr int ATTN_LDS_BYTES=LDS_BYTES;
#undef SBAR
#undef WAIT_BAR
}

#define GAS __attribute__((address_space(1)))
#define LAS __attribute__((address_space(3)))
#define DEV __device__ __forceinline__
typedef unsigned short bf16_t;
typedef float f32x4 __attribute__((ext_vector_type(4)));
typedef unsigned u32x4 __attribute__((ext_vector_type(4)));
typedef unsigned u32x2 __attribute__((ext_vector_type(2)));
typedef short bf16x8 __attribute__((ext_vector_type(8)));
template <int CTRL> DEV float dpp(float x) { return __builtin_bit_cast(float, __builtin_amdgcn_mov_dpp(__builtin_bit_cast(int, x), CTRL, 0xf, 0xf, true)); }
template <int CTRL, int ROWMASK> DEV float dpp_bcast_add(float v) { return v + __builtin_bit_cast(float, __builtin_amdgcn_update_dpp(0, __builtin_bit_cast(int, v), CTRL, ROWMASK, 0xf, false)); }
DEV float readlane63(float v) { return __builtin_bit_cast(float, __builtin_amdgcn_readlane(__builtin_bit_cast(int, v), 63)); }
DEV f32x4 mfma16(bf16x8 a, bf16x8 b, f32x4 c) { return __builtin_amdgcn_mfma_f32_16x16x32_bf16(a, b, c, 0, 0, 0); }
#define LDS_WAIT() asm volatile("s_waitcnt lgkmcnt(0)" ::: "memory")
#define SCHED_BARRIER() __builtin_amdgcn_sched_barrier(0)
#define OPAQUE(x) asm volatile("" : "+v"(x))
#define BAR_LDS() asm volatile("s_waitcnt lgkmcnt(0)\n\ts_barrier" ::: "memory")
constexpr int DMODEL = 1024;
constexpr int NCTX = 16, TCTX = 256, NLAT = 4, TLAT = 4096, PAST = 512, TKL = PAST + TLAT;
constexpr int MCTX = NCTX * TCTX, MLAT = NLAT * TLAT, MROWS = MCTX + MLAT;
constexpr int L0_IN = 3520, L0_INP = 3584, L0_LD = 3520;
constexpr int L1_IN = 3628, L1_INP = 3840, L1_LD = 3632;
constexpr int C0_R = 0, C0_K = 512, C0_V = 1024, C0_WF = 1536, C0_WB = 1600, C0_A = 1664, C0_RWG = 1728, C0_Q = 2240, C0_AK = 2752, C0_AV = 2880, C0_ATG = 3008;
constexpr int C1_GQ = 0, C1_GK = 256, C1_GV = 512, C1_GF = 1024, C1_GB = 1040, C1_GLG = 1056, C1_DQKV = 1568, C1_AF = 3104, C1_AB = 3108, C1_BETA = 3112, C1_GDG = 3116;
enum { I_XP = 0, I_XS, I_RWF, I_RWB, I_CK, I_CV, I_GLF, I_GLB, I_GDF, I_GDB, I_C, I_CCTX,
       I0_MODW, I0_MODB, I0_GPRE, I0_GPOST, I0_WIN, I0_WOUT, I0_MU, I0_W0F, I0_W2F, I0_W0B, I0_W2B, I0_A0, I0_A2, I0_KK, I0_KA, I0_RK, I0_GNG, I0_GNB, I0_GQ, I0_GK,
       I1_MODW, I1_MODB, I1_GPRE, I1_GPOST, I1_WIN, I1_WOUT, I1_G2F, I1_GBF, I1_G2B, I1_GBB, I1_GLN, I1_CONV, I1_ALF, I1_DTF, I1_ALB, I1_DTB, I1_GDN, N_IN };
static_assert(N_IN == 49, "49 inputs");
constexpr size_t O_Y = 0, O_RWF = 20971520, O_RWB = 21495808, O_NK = 22020096, O_NV = 22544384, O_GLF = 23068672, O_GLB = 23592960, O_GDF = 24117248, O_GDB = 25165824, O_END = 26214400;
constexpr size_t MiB = 1u << 20;
constexpr size_t WS_LORA = 256 * 1024;
constexpr size_t WS_MODV = 1 * MiB;
constexpr size_t WS_MODV2 = 448 * 1024;
constexpr size_t WS_ROPE = 1 * MiB + 128 * 1024;
constexpr size_t WS_CORR = 1 * MiB + 256 * 1024;
constexpr size_t WS_W0IN = 2 * MiB, WS_W0OUT = 9 * MiB, WS_W1IN = 11 * MiB, WS_W1OUT = 19 * MiB;
constexpr size_t WS_KC = 21 * MiB, WS_VC = 22 * MiB, WS_KL = 23 * MiB, WS_VL = 23 * MiB + 4608 * 1024;
constexpr size_t WS_XA = 32 * MiB, WS_XB = 72 * MiB;
constexpr size_t WS_PROJ = 112 * MiB;
static_assert(WS_W0IN + (size_t)L0_INP * 1024 * 2 <= WS_W0OUT && WS_W1IN + (size_t)L1_INP * 1024 * 2 <= WS_W1OUT && WS_VL + 4608 * 1024 <= WS_XA, "ws map");
static_assert(WS_XA + (size_t)MROWS * 2048 == WS_XB && WS_XB + (size_t)MROWS * 2048 == WS_PROJ && WS_PROJ + (size_t)MROWS * L1_LD * 2 <= 256 * MiB, "ws map");
static_assert(WS_CORR + (size_t)MROWS * 8 * 4 <= WS_W0IN, "ws map");
constexpr int LDS_BYTES = 147456;

struct Args { const float* in[N_IN]; float* out; unsigned char* ws; int ph_lo, ph_hi, flags, pad; };

#if defined(EMU)
struct BufRes { unsigned char* p; };
DEV BufRes make_buf(const void* p) { return BufRes{(unsigned char*)p}; }
DEV unsigned buf_ld16(BufRes r, unsigned voff, unsigned soff) { return *(const unsigned short*)(r.p + voff + soff); }
DEV void bst16(BufRes r, unsigned off, u32x4 v) { *(u32x4*)(r.p + off) = v; }
DEV void bst8(BufRes r, unsigned off, u32x2 v) { *(u32x2*)(r.p + off) = v; }
DEV u32x4 bld16(BufRes r, unsigned voff, unsigned soff) { return *(const u32x4*)(r.p + voff + soff); }
DEV u32x2 bld8(BufRes r, unsigned voff, unsigned soff) { return *(const u32x2*)(r.p + voff + soff); }
DEV u32x2 bld8nt(BufRes r, unsigned voff, unsigned soff) { return *(const u32x2*)(r.p + voff + soff); }
DEV void buf_st16(BufRes r, unsigned voff, unsigned soff, unsigned v) { *(unsigned short*)(r.p + voff + soff) = (unsigned short)v; }
#else
typedef __amdgpu_buffer_rsrc_t BufRes;
DEV BufRes make_buf(const void* p) { return __builtin_amdgcn_make_buffer_rsrc((void*)p, 0, 0x7ffffffe, 0x00020000); }
DEV unsigned buf_ld16(BufRes r, unsigned voff, unsigned soff) { return __builtin_amdgcn_raw_buffer_load_b16(r, voff, soff, 0); }
DEV void bst16(BufRes r, unsigned off, u32x4 v) { __builtin_amdgcn_raw_buffer_store_b128(v, r, off, 0, 16); }
DEV void bst8(BufRes r, unsigned off, u32x2 v) { __builtin_amdgcn_raw_buffer_store_b64(v, r, off, 0, 16); }
DEV u32x4 bld16(BufRes r, unsigned voff, unsigned soff) { return __builtin_amdgcn_raw_buffer_load_b128(r, voff, soff, 16); }
DEV u32x2 bld8(BufRes r, unsigned voff, unsigned soff) { return __builtin_amdgcn_raw_buffer_load_b64(r, voff, soff, 16); }
DEV u32x2 bld8nt(BufRes r, unsigned voff, unsigned soff) { return __builtin_amdgcn_raw_buffer_load_b64(r, voff, soff, 18); }
DEV void buf_st16(BufRes r, unsigned voff, unsigned soff, unsigned v) { __builtin_amdgcn_raw_buffer_store_b16((unsigned short)v, r, voff, soff, 0); }
#endif
DEV float bf2f(unsigned u16) { return __uint_as_float(u16 << 16); }
DEV unsigned f2bf_sw(float f) { unsigned u = __float_as_uint(f); return (u + 0x7fffu + ((u >> 16) & 1u)) >> 16; }
#if defined(EMU)
DEV unsigned pk2_sw(float lo, float hi) { return f2bf_sw(lo) | (f2bf_sw(hi) << 16); }
#else
DEV unsigned rne16_(float f) { const unsigned u = __float_as_uint(f); return u + 0x7fffu + ((u >> 16) & 1u); }
DEV unsigned pk2_sw(float lo, float hi) { return __builtin_amdgcn_perm(rne16_(hi), rne16_(lo), 0x07060302u); }
#endif
DEV unsigned f2bf(float f) { return f2bf_sw(f); }
DEV unsigned pk2(float lo, float hi) { return pk2_sw(lo, hi); }
DEV void unpack8(const u32x4 v, float (&f)[8]) {
    f[0] = __uint_as_float(v.x << 16); f[1] = __uint_as_float(v.x & 0xffff0000u); f[2] = __uint_as_float(v.y << 16); f[3] = __uint_as_float(v.y & 0xffff0000u);
    f[4] = __uint_as_float(v.z << 16); f[5] = __uint_as_float(v.z & 0xffff0000u); f[6] = __uint_as_float(v.w << 16); f[7] = __uint_as_float(v.w & 0xffff0000u);
}
DEV void ld8(const bf16_t* p, float (&f)[8]) { unpack8(*(const u32x4*)p, f); }
DEV void ld8h(const bf16_t* p, float (&f)[8]) { const u32x2 a = *(const u32x2*)p, b = *(const u32x2*)(p + 4); unpack8((u32x4){a.x, a.y, b.x, b.y}, f); }
DEV u32x4 pack8(const float (&f)[8]) { u32x4 v; v.x = pk2(f[0], f[1]); v.y = pk2(f[2], f[3]); v.z = pk2(f[4], f[5]); v.w = pk2(f[6], f[7]); return v; }
DEV void st8(bf16_t* p, const float (&f)[8]) { *(u32x4*)p = pack8(f); }
#if defined(EMU)
DEV float rcpf_(float x) { return 1.f / x; }
DEV float rsqf_(float x) { return 1.f / sqrtf(x); }
#else
DEV float rsqf_(float x) { return __builtin_amdgcn_rsqf(x); }
DEV float rcpf_(float x) { return __builtin_amdgcn_rcpf(x); }
#endif
DEV float sigmoidf_(float x) { return rcpf_(1.f + __expf(-x)); }
DEV float siluf_(float x) { return x * rcpf_(1.f + __expf(-x)); }
DEV float tanhf_(float x) { return 1.f - 2.f * rcpf_(__expf(2.f * x) + 1.f); }
DEV float log_sigmoidf_(float x) { return fminf(x, 0.f) - __logf(1.f + __expf(-fabsf(x))); }
DEV float softplusf_(float x) { return fmaxf(x, 0.f) + __logf(1.f + __expf(-fabsf(x))); }
DEV float sum4(float x) { x += dpp<0xB1>(x); x += dpp<0x4E>(x); return x; }
DEV float sum8(float x) { x = sum4(x); x += dpp<0x141>(x); return x; }
DEV float sum16(float x) { x = sum8(x); x += dpp<0x128>(x); return x; }
#if defined(EMU)
DEV float wave_sum(float v) {
#pragma unroll
    for (int o = 1; o < 64; o <<= 1) v += __shfl_xor(v, o);
    return v;
}
#else
DEV float wave_sum(float v) { v = sum16(v); v = dpp_bcast_add<0x142, 0xa>(v); v = dpp_bcast_add<0x143, 0xc>(v); return readlane63(v); }
#endif
DEV bf16x8 acc2b(const f32x4 lo, const f32x4 hi) {
    const unsigned a = pk2(lo[0], lo[1]), b = pk2(lo[2], lo[3]), c = pk2(hi[0], hi[1]), d = pk2(hi[2], hi[3]);
    return __builtin_bit_cast(bf16x8, (u32x4){a, b, c, d});
}
DEV bf16x8 ldperm(const LAS bf16_t* p) { const u32x2 lo = *(const LAS u32x2*)p, hi = *(const LAS u32x2*)(p + 16); return __builtin_bit_cast(bf16x8, (u32x4){lo.x, lo.y, hi.x, hi.y}); }
DEV bf16x8 ldfrag(const LAS bf16_t* p) { return *(const LAS bf16x8*)p; }

struct EpiStoreBf16 {
    static constexpr bool PERM = true, AFTER_DRAIN = false;
    bf16_t* O; int ldc;
    __device__ __forceinline__ void operator()(const pg8::f32x4 (&acc)[2][2][4][2], const pg8::Unit& u, int wr, int wc, int fr, int fq) const {
        const int row0 = u.pm * 256 + wr * 64 + fr, col0 = u.pn * 256 + wc * 32 + 8 * fq;
#pragma unroll
        for (int ai = 0; ai < 2; ++ai)
#pragma unroll
            for (int m = 0; m < 4; ++m) { bf16_t* rowp = O + (size_t)(row0 + ai * 128 + m * 16) * ldc;
#pragma unroll
                for (int bj = 0; bj < 2; ++bj) { const int c = col0 + bj * 128;
                    if (c < ldc) { const pg8::f32x4 v0 = acc[ai][bj][m][0], v1 = acc[ai][bj][m][1]; u32x4 w; w.x = pk2(v0[0], v0[1]); w.y = pk2(v0[2], v0[3]); w.z = pk2(v1[0], v1[1]); w.w = pk2(v1[2], v1[3]);
                        *(u32x4*)(rowp + c) = w; } } }
    }
};
struct EpiStoreBf16Sig {
    static constexpr bool PERM = true, AFTER_DRAIN = false;
    bf16_t* O; int ldc; GAS unsigned* cnt;
    __device__ __forceinline__ void operator()(const pg8::f32x4 (&acc)[2][2][4][2], const pg8::Unit& u, int wr, int wc, int fr, int fq) const {
        const BufRes res = make_buf(O);
        const int row0 = u.pm * 256 + wr * 64 + fr, col0 = u.pn * 256 + wc * 32 + 8 * fq;
#pragma unroll
        for (int ai = 0; ai < 2; ++ai)
#pragma unroll
            for (int m = 0; m < 4; ++m) { const unsigned rowb = (unsigned)(row0 + ai * 128 + m * 16) * (unsigned)ldc;
#pragma unroll
                for (int bj = 0; bj < 2; ++bj) { const int c = col0 + bj * 128;
                    const pg8::f32x4 v0 = acc[ai][bj][m][0], v1 = acc[ai][bj][m][1]; u32x4 w; w.x = pk2(v0[0], v0[1]); w.y = pk2(v0[2], v0[3]); w.z = pk2(v1[0], v1[1]); w.w = pk2(v1[2], v1[3]);
                    bst16(res, (rowb + (unsigned)c) * 2u, w); } }
        asm volatile("s_waitcnt vmcnt(0)" ::: "memory");
        if ((threadIdx.x & 63) == 0) __hip_atomic_fetch_add(cnt + u.pm * 16, 1u, __ATOMIC_RELAXED, __HIP_MEMORY_SCOPE_AGENT);
    }
};
struct EpiStoreF32 {
    static constexpr bool PERM = false, AFTER_DRAIN = false;
    float* O; int ldc;
    __device__ __forceinline__ void operator()(const pg8::f32x4 (&acc)[2][2][4][2], const pg8::Unit& u, int wr, int wc, int fr, int fq) const {
        const int row0 = u.pm * 256 + wr * 64 + fr, col0 = u.pn * 256 + wc * 32 + 4 * fq;
#pragma unroll
        for (int ai = 0; ai < 2; ++ai)
#pragma unroll
            for (int m = 0; m < 4; ++m) { float* rowp = O + (size_t)(row0 + ai * 128 + m * 16) * ldc + col0;
#pragma unroll
                for (int bj = 0; bj < 2; ++bj)
#pragma unroll
                    for (int n = 0; n < 2; ++n) *(f32x4*)(rowp + bj * 128 + n * 16) = acc[ai][bj][m][n]; }
    }
};

__device__ __forceinline__ void transpose_item(const float* W, int K, int N, bf16_t* WT, LAS float* scr, int item, int nblk, int lane) {
    const int kb = item / nblk, nb = item % nblk, k0 = 64 * kb, n0 = 32 * nb;
    const int n = n0 + (lane & 31); const bool ok = n < N;
    float wv[32];
#pragma unroll
    for (int i = 0; i < 32; ++i) { const int kk = 2 * i + (lane >> 5); wv[i] = __builtin_nontemporal_load(&W[(size_t)(k0 + kk) * N + (ok ? n : 0)]); }
#pragma unroll
    for (int i = 0; i < 32; ++i) { const int kk = 2 * i + (lane >> 5); scr[kk * 33 + (lane & 31)] = ok ? wv[i] : 0.f; }
    LDS_WAIT();
    const int c = lane & 7;
#pragma unroll
    for (int j = 0; j < 4; ++j) { const int nn = (lane >> 3) + 8 * j; const LAS float* s = scr + (8 * c) * 33 + nn;
        u32x4 o; o.x = pk2(s[0 * 33], s[1 * 33]); o.y = pk2(s[2 * 33], s[3 * 33]); o.z = pk2(s[4 * 33], s[5 * 33]); o.w = pk2(s[6 * 33], s[7 * 33]);
        *(u32x4*)(WT + (size_t)(n0 + nn) * K + k0 + 8 * c) = o; }
    LDS_WAIT();
}

__device__ __forceinline__ void p0_prologue(const Args& a, LAS unsigned char* lds, int tid, int lane, int wave) {
    unsigned char* ws = a.ws;
    {
        LAS float* scr = (LAS float*)(lds + wave * 16384);
        const int gw = blockIdx.x * 8 + wave, NGW = gridDim.x * 8;
        constexpr int I0 = 16 * (L0_INP / 32), I1 = 16 * 32, I2 = 16 * (L1_INP / 32), I3 = 16 * 32;
        for (int it = gw; it < I0 + I1 + I2 + I3; it += NGW) {
            int r = it;
            if (r < I0) { transpose_item(a.in[I0_WIN], 1024, L0_IN, (bf16_t*)(ws + WS_W0IN), scr, r, L0_INP / 32, lane); continue; } r -= I0;
            if (r < I1) { transpose_item(a.in[I0_WOUT], 1024, 1024, (bf16_t*)(ws + WS_W0OUT), scr, r, 32, lane); continue; } r -= I1;
            if (r < I2) { transpose_item(a.in[I1_WIN], 1024, L1_IN, (bf16_t*)(ws + WS_W1IN), scr, r, L1_INP / 32, lane); continue; } r -= I2;
            transpose_item(a.in[I1_WOUT], 1024, 1024, (bf16_t*)(ws + WS_W1OUT), scr, r, 32, lane);
        }
    }
    {
        const int gw = blockIdx.x * 8 + wave, NGW = gridDim.x * 8, li = lane & 15, g = lane >> 4;
        for (int it = gw; it < 192; it += NGW) { const int mat = it >> 6, h = (it >> 3) & 7, tn = (it >> 1) & 3, ks = it & 1;
            const float* W = a.in[mat == 0 ? I0_W2F : (mat == 1 ? I0_W2B : I0_A2)]; float tw[8];
#pragma unroll
            for (int jj = 0; jj < 8; ++jj) tw[jj] = W[(32 * ks + 8 * g + jj) * 512 + h * 64 + 16 * tn + li];
            *(u32x4*)(ws + WS_LORA + ((size_t)it * 64 + lane) * 16) = pack8(tw); }
    }
    __syncthreads();
    if (blockIdx.x < 192) {
        const int layer = blockIdx.x / 96, jc = (blockIdx.x % 96) >> 1, kh = blockIdx.x & 1;
        LAS float* sv = (LAS float*)lds; LAS float* red = (LAS float*)(lds + 32768);
        for (int u = tid; u < 5 * 512; u += 512) { const int c = u >> 9, i = 512 * kh + (u & 511); const float x = (c == 0) ? a.in[I_CCTX][i] : a.in[I_C][(c - 1) * 1024 + i]; sv[u] = siluf_(x); }
        __syncthreads();
        const float* mw = a.in[layer ? I1_MODW : I0_MODW];
        const int j = jc * 64 + lane;
        float acc0 = 0.f, acc1 = 0.f, acc2 = 0.f, acc3 = 0.f, acc4 = 0.f;
#pragma unroll 16
        for (int ii = 0; ii < 64; ++ii) { const int il = wave * 64 + ii; const float w = __builtin_nontemporal_load(&mw[(size_t)(512 * kh + il) * 3072 + j]);
            acc0 += sv[il] * w; acc1 += sv[512 + il] * w; acc2 += sv[1024 + il] * w; acc3 += sv[1536 + il] * w; acc4 += sv[2048 + il] * w; }
        red[(wave * 5 + 0) * 64 + lane] = acc0; red[(wave * 5 + 1) * 64 + lane] = acc1; red[(wave * 5 + 2) * 64 + lane] = acc2; red[(wave * 5 + 3) * 64 + lane] = acc3; red[(wave * 5 + 4) * 64 + lane] = acc4;
        __syncthreads();
        if (tid < 320) { const int c = tid >> 6; float s = kh ? 0.f : a.in[layer ? I1_MODB : I0_MODB][j];
#pragma unroll
            for (int w = 0; w < 8; ++w) s += red[(w * 5 + c) * 64 + lane];
            ((float*)(ws + (kh ? WS_MODV2 : WS_MODV)))[(layer * 5 + c) * 3072 + j] = s; }
    } else if (blockIdx.x == 192) {
        for (int idx = tid; idx < 1024; idx += 512) { const int pos = idx >> 4, j = idx & 15;
            const float inv = exp2f(-(float)j * (13.287712379549449f / 16.f)); const float ang = (float)pos * inv;
            ((float*)(ws + WS_ROPE))[2 * idx] = cosf(ang); ((float*)(ws + WS_ROPE))[2 * idx + 1] = sinf(ang); }
    }
}

__device__ __forceinline__ const float* xrow_ptr(const Args& a, int row) { return row < MCTX ? a.in[I_XP] + (size_t)row * 1024 : a.in[I_XS] + (size_t)(row - MCTX) * 1024; }
__device__ __forceinline__ int row_cv(int row) { return row < MCTX ? 0 : 1 + (row - MCTX) / TLAT; }
__device__ __forceinline__ float dot4(const f32x4 v) { return (v.x * v.x + v.y * v.y) + (v.z * v.z + v.w * v.w); }

struct RowPar { f32x4 c[4]; };
__device__ __forceinline__ RowPar rowpar_load(const float* p, int lane) { RowPar r;
#pragma unroll
    for (int j = 0; j < 4; ++j) r.c[j] = *(const f32x4*)(p + (64 * j + lane) * 4);
    return r; }
__device__ __forceinline__ RowPar modpar_load(const Args& a, int off, int lane) { RowPar r; const float* p0 = (const float*)(a.ws + WS_MODV) + off; const float* p1 = (const float*)(a.ws + WS_MODV2) + off;
#pragma unroll
    for (int j = 0; j < 4; ++j) r.c[j] = *(const f32x4*)(p0 + (64 * j + lane) * 4) + *(const f32x4*)(p1 + (64 * j + lane) * 4);
    return r; }
__device__ __forceinline__ void h0_compute(const f32x4 (&v)[4], const RowPar& g, const RowPar& sh, const RowPar& sc, bf16_t* xa_row, int lane) {
    float ss = 0.f;
#pragma unroll
    for (int j = 0; j < 4; ++j) ss += dot4(v[j]);
    const float rstd = rsqf_(wave_sum(ss) * (1.f / 1024.f) + 1e-6f);
#pragma unroll
    for (int j = 0; j < 4; ++j) { const int col = (64 * j + lane) * 4;
        const f32x4 h = v[j] * rstd * g.c[j] * (sc.c[j] + 1.f) + sh.c[j]; u32x2 w; w.x = pk2(h.x, h.y); w.y = pk2(h.z, h.w); *(u32x2*)(xa_row + col) = w; }
}
__device__ __forceinline__ void rows_h0(const Args& a, int lane, int gw, int NGW) {
    const float* modv = (const float*)(a.ws + WS_MODV); bf16_t* XA = (bf16_t*)(a.ws + WS_XA);
    const int per = (MROWS + NGW - 1) / NGW, r0 = gw * per, r1 = r0 + per < MROWS ? r0 + per : MROWS;
    const RowPar g = rowpar_load(a.in[I0_GPRE], lane); RowPar sh = g, sc = g; int cur = -1;
    for (int row = r0; row < r1; row += 2) {
        const int row2 = row + 1 < r1 ? row + 1 : row;
        const f32x4* xr = (const f32x4*)xrow_ptr(a, row) + lane; const f32x4* xr2 = (const f32x4*)xrow_ptr(a, row2) + lane;
        f32x4 v[4], w[4];
#pragma unroll
        for (int j = 0; j < 4; ++j) { v[j] = __builtin_nontemporal_load(&xr[64 * j]); w[j] = __builtin_nontemporal_load(&xr2[64 * j]); }
        if (row_cv(row) != cur) { cur = row_cv(row); sh = modpar_load(a, cur * 3072, lane); sc = modpar_load(a, cur * 3072 + 1024, lane); }
        h0_compute(v, g, sh, sc, XA + (size_t)row * 1024, lane);
        if (row2 != row) { if (row_cv(row2) != cur) { cur = row_cv(row2); sh = modpar_load(a, cur * 3072, lane); sc = modpar_load(a, cur * 3072 + 1024, lane); }
            h0_compute(w, g, sh, sc, XA + (size_t)row2 * 1024, lane); }
    }
}

__device__ __forceinline__ void rows_attn_prep(const Args& a, int lane, int gw, int NGW, int r0 = 0, int r1 = MROWS, int k0 = 0, int k1 = NLAT * PAST) {
    const bf16_t* PROJ = (const bf16_t*)(a.ws + WS_PROJ); const float* rope = (const float*)(a.ws + WS_ROPE);
    bf16_t* Qb = (bf16_t*)a.out; bf16_t* KC = (bf16_t*)(a.ws + WS_KC); bf16_t* VC = (bf16_t*)(a.ws + WS_VC); bf16_t* KL = (bf16_t*)(a.ws + WS_KL); bf16_t* VL = (bf16_t*)(a.ws + WS_VL);
    const BufRes qres = make_buf(Qb), kcres = make_buf(KC), vcres = make_buf(VC), klres = make_buf(KL), vlres = make_buf(VL);
    const int i8 = lane & 7;
    float gq[8], gk[8];
#pragma unroll
    for (int e = 0; e < 8; ++e) { gq[e] = a.in[I0_GQ][8 * i8 + e]; gk[e] = a.in[I0_GK][8 * i8 + e]; }
    for (int row = r0 + gw; row < r1; row += NGW) {
        const bf16_t* pr = PROJ + (size_t)row * L0_LD; const bool lat = row >= MCTX; const int t = lat ? (row - MCTX) % TLAT : 0; const int bl = lat ? (row - MCTX) / TLAT : 0;
        const int pos = (i8 < 4) ? (t >> 6) : (t & 63);
        float cs[8], sn[8];
#pragma unroll
        for (int e = 0; e < 8; ++e) { const int f = 8 * (i8 & 1) + e; cs[e] = lat ? rope[(pos * 16 + f) * 2] : 1.f; sn[e] = lat ? rope[(pos * 16 + f) * 2 + 1] : 0.f; }
        const float sgn = (i8 & 2) ? 1.f : -1.f;
        {
            float x[8]; unpack8(__builtin_nontemporal_load((const u32x4*)(pr + C0_Q + 8 * lane)), x); float ss = 0.f;
#pragma unroll
            for (int e = 0; e < 8; ++e) ss += x[e] * x[e];
            const float rstd = rsqf_(sum8(ss) * (1.f / 64.f) + 1e-6f);
            float y[8];
#pragma unroll
            for (int e = 0; e < 8; ++e) { const float v = x[e] * rstd * gq[e]; const float p = __shfl_xor(v, 2); y[e] = (v * cs[e] + sgn * p * sn[e]) * attn_body::C2; }
            bst16(qres, (unsigned)(row * 512 + 8 * lane) * 2u, pack8(y));
        }
        {
            const int l5 = lane & 31; const bool isv = l5 >= 16; const int l4 = l5 & 15;
            float x[8]; ld8(pr + (isv ? C0_AV : C0_AK) + 8 * l4, x); float ss = 0.f;
#pragma unroll
            for (int e = 0; e < 8; ++e) ss += x[e] * x[e];
            const float rstd = rsqf_(sum8(ss) * (1.f / 64.f) + 1e-6f);
            float y[8], z[8];
#pragma unroll
            for (int e = 0; e < 8; ++e) { const float v = x[e] * rstd * gk[e]; const float p = __shfl_xor(v, 2); y[e] = v; z[e] = v * cs[e] + sgn * p * sn[e]; }
            if (lane < 32) {
                if (!lat) {
                    float* o32 = a.out + (isv ? O_NV : O_NK) + (size_t)row * 128 + 8 * l4;
                    if (isv) { *(f32x4*)o32 = (f32x4){x[0], x[1], x[2], x[3]}; *(f32x4*)(o32 + 4) = (f32x4){x[4], x[5], x[6], x[7]}; bst16(vcres, (unsigned)(row * 128 + 8 * l4) * 2u, pack8(x)); }
                    else     { *(f32x4*)o32 = (f32x4){y[0], y[1], y[2], y[3]}; *(f32x4*)(o32 + 4) = (f32x4){y[4], y[5], y[6], y[7]}; bst16(kcres, (unsigned)(row * 128 + 8 * l4) * 2u, pack8(y)); }
                } else {
                    const unsigned kr = (unsigned)((bl * TKL + PAST + t) * 128 + 8 * l4) * 2u;
                    if (isv) bst16(vlres, kr, pack8(x)); else bst16(klres, kr, pack8(z));
                }
            }
        }
    }
    for (int r = k0 + gw; r < k1; r += NGW) {
        if (lane < 32) { const bool isv = lane >= 16; const int l4 = lane & 15; const int b = r / PAST, p = r % PAST;
            const float* src = a.in[isv ? I_CV : I_CK] + (size_t)r * 128 + 8 * l4; const f32x4 u0 = *(const f32x4*)src, u1 = *(const f32x4*)(src + 4);
            float x[8] = {u0.x, u0.y, u0.z, u0.w, u1.x, u1.y, u1.z, u1.w};
            const unsigned kr = (unsigned)((b * TKL + p) * 128 + 8 * l4) * 2u; const u32x4 pk = pack8(x);
            if (isv) bst16(vlres, kr, pk); else bst16(klres, kr, pk); }
    }
}

struct Fin0Row { u32x4 f, b, vc, vp, vn, g, oa, ga; float cr, mp, mn; };
__device__ __forceinline__ Fin0Row fin0_load(const bf16_t* PROJ, const bf16_t* OF, const bf16_t* OBk, const bf16_t* Oat, const float* corr, int row, int c0, int hd) {
    const bool lat = row >= MCTX; const int T = lat ? TLAT : TCTX; const int t = lat ? (row - MCTX) % TLAT : row % TCTX;
    const bf16_t* pr = PROJ + (size_t)row * L0_LD; Fin0Row r;
    r.f = __builtin_nontemporal_load((const u32x4*)(OF + (size_t)row * 512 + c0)); r.b = __builtin_nontemporal_load((const u32x4*)(OBk + (size_t)row * 512 + c0));
    r.vc = *(const u32x4*)(pr + C0_V + c0); r.vp = *(const u32x4*)(pr + (t > 0 ? -L0_LD : 0) + C0_V + c0); r.vn = *(const u32x4*)(pr + (t < T - 1 ? L0_LD : 0) + C0_V + c0);
    r.g = __builtin_nontemporal_load((const u32x4*)(pr + C0_RWG + c0)); r.oa = __builtin_nontemporal_load((const u32x4*)(Oat + (size_t)row * 512 + c0)); r.ga = __builtin_nontemporal_load((const u32x4*)(pr + C0_ATG + c0));
    r.cr = corr[(size_t)row * 8 + hd]; r.mp = t > 0 ? 1.f : 0.f; r.mn = t < T - 1 ? 1.f : 0.f; return r;
}
__device__ __forceinline__ void fin0_compute(const Fin0Row& r, bf16_t* xrow, int c0, const float (&gng)[8], const float (&gnb)[8], const float (&muv)[8]) {
    float f[8], b[8], s[8]; unpack8(r.f, f); unpack8(r.b, b);
    float sm = 0.f;
#pragma unroll
    for (int e = 0; e < 8; ++e) { s[e] = f[e] + b[e]; sm += s[e]; }
    const float mean = sum8(sm) * (1.f / 64.f); float q = 0.f;
#pragma unroll
    for (int e = 0; e < 8; ++e) { s[e] -= mean; q += s[e] * s[e]; }
    const float rstd = rsqf_(sum8(q) * (1.f / 64.f) + 64e-5f);
    float vc[8], vp[8], vn[8], g[8], o[8]; unpack8(r.vc, vc); unpack8(r.vp, vp); unpack8(r.vn, vn); unpack8(r.g, g);
#pragma unroll
    for (int e = 0; e < 8; ++e) { const float vs = vc[e] + muv[e] * (0.5f * (r.mp * vp[e] + r.mn * vn[e]) - vc[e]); o[e] = (s[e] * rstd * gng[e] + gnb[e] + r.cr * vs) * siluf_(g[e]); }
    st8(xrow + c0, o);
    float oa[8], ga[8]; unpack8(r.oa, oa); unpack8(r.ga, ga);
#pragma unroll
    for (int e = 0; e < 8; ++e) o[e] = oa[e] * siluf_(ga[e]);
    st8(xrow + 512 + c0, o);
}
__device__ __forceinline__ void rows_fin0(const Args& a, int lane, int gw, int NGW) {
    const bf16_t* PROJ = (const bf16_t*)(a.ws + WS_PROJ); const bf16_t* OF = (const bf16_t*)(a.ws + WS_XB); const bf16_t* OBk = OF + (size_t)MROWS * 512;
    const bf16_t* Oat = (const bf16_t*)a.out; const float* corr = (const float*)(a.ws + WS_CORR); bf16_t* XA = (bf16_t*)(a.ws + WS_XA);
    const int c0 = 8 * lane, hd = lane >> 3;
    float gng[8], gnb[8], muv[8];
#pragma unroll
    for (int e = 0; e < 8; ++e) { gng[e] = a.in[I0_GNG][c0 + e]; gnb[e] = a.in[I0_GNB][c0 + e]; muv[e] = a.in[I0_MU][C0_V + c0 + e]; }
    for (int row = gw; row < MROWS; row += 2 * NGW) {
        const int row2 = row + NGW < MROWS ? row + NGW : row;
        const Fin0Row r0 = fin0_load(PROJ, OF, OBk, Oat, corr, row, c0, hd), r1 = fin0_load(PROJ, OF, OBk, Oat, corr, row2, c0, hd);
        fin0_compute(r0, XA + (size_t)row * 1024, c0, gng, gnb, muv);
        if (row2 != row) fin0_compute(r1, XA + (size_t)row2 * 1024, c0, gng, gnb, muv);
    }
}

struct MidPar { RowPar gate, shift, scale; };
__device__ __forceinline__ MidPar midpar_load(const Args& a, int cv, int lane) {
    MidPar m; m.gate = modpar_load(a, cv * 3072 + 2048, lane); m.shift = modpar_load(a, (5 + cv) * 3072, lane); m.scale = modpar_load(a, (5 + cv) * 3072 + 1024, lane); return m; }
__device__ __forceinline__ void mid_compute(const Args& a, const u32x2 (&ow)[4], const f32x4 (&xv)[4], int row, int lane, const RowPar& gpost, const RowPar& gpre, const MidPar& m) {
    bf16_t* XB = (bf16_t*)(a.ws + WS_XB);
    u32x2* x1row = (u32x2*)(a.out + (size_t)row * 1024) + lane;
    f32x4 v[4]; float ss = 0.f;
#pragma unroll
    for (int j = 0; j < 4; ++j) { v[j] = (f32x4){__uint_as_float(ow[j].x << 16), __uint_as_float(ow[j].x & 0xffff0000u), __uint_as_float(ow[j].y << 16), __uint_as_float(ow[j].y & 0xffff0000u)}; ss += dot4(v[j]); }
    const float rstd = rsqf_(wave_sum(ss) * (1.f / 1024.f) + 1e-6f);
    float s1 = 0.f;
#pragma unroll
    for (int j = 0; j < 4; ++j) { v[j] = xv[j] + m.gate.c[j] * (v[j] * rstd * gpost.c[j]); u32x2 w1; w1.x = pk2(v[j].x, v[j].y); w1.y = pk2(v[j].z, v[j].w); __builtin_nontemporal_store(w1, &x1row[64 * j]); s1 += dot4(v[j]); }
    const float rstd1 = rsqf_(wave_sum(s1) * (1.f / 1024.f) + 1e-6f);
#pragma unroll
    for (int j = 0; j < 4; ++j) { const int col = (64 * j + lane) * 4;
        const f32x4 h = v[j] * rstd1 * gpre.c[j] * (m.scale.c[j] + 1.f) + m.shift.c[j]; u32x2 w; w.x = pk2(h.x, h.y); w.y = pk2(h.z, h.w); *(u32x2*)(XB + (size_t)row * 1024 + col) = w; }
}
__device__ __forceinline__ void rows_mid(const Args& a, int lane, int gw, int NGW) {
    const bf16_t* XB = (const bf16_t*)(a.ws + WS_XB);
    const int per = (MROWS + NGW - 1) / NGW, r0 = gw * per, r1 = r0 + per < MROWS ? r0 + per : MROWS;
    const RowPar gpost = rowpar_load(a.in[I0_GPOST], lane), gpre = rowpar_load(a.in[I1_GPRE], lane); MidPar m; m.gate = gpost; m.shift = gpost; m.scale = gpost; int cur = -1;
    for (int row = r0; row < r1; row += 2) {
        const int row2 = row + 1 < r1 ? row + 1 : row;
        const f32x4* xr = (const f32x4*)xrow_ptr(a, row) + lane; const f32x4* xr2 = (const f32x4*)xrow_ptr(a, row2) + lane;
        u32x2 o0[4], o1[4]; f32x4 x0[4], x1[4];
#pragma unroll
        for (int j = 0; j < 4; ++j) { o0[j] = *(const u32x2*)(XB + (size_t)row * 1024 + (64 * j + lane) * 4); o1[j] = *(const u32x2*)(XB + (size_t)row2 * 1024 + (64 * j + lane) * 4); x0[j] = xr[64 * j]; x1[j] = xr2[64 * j]; }
        if (row_cv(row) != cur) { cur = row_cv(row); m = midpar_load(a, cur, lane); }
        mid_compute(a, o0, x0, row, lane, gpost, gpre, m);
        if (row2 != row) { if (row_cv(row2) != cur) { cur = row_cv(row2); m = midpar_load(a, cur, lane); }
            mid_compute(a, o1, x1, row2, lane, gpost, gpre, m); }
    }
}

struct Fin1Row { u32x4 f0, f1, g0; u32x2 g1a, g1b; };
__device__ __forceinline__ Fin1Row fin1_load(const bf16_t* PROJ, const bf16_t* O4, int row, int c0) {
    const bf16_t* pr = PROJ + (size_t)row * L1_LD; const bf16_t* orow = O4 + (size_t)row * 1024; Fin1Row r;
    r.f0 = *(const u32x4*)(orow + c0); r.f1 = *(const u32x4*)(orow + 512 + c0); r.g0 = __builtin_nontemporal_load((const u32x4*)(pr + C1_GLG + c0));
    r.g1a = __builtin_nontemporal_load((const u32x2*)(pr + C1_GDG + c0)); r.g1b = __builtin_nontemporal_load((const u32x2*)(pr + C1_GDG + c0 + 4)); return r;
}
__device__ __forceinline__ void fin1_compute(const Fin1Row& r, bf16_t* orow, int c0, const float (&gl)[8], const float (&gd)[8]) {
#pragma unroll
    for (int br = 0; br < 2; ++br) {
        float f[8], g[8], o[8]; unpack8(br == 0 ? r.f0 : r.f1, f); unpack8(br == 0 ? r.g0 : (u32x4){r.g1a.x, r.g1a.y, r.g1b.x, r.g1b.y}, g);
        float ss = 0.f;
#pragma unroll
        for (int e = 0; e < 8; ++e) ss += f[e] * f[e];
        const float rstd = rsqf_(sum16(ss) * (1.f / 128.f) + 1e-6f);
#pragma unroll
        for (int e = 0; e < 8; ++e) o[e] = f[e] * rstd * (br == 0 ? gl[e] : gd[e]) * siluf_(g[e]);
        st8(orow + br * 512 + c0, o);
    }
}
__device__ __forceinline__ void rows_fin1(const Args& a, int lane, int gw, int NGW) {
    const bf16_t* PROJ = (const bf16_t*)(a.ws + WS_PROJ); bf16_t* O4 = (bf16_t*)(a.ws + WS_XA);
    const int c0 = 8 * lane, d0 = c0 & 127;
    float gl[8], gd[8];
#pragma unroll
    for (int e = 0; e < 8; ++e) { gl[e] = a.in[I1_GLN][d0 + e]; gd[e] = a.in[I1_GDN][d0 + e]; }
    for (int row = gw; row < MROWS; row += 2 * NGW) {
        const int row2 = row + NGW < MROWS ? row + NGW : row;
        const Fin1Row r0 = fin1_load(PROJ, O4, row, c0), r1 = fin1_load(PROJ, O4, row2, c0);
        fin1_compute(r0, O4 + (size_t)row * 1024, c0, gl, gd);
        if (row2 != row) fin1_compute(r1, O4 + (size_t)row2 * 1024, c0, gl, gd);
    }
}

__device__ __forceinline__ void final_compute(const u32x2 (&ow)[4], const u32x2 (&xw)[4], f32x4* yrow, const RowPar& gate, const RowPar& gpost) {
    f32x4 v[4]; float ss = 0.f;
#pragma unroll
    for (int j = 0; j < 4; ++j) { v[j] = (f32x4){__uint_as_float(ow[j].x << 16), __uint_as_float(ow[j].x & 0xffff0000u), __uint_as_float(ow[j].y << 16), __uint_as_float(ow[j].y & 0xffff0000u)}; ss += dot4(v[j]); }
    const float rstd = rsqf_(wave_sum(ss) * (1.f / 1024.f) + 1e-6f);
#pragma unroll
    for (int j = 0; j < 4; ++j) { const f32x4 xv = (f32x4){__uint_as_float(xw[j].x << 16), __uint_as_float(xw[j].x & 0xffff0000u), __uint_as_float(xw[j].y << 16), __uint_as_float(xw[j].y & 0xffff0000u)};
        __builtin_nontemporal_store(xv + gate.c[j] * (v[j] * rstd * gpost.c[j]), &yrow[64 * j]); }
}
__device__ __forceinline__ void rows_final(const Args& a, int lane, int gw, int NGW) {
    const float* modv1 = (const float*)(a.ws + WS_MODV) + 5 * 3072; const bf16_t* out2 = (const bf16_t*)(a.ws + WS_XB);
    const int per = (MROWS + NGW - 1) / NGW, r0 = gw * per, r1 = r0 + per < MROWS ? r0 + per : MROWS;
    const RowPar gpost = rowpar_load(a.in[I1_GPOST], lane); RowPar gate = gpost; int cur = -1;
    for (int row = r0; row < r1; row += 2) {
        const int row2 = row + 1 < r1 ? row + 1 : row;
        f32x4* y0 = (f32x4*)(a.out + (size_t)row * 1024) + lane; f32x4* y1 = (f32x4*)(a.out + (size_t)row2 * 1024) + lane;
        u32x2 o0[4], o1[4], x0[4], x1[4];
#pragma unroll
        for (int j = 0; j < 4; ++j) { o0[j] = *(const u32x2*)(out2 + (size_t)row * 1024 + (64 * j + lane) * 4); o1[j] = *(const u32x2*)(out2 + (size_t)row2 * 1024 + (64 * j + lane) * 4); x0[j] = ((const u32x2*)(a.out + (size_t)row * 1024) + lane)[64 * j]; x1[j] = ((const u32x2*)(a.out + (size_t)row2 * 1024) + lane)[64 * j]; }
        if (row_cv(row) != cur) { cur = row_cv(row); gate = modpar_load(a, (5 + cur) * 3072 + 2048, lane); }
        final_compute(o0, x0, y0, gate, gpost);
        if (row2 != row) { if (row_cv(row2) != cur) { cur = row_cv(row2); gate = modpar_load(a, (5 + cur) * 3072 + 2048, lane); }
            final_compute(o1, x1, y1, gate, gpost); }
    }
}
DEV int chain_row(int rbase, int T, int dir, int n) { return rbase + (dir ? T - 1 - n : n); }

constexpr int GL_QT = 0, GL_KT = 9216, GL_KD = 18432, GL_VT = 27648, GL_ATT = 46080, GL_DEC = 55296, GL_SEG = 55552, GL_GIN = 57600, GL_END = 61696;
DEV void gla_chunk_chain(const Args& a, LAS unsigned char* lds, int tid, int lane, int wave, int T, int rbase, const float* s0, float* sout, int h, int dir) {
    const bf16_t* PROJ = (const bf16_t*)(a.ws + WS_PROJ);
    LAS bf16_t* QT = (LAS bf16_t*)(lds + GL_QT);
    LAS bf16_t* KT = (LAS bf16_t*)(lds + GL_KT);
    LAS bf16_t* KD = (LAS bf16_t*)(lds + GL_KD);
    LAS bf16_t* VT = (LAS bf16_t*)(lds + GL_VT);
    LAS bf16_t* ATT = (LAS bf16_t*)(lds + GL_ATT);
    LAS float* DEC = (LAS float*)(lds + GL_DEC);
    LAS float* SEG = (LAS float*)(lds + GL_SEG);
    LAS float* GIN = (LAS float*)(lds + GL_GIN);
    const int d = lane, seg = wave, hc = h * 64 + d, NC = T / 64;
    const float* g2 = a.in[dir ? I1_G2B : I1_G2F];
    float g2c[16];
#pragma unroll
    for (int i = 0; i < 16; ++i) g2c[i] = g2[i * 256 + hc];
    const float gb = a.in[dir ? I1_GBB : I1_GBF][hc];
    const int cgin = dir ? C1_GB : C1_GF;
    const int li = lane & 15, g = lane >> 4, v0 = 16 * wave;
    const float* sp0 = s0 ? s0 : a.in[I_GLF];
    f32x4 S[4];
#pragma unroll
    for (int dt = 0; dt < 4; ++dt)
#pragma unroll
        for (int r = 0; r < 4; ++r) { const float sv_ = sp0[(size_t)(16 * dt + 4 * g + r) * 128 + v0 + li]; S[dt][r] = s0 ? sv_ : 0.f; }
    bf16_t* O4 = (bf16_t*)(a.ws + WS_XA) + (dir ? 1024 : 0) + h * 128;
    const int ltt = tid >> 3, lp = tid & 7;
    unsigned graw; u32x4 vraw0, vraw1; unsigned short qraw[8], kraw[8];
#define GLA_LOAD(c_) do { const bf16_t* pr_ = PROJ + chain_row(rbase, T, dir, (c_) * 64 + ltt) * L1_LD; graw = *(const unsigned*)(pr_ + cgin + 2 * lp); \
        vraw0 = *(const u32x4*)(pr_ + C1_GV + h * 128 + 16 * lp); vraw1 = *(const u32x4*)(pr_ + C1_GV + h * 128 + 16 * lp + 8); \
        _Pragma("unroll") for (int e = 0; e < 8; ++e) { const bf16_t* pq_ = PROJ + chain_row(rbase, T, dir, (c_) * 64 + 8 * seg + e) * L1_LD; qraw[e] = pq_[C1_GQ + hc]; kraw[e] = pq_[C1_GK + hc]; } } while (0)
    GLA_LOAD(0);
    for (int c = 0; c < NC; ++c) {
        GIN[ltt * 16 + 2 * lp] = bf2f(graw & 0xffffu); GIN[ltt * 16 + 2 * lp + 1] = bf2f(graw >> 16);
        {
            const unsigned vw[8] = {vraw0.x, vraw0.y, vraw0.z, vraw0.w, vraw1.x, vraw1.y, vraw1.z, vraw1.w};
#pragma unroll
            for (int jj = 0; jj < 8; ++jj) { VT[(16 * lp + 2 * jj) * 72 + ltt] = (bf16_t)(vw[jj] & 0xffffu); VT[(16 * lp + 2 * jj + 1) * 72 + ltt] = (bf16_t)(vw[jj] >> 16); }
        }
        float qf[8], kf[8];
#pragma unroll
        for (int e = 0; e < 8; ++e) { qf[e] = bf2f(qraw[e]); kf[e] = bf2f(kraw[e]); }
        BAR_LDS();
        GLA_LOAD(c + 1 < NC ? c + 1 : c);
        float cl[8];
        {
            float run = 0.f;
#pragma unroll
            for (int e = 0; e < 8; ++e) {
                const LAS f32x4* g4 = (const LAS f32x4*)(GIN + (8 * seg + e) * 16); float x = gb;
#pragma unroll
                for (int i = 0; i < 4; ++i) { const f32x4 y = g4[i]; x += y[0] * g2c[4 * i] + y[1] * g2c[4 * i + 1] + y[2] * g2c[4 * i + 2] + y[3] * g2c[4 * i + 3]; }
                run += log_sigmoidf_(x) * (1.f / 16.f); cl[e] = run;
            }
            SEG[seg * 64 + d] = run;
        }
        BAR_LDS();
        {
            float off = 0.f, tot = 0.f;
#pragma unroll
            for (int s2 = 0; s2 < 8; ++s2) { const float sv = SEG[s2 * 64 + d]; tot += sv; off += (s2 < seg) ? sv : 0.f; }
            float kd[8];
#pragma unroll
            for (int e = 0; e < 8; ++e) { const float cum = off + cl[e]; const int tt = 8 * seg + e; const float eq = __expf(cum);
                QT[tt * 72 + d] = (bf16_t)f2bf(qf[e] * 0.125f * eq); KT[tt * 72 + d] = (bf16_t)f2bf(kf[e] * __expf(-cum)); kd[e] = kf[e] * __expf(tot - cum); }
            *(LAS u32x4*)(KD + d * 72 + 8 * seg) = pack8(kd);
            if (seg == 0) DEC[d] = __expf(tot);
        }
        BAR_LDS();
#pragma unroll
        for (int q2 = 0; q2 < 2; ++q2) {
            const int idx = 2 * wave + q2, tm = idx >> 2, tn = idx & 3; f32x4 acc = {0.f, 0.f, 0.f, 0.f};
            if (tn <= tm) {
#pragma unroll
                for (int ks = 0; ks < 2; ++ks) acc = mfma16(ldfrag(QT + (16 * tm + li) * 72 + 32 * ks + 8 * g), ldfrag(KT + (16 * tn + li) * 72 + 32 * ks + 8 * g), acc);
            }
#pragma unroll
            for (int r = 0; r < 4; ++r) { const int t = 16 * tm + 4 * g + r, s = 16 * tn + li; ATT[t * 72 + s] = (bf16_t)f2bf((s <= t) ? acc[r] : 0.f); }
        }
        BAR_LDS();
        {
            bf16x8 bv[2], sb[2];
#pragma unroll
            for (int ks = 0; ks < 2; ++ks) { bv[ks] = ldfrag(VT + (v0 + li) * 72 + 32 * ks + 8 * g); sb[ks] = acc2b(S[2 * ks], S[2 * ks + 1]); }
#pragma unroll
            for (int mt = 0; mt < 4; ++mt) {
                f32x4 o = {0.f, 0.f, 0.f, 0.f};
#pragma unroll
                for (int ks = 0; ks < 2; ++ks) o = mfma16(ldfrag(ATT + (16 * mt + li) * 72 + 32 * ks + 8 * g), bv[ks], o);
#pragma unroll
                for (int ks = 0; ks < 2; ++ks) o = mfma16(ldperm(QT + (16 * mt + li) * 72 + 32 * ks + 4 * g), sb[ks], o);
#pragma unroll
                for (int r = 0; r < 4; ++r) O4[chain_row(rbase, T, dir, c * 64 + 16 * mt + 4 * g + r) * 2048 + v0 + li] = (bf16_t)f2bf(o[r]);
            }
#pragma unroll
            for (int dt = 0; dt < 4; ++dt) {
                const f32x4 dec = *(const LAS f32x4*)(DEC + 16 * dt + 4 * g); f32x4 acc = S[dt] * dec;
#pragma unroll
                for (int ks = 0; ks < 2; ++ks) acc = mfma16(ldfrag(KD + (16 * dt + li) * 72 + 32 * ks + 8 * g), bv[ks], acc);
                S[dt] = acc;
            }
        }
        BAR_LDS();
    }
#undef GLA_LOAD
    if (sout) {
#pragma unroll
        for (int dt = 0; dt < 4; ++dt)
#pragma unroll
            for (int r = 0; r < 4; ++r) sout[(size_t)(16 * dt + 4 * g + r) * 128 + v0 + li] = S[dt][r];
    }
}

typedef float f32x2 __attribute__((ext_vector_type(2)));
template <int NS> DEV void fwd_subst(const LAS float* A  , const float (&rhs_own)[64 / NS], float (&x)[64 / NS], int q) {
    f32x2 xv[32 / NS];
#pragma unroll
    for (int i = 0; i < 32 / NS; ++i) xv[i] = (f32x2){0.f, 0.f};
#pragma unroll
    for (int t = 0; t < 64; ++t) {
        const int own = (t >> 2) % NS, xi = 4 * (t / (4 * NS)) + (t & 3);
        f32x2 acc2 = {(q == own) ? rhs_own[xi] : 0.f, 0.f};
        const int nblk = (t + 4 * NS - 1) / (4 * NS);
#pragma unroll
        for (int m = 0; m < nblk; ++m) { const f32x4 a4 = *(const LAS f32x4*)(A + t * 68 + 4 * NS * m + 4 * q);
            acc2 -= (f32x2){a4[0], a4[1]} * xv[2 * m]; acc2 -= (f32x2){a4[2], a4[3]} * xv[2 * m + 1]; }
        float acc = acc2[0] + acc2[1];
        acc += dpp<0xB1>(acc);
        if (NS == 4) acc += dpp<0x4E>(acc);
        const float keep = xv[xi >> 1][xi & 1];
        xv[xi >> 1][xi & 1] = (q == own) ? acc : keep;
    }
#pragma unroll
    for (int i = 0; i < 64 / NS; ++i) x[i] = xv[i >> 1][i & 1];
}

template <int DS> DEV void diag16_inverse(const LAS float* A  , LAS bf16_t* DBF, int I, int lane) {
    const int c = lane & 15; float x[16];
#pragma unroll
    for (int i = 0; i < 16; ++i) x[i] = 0.f;
#pragma unroll
    for (int t = 0; t < 16; ++t) { float acc = (t == c) ? 1.f : 0.f; const LAS f32x4* ar = (const LAS f32x4*)(A + (16 * I + t) * 68 + 16 * I);
#pragma unroll
        for (int s4 = 0; s4 < (t + 3) / 4; ++s4) { const f32x4 a4 = ar[s4]; acc -= a4[0] * x[4 * s4] + a4[1] * x[4 * s4 + 1] + a4[2] * x[4 * s4 + 2] + a4[3] * x[4 * s4 + 3]; }
        x[t] = acc; }
    if (lane < 16) {
#pragma unroll
        for (int t = 0; t < 16; ++t) { DBF[(16 * I + t) * DS + c] = (bf16_t)f2bf(x[t]); DBF[(16 * I + t) * DS + 16 + c] = (bf16_t)0; }
    }
}
template <int DS, class RHS> DEV void block_solve16(const LAS bf16_t* ABF  , const LAS bf16_t* DBF, const RHS& rhs, f32x4 (&X)[4], int li, int g) {
    const f32x4 z = {0.f, 0.f, 0.f, 0.f};
    X[0] = mfma16(ldperm(DBF + li * DS + 4 * g), acc2b(rhs(0), z), z);
    f32x4 y = mfma16(ldperm(ABF + (16 + li) * 72 + 4 * g), acc2b(X[0], z), -rhs(1));
    X[1] = mfma16(ldperm(DBF + (16 + li) * DS + 4 * g), acc2b(-y, z), z);
    const bf16x8 b01 = acc2b(X[0], X[1]);
    y = mfma16(ldperm(ABF + (32 + li) * 72 + 4 * g), b01, -rhs(2));
    X[2] = mfma16(ldperm(DBF + (32 + li) * DS + 4 * g), acc2b(-y, z), z);
    y = mfma16(ldperm(ABF + (48 + li) * 72 + 4 * g), b01, -rhs(3));
    y = mfma16(ldperm(ABF + (48 + li) * 72 + 32 + 4 * g), acc2b(X[2], z), y);
    X[3] = mfma16(ldperm(DBF + (48 + li) * DS + 4 * g), acc2b(-y, z), z);
}

constexpr int GD_Q = 0, GD_K = 17408, GD_V = 34816, GD_U0T = 17408, GD_KT = 52224, GD_W = 70656, GD_AQK = 88064, GD_A = 97280, GD_SC = 114688, GD_CW = 116480, GD_END = 121088;
DEV void gdn_chunk_chain(const Args& a, LAS unsigned char* lds, int tid, int lane_in, int wave, int T, int rbase, const float* s0, float* sout, int h, int dir) {
    const bf16_t* PROJ = (const bf16_t*)(a.ws + WS_PROJ);
    LAS bf16_t* Q = (LAS bf16_t*)(lds + GD_Q);
    LAS bf16_t* K = (LAS bf16_t*)(lds + GD_K);
    LAS bf16_t* V = (LAS bf16_t*)(lds + GD_V);
    LAS float* U0T = (LAS float*)(lds + GD_U0T);
    LAS bf16_t* KT = (LAS bf16_t*)(lds + GD_KT);
    LAS bf16_t* W = (LAS bf16_t*)(lds + GD_W);
    LAS bf16_t* AQK = (LAS bf16_t*)(lds + GD_AQK);
    LAS float* A = (LAS float*)(lds + GD_A);
    LAS float* SC = (LAS float*)(lds + GD_SC);
    LAS float* LOGA = SC, *BETA = SC + 64, *GC = SC + 128, *GAM = SC + 192, *EE = SC + 256, *BG = SC + 320, *GLs = SC + 384;
    LAS float* CW = (LAS float*)(lds + GD_CW);
    const int NC = T / 64;
    const float nA = -__expf(a.in[dir ? I1_ALB : I1_ALF][h]), dtb = a.in[dir ? I1_DTB : I1_DTF][h];
    const int ca = dir ? C1_AB : C1_AF;
    for (int u = tid; u < 3 * 384; u += 512) { const int tap = u / 384, rem = u % 384, arr = rem >> 7, dd = rem & 127; CW[u] = a.in[I1_CONV][tap * 1536 + arr * 512 + h * 128 + dd]; }
    const int li0 = lane_in & 15, g0 = lane_in >> 4, v0 = 16 * wave;
    const float* sp0 = s0 ? s0 : a.in[I_GDF];
    f32x4 S[8];
#pragma unroll
    for (int dt = 0; dt < 8; ++dt)
#pragma unroll
        for (int r = 0; r < 4; ++r) { const float sv_ = sp0[(size_t)(16 * dt + 4 * g0 + r) * 128 + v0 + li0]; S[dt][r] = s0 ? sv_ : 0.f; }
    bf16_t* O4 = (bf16_t*)(a.ws + WS_XA) + (dir ? 1536 : 512) + h * 128;
    unsigned pf_acc = 0u;
    BAR_LDS();
    for (int c = 0; c < NC; ++c) {
        int tv = tid; OPAQUE(tv);
        const int lane = tv & 63, li = lane & 15, g = lane >> 4, tt = tv >> 3, part = tv & 7;
        unsigned pfv = 0u;
        { const int tq = tv < 396 ? tv : tv - 396, cn = c + 1 < NC ? c + 1 : c; const int ri = tq / 6, s6 = tq % 6; const long lo = (long)(dir ? chain_row(rbase, T, dir, cn * 64 + 63) : chain_row(rbase, T, dir, cn * 64)) - 1 + ri;
            const long rr = lo < rbase ? rbase : (lo > rbase + T - 1 ? rbase + T - 1 : lo);
            pfv = *(const volatile unsigned*)(PROJ + (size_t)rr * L1_LD + C1_DQKV + (s6 >> 1) * 512 + h * 128 + 64 * (s6 & 1)); }
        {
            const size_t row = chain_row(rbase, T, dir, c * 64 + tt); const int tact = (int)(row - rbase); const bool hp = tact > 0, hn = tact < T - 1;
            const bf16_t* pc = PROJ + row * L1_LD + C1_DQKV + h * 128 + 16 * part;
            const int op = hp ? -L1_LD : 0, on = hn ? L1_LD : 0; const float mp = hp ? 1.f : 0.f, mn = hn ? 1.f : 0.f;
            u32x4 ra[2][3], rb[2][3];
#define GDN_LD(dst, arr) do { _Pragma("unroll") for (int hf = 0; hf < 2; ++hf) { const bf16_t* p_ = pc + (arr) * 512 + 8 * hf; dst[hf][0] = *(const u32x4*)(p_ + op); dst[hf][1] = *(const u32x4*)p_; dst[hf][2] = *(const u32x4*)(p_ + on); } } while (0)
#define GDN_CONV(y, src, arr) do { _Pragma("unroll") for (int hf = 0; hf < 2; ++hf) { float cur[8], prv[8], nxt[8]; unpack8(src[hf][0], prv); unpack8(src[hf][1], cur); unpack8(src[hf][2], nxt); \
                _Pragma("unroll") for (int e4 = 0; e4 < 2; ++e4) { const int cb = (arr) * 128 + 16 * part + 8 * hf + 4 * e4; \
                    const f32x4 w0 = *(const LAS f32x4*)(CW + cb) * mp, w1 = *(const LAS f32x4*)(CW + 384 + cb), w2 = *(const LAS f32x4*)(CW + 768 + cb) * mn; \
                    _Pragma("unroll") for (int e = 0; e < 4; ++e) y[8 * hf + 4 * e4 + e] = siluf_(w0[e] * prv[4 * e4 + e] + w1[e] * cur[4 * e4 + e] + w2[e] * nxt[4 * e4 + e]); } } } while (0)
#define GDN_ST(dst, y) do { _Pragma("unroll") for (int hf = 0; hf < 2; ++hf) { float t8[8]; _Pragma("unroll") for (int e = 0; e < 8; ++e) t8[e] = y[8 * hf + e]; *(LAS u32x4*)(dst + tt * 136 + 16 * part + 8 * hf) = pack8(t8); } } while (0)
            GDN_LD(ra, 0); GDN_LD(rb, 1);
            SCHED_BARRIER();
            {
                float y[16]; GDN_CONV(y, ra, 0); float sq = 0.f;
#pragma unroll
                for (int e = 0; e < 16; ++e) sq += y[e] * y[e];
                const float qn = rsqf_(sum8(sq) + 1e-6f) * 0.08838834764831845f;
#pragma unroll
                for (int e = 0; e < 16; ++e) y[e] *= qn;
                GDN_ST(Q, y);
            }
            SCHED_BARRIER();
            GDN_LD(ra, 2);
            SCHED_BARRIER();
            {
                float y[16]; GDN_CONV(y, rb, 1); float sk = 0.f;
#pragma unroll
                for (int e = 0; e < 16; ++e) sk += y[e] * y[e];
                const float kn = rsqf_(sum8(sk) + 1e-6f);
#pragma unroll
                for (int e = 0; e < 16; ++e) y[e] *= kn;
                GDN_ST(K, y);
#pragma unroll
                for (int e = 0; e < 16; ++e) KT[(16 * part + e) * 72 + tt] = (bf16_t)f2bf(y[e]);
            }
            SCHED_BARRIER();
            {
                float y[16]; GDN_CONV(y, ra, 2); GDN_ST(V, y);
            }
#undef GDN_LD
#undef GDN_CONV
#undef GDN_ST
            if (part == 0) { const bf16_t* ps = PROJ + row * L1_LD; LOGA[tt] = nA * softplusf_(bf2f(ps[ca + h]) + dtb); BETA[tt] = sigmoidf_(bf2f(ps[C1_BETA + h])); }
        }
        BAR_LDS();
        if (wave == 0) {
            float x = LOGA[lane];
#pragma unroll
            for (int off = 1; off < 64; off <<= 1) { const float y2 = __shfl_up(x, off); x += (lane >= off) ? y2 : 0.f; }
            const float gl = __shfl(x, 63);
            GC[lane] = x; const float gm = __expf(x); GAM[lane] = gm; EE[lane] = __expf(gl - x); BG[lane] = BETA[lane] * gm;
            if (lane == 63) GLs[0] = __expf(gl);
        }
        BAR_LDS();
#pragma unroll
        for (int q2 = 0; q2 < 2; ++q2) {
            const int idx = 2 * wave + q2, tm = idx >> 2, tn = idx & 3; f32x4 ak = {0.f, 0.f, 0.f, 0.f}, aq = {0.f, 0.f, 0.f, 0.f};
            if (tn <= tm) {
#pragma unroll
                for (int ks = 0; ks < 4; ++ks) { const bf16x8 kb = ldfrag(K + (16 * tn + li) * 136 + 32 * ks + 8 * g);
                    ak = mfma16(ldfrag(K + (16 * tm + li) * 136 + 32 * ks + 8 * g), kb, ak); aq = mfma16(ldfrag(Q + (16 * tm + li) * 136 + 32 * ks + 8 * g), kb, aq); }
            }
            const int s = 16 * tn + li; const float gs = GC[s];
#pragma unroll
            for (int r = 0; r < 4; ++r) { const int t = 16 * tm + 4 * g + r; const float dec = __expf(fminf(GC[t] - gs, 0.f));
                A[t * 68 + s] = (s < t) ? BETA[t] * dec * ak[r] : 0.f; AQK[t * 72 + s] = (bf16_t)f2bf((s <= t) ? dec * aq[r] : 0.f); }
        }
        BAR_LDS();
        {
            const int col = tv >> 1, hq = tv & 1;
            const LAS bf16_t* rsrc = (col < 128) ? K + col : V + (col - 128); const LAS float* rsc = (col < 128) ? BG : BETA;
            float x[32], rh[32];
#pragma unroll
            for (int m = 0; m < 8; ++m) { const f32x4 sc4 = *(const LAS f32x4*)(rsc + 8 * m + 4 * hq);
#pragma unroll
                for (int e = 0; e < 4; ++e) rh[4 * m + e] = sc4[e] * bf2f(rsrc[(8 * m + 4 * hq + e) * 136]); }
            fwd_subst<2>(A, rh, x, hq);
            BAR_LDS();
            if (col < 128) {
#pragma unroll
                for (int m = 0; m < 8; ++m)
#pragma unroll
                    for (int e = 0; e < 4; ++e) W[(8 * m + 4 * hq + e) * 136 + col] = (bf16_t)f2bf(x[4 * m + e]);
            } else {
#pragma unroll
                for (int m = 0; m < 8; ++m) *(LAS f32x4*)(U0T + (col - 128) * 68 + 8 * m + 4 * hq) = (f32x4){x[4 * m], x[4 * m + 1], x[4 * m + 2], x[4 * m + 3]};
            }
        }
        BAR_LDS();
        {
            bf16x8 sb[4];
#pragma unroll
            for (int ks = 0; ks < 4; ++ks) sb[ks] = acc2b(S[2 * ks], S[2 * ks + 1]);
            f32x4 u[4];
#pragma unroll
            for (int mt = 0; mt < 4; ++mt) { f32x4 p = {0.f, 0.f, 0.f, 0.f};
#pragma unroll
                for (int ks = 0; ks < 4; ++ks) p = mfma16(ldperm(W + (16 * mt + li) * 136 + 32 * ks + 4 * g), sb[ks], p);
                u[mt] = *(const LAS f32x4*)(U0T + (v0 + li) * 68 + 16 * mt + 4 * g) - p; }
            bf16x8 ub[2], ueb[2];
#pragma unroll
            for (int k2 = 0; k2 < 2; ++k2) { ub[k2] = acc2b(u[2 * k2], u[2 * k2 + 1]);
                ueb[k2] = acc2b(u[2 * k2] * *(const LAS f32x4*)(EE + 32 * k2 + 4 * g), u[2 * k2 + 1] * *(const LAS f32x4*)(EE + 32 * k2 + 16 + 4 * g)); }
#pragma unroll
            for (int mt = 0; mt < 4; ++mt) { f32x4 o = {0.f, 0.f, 0.f, 0.f};
#pragma unroll
                for (int ks = 0; ks < 4; ++ks) o = mfma16(ldperm(Q + (16 * mt + li) * 136 + 32 * ks + 4 * g), sb[ks], o);
                o = o * *(const LAS f32x4*)(GAM + 16 * mt + 4 * g);
#pragma unroll
                for (int k2 = 0; k2 < 2; ++k2) o = mfma16(ldperm(AQK + (16 * mt + li) * 72 + 32 * k2 + 4 * g), ub[k2], o);
#pragma unroll
                for (int r = 0; r < 4; ++r) O4[chain_row(rbase, T, dir, c * 64 + 16 * mt + 4 * g + r) * 2048 + v0 + li] = (bf16_t)f2bf(o[r]); }
            const float gl = GLs[0];
#pragma unroll
            for (int dt = 0; dt < 8; ++dt) { f32x4 acc = S[dt] * gl;
#pragma unroll
                for (int k2 = 0; k2 < 2; ++k2) acc = mfma16(ldperm(KT + (16 * dt + li) * 72 + 32 * k2 + 4 * g), ueb[k2], acc);
                S[dt] = acc; }
        }
        pf_acc ^= pfv;
        BAR_LDS();
    }
    if (pf_acc == 0x9e3779b9u) LOGA[0] = 1.f;
    if (sout) {
        int sidx = 4 * g0 * 128 + v0 + li0; OPAQUE(sidx);
#pragma unroll
        for (int dt = 0; dt < 8; ++dt)
#pragma unroll
            for (int r = 0; r < 4; ++r) sout[(size_t)((16 * dt + r) * 128 + sidx)] = S[dt][r];
    }
}

constexpr int RW_RT = 0, RW_KKT = 9216, RW_BT = 18432, RW_KT = 27648, RW_KDT = 36864, RW_BDT = 46080, RW_VT = 55296, RW_AAB = 64512, RW_AKV = 81920, RW_AAK = 99328, RW_ARB = 108544, RW_ARK = 117760,
              RW_SEG = 126976, RW_GL = 129024, RW_END = 129280;
DEV float wave_sum_f(float v) { v = sum16(v); v = dpp_bcast_add<0x142, 0xa>(v); v = dpp_bcast_add<0x143, 0xc>(v); return readlane63(v); }
DEV void rwkv_chunk_chain(const Args& a, LAS unsigned char* lds, int tid, int lane_in, int wave, int T, int rbase, const float* s0, float* sout, int h, int dir) {
    const bf16_t* PROJ = (const bf16_t*)(a.ws + WS_PROJ);
    LAS bf16_t* RT = (LAS bf16_t*)(lds + RW_RT);
    LAS bf16_t* KKT = (LAS bf16_t*)(lds + RW_KKT);
    LAS bf16_t* BT = (LAS bf16_t*)(lds + RW_BT);
    LAS bf16_t* KT = (LAS bf16_t*)(lds + RW_KT);
    LAS bf16_t* KDT = (LAS bf16_t*)(lds + RW_KDT);
    LAS bf16_t* BDT = (LAS bf16_t*)(lds + RW_BDT);
    LAS bf16_t* VT = (LAS bf16_t*)(lds + RW_VT);
    LAS float* AAB = (LAS float*)(lds + RW_AAB);
    LAS float* AKV = (LAS float*)(lds + RW_AKV);
    LAS bf16_t* AAK = (LAS bf16_t*)(lds + RW_AAK);
    LAS bf16_t* ARB = (LAS bf16_t*)(lds + RW_ARB);
    LAS bf16_t* ARK = (LAS bf16_t*)(lds + RW_ARK);
    LAS float* SEG = (LAS float*)(lds + RW_SEG);
    LAS float* GL = (LAS float*)(lds + RW_GL);
    const int NC = T / 64, seg = wave, cw = dir ? C0_WB : C0_WF;
    const float* mu = a.in[I0_MU];
    float* corr = (float*)(a.ws + WS_CORR);
    bf16_t* Oout = (bf16_t*)(a.ws + WS_XB) + (dir ? (size_t)MROWS * 512 : 0) + h * 64;
    const int li0 = lane_in & 15, g0 = lane_in >> 4, v0 = 16 * wave;
    bf16x8 w2f[2], a2f[2];
    {
        const float* w2 = a.in[dir ? I0_W2B : I0_W2F]; const float* a2 = a.in[I0_A2]; const int dc = h * 64 + 16 * (wave & 3) + li0;
#pragma unroll
        for (int ks = 0; ks < 2; ++ks) { float tw[8], ta[8];
#pragma unroll
            for (int j = 0; j < 8; ++j) { tw[j] = w2[(32 * ks + 8 * g0 + j) * 512 + dc]; ta[j] = a2[(32 * ks + 8 * g0 + j) * 512 + dc]; }
            w2f[ks] = __builtin_bit_cast(bf16x8, pack8(tw)); a2f[ks] = __builtin_bit_cast(bf16x8, pack8(ta)); }
    }
    const float* sp0 = s0 ? s0 : a.in[I_RWF];
    f32x4 S[4];
#pragma unroll
    for (int dt = 0; dt < 4; ++dt) { const f32x4 sv_ = *(const f32x4*)(sp0 + (size_t)((v0 & 63) + li0) * 64 + 16 * dt + 4 * g0); S[dt] = (s0 && wave < 4) ? sv_ : (f32x4){0.f, 0.f, 0.f, 0.f}; }
    unsigned pf_acc = 0u;
    for (int c = 0; c < NC; ++c) {
        int tv = tid; OPAQUE(tv);
        const int lane = tv & 63, li = lane & 15, g = lane >> 4, d = lane, hc = h * 64 + d;
        unsigned pfv = 0u;
        { const int tq = tv < 330 ? tv : tv - 330, cn = c + 1 < NC ? c + 1 : c; const int ri = tq / 5, s5 = tq % 5; int n = cn * 64 - 1 + ri; n = n > T - 1 ? T - 1 : n;
            const int colp = (s5 < 3) ? (s5 * 512 + h * 64) : (s5 == 3 ? cw : C0_A);
            pfv = *(const volatile unsigned*)(PROJ + chain_row(rbase, T, dir, n) * L0_LD + colp); }
        float rr[8], ks_[8], vv[8];
        {
            const int n0 = c * 64 + 8 * seg;
            const float mu_r = mu[C0_R + hc], mu_k = mu[C0_K + hc], mu_v = mu[C0_V + hc], mu_w = mu[cw + d], mu_a = mu[C0_A + d];
            float xr[10], xk[10], xv[10], xw[10], xa[10];
            unsigned short qr_[10], qk_[10], qv_[10], qw_[10], qa_[10];
#pragma unroll
            for (int i = 0; i < 10; ++i) { const int n = n0 - 1 + i; const int nc = n < 0 ? 0 : (n > T - 1 ? T - 1 : n);
                const bf16_t* p = PROJ + chain_row(rbase, T, dir, nc) * L0_LD;
                qr_[i] = p[C0_R + hc]; qk_[i] = p[C0_K + hc]; qv_[i] = p[C0_V + hc]; qw_[i] = p[cw + d]; qa_[i] = p[C0_A + d]; }
            SCHED_BARRIER();
#pragma unroll
            for (int i = 0; i < 10; ++i) { const int n = n0 - 1 + i; const bool ok = n >= 0 && n <= T - 1; const float m = ok ? 1.f : 0.f;
                xr[i] = bf2f(qr_[i]) * m; xk[i] = bf2f(qk_[i]) * m; xv[i] = bf2f(qv_[i]) * m; xw[i] = bf2f(qw_[i]) * m; xa[i] = bf2f(qa_[i]) * m; }
#pragma unroll
            for (int e = 0; e < 8; ++e) { const int tt = 8 * seg + e;
                rr[e] = xr[e + 1] + mu_r * (0.5f * (xr[e] + xr[e + 2]) - xr[e + 1]); ks_[e] = xk[e + 1] + mu_k * (0.5f * (xk[e] + xk[e + 2]) - xk[e + 1]); vv[e] = xv[e + 1] + mu_v * (0.5f * (xv[e] + xv[e + 2]) - xv[e + 1]);
                AAK[tt * 72 + d] = (bf16_t)f2bf(tanhf_(xw[e + 1] + mu_w * (0.5f * (xw[e] + xw[e + 2]) - xw[e + 1]))); ARB[tt * 72 + d] = (bf16_t)f2bf(xa[e + 1] + mu_a * (0.5f * (xa[e] + xa[e + 2]) - xa[e + 1])); }
        }
        BAR_LDS();
        {
            const int tn = wave & 3;
#pragma unroll
            for (int t2 = 0; t2 < 2; ++t2) { const int tm = 2 * (wave >> 2) + t2; f32x4 aw = {0.f, 0.f, 0.f, 0.f}, aa = {0.f, 0.f, 0.f, 0.f};
#pragma unroll
                for (int ks = 0; ks < 2; ++ks) { aw = mfma16(ldfrag(AAK + (16 * tm + li) * 72 + 32 * ks + 8 * g), w2f[ks], aw); aa = mfma16(ldfrag(ARB + (16 * tm + li) * 72 + 32 * ks + 8 * g), a2f[ks], aa); }
#pragma unroll
                for (int r = 0; r < 4; ++r) { AAB[(16 * tm + 4 * g + r) * 68 + 16 * tn + li] = aw[r]; AKV[(16 * tm + 4 * g + r) * 68 + 16 * tn + li] = aa[r]; } }
        }
        BAR_LDS();
        float kk[8], bb[8], lw[8], cl[8];
        {
            const float w0 = a.in[dir ? I0_W0B : I0_W0F][hc], a0v = a.in[I0_A0][hc], kkc = a.in[I0_KK][hc], kac = a.in[I0_KA][hc], rkc = a.in[I0_RK][hc];
            float run = 0.f;
#pragma unroll
            for (int e = 0; e < 8; ++e) { const int tt = 8 * seg + e;
                lw[e] = -0.6065306597126334f * sigmoidf_(AAB[tt * 68 + d] + w0); const float av = sigmoidf_(AKV[tt * 68 + d] + a0v);
                const float kkp = ks_[e] * kkc; kk[e] = kkp * rsqf_(wave_sum_f(kkp * kkp) + 1e-6f);
                ks_[e] = ks_[e] * (1.f + (av - 1.f) * kac); bb[e] = kk[e] * av;
                const float cr = wave_sum_f(rr[e] * ks_[e] * rkc);
                if (dir == 0 && lane == 0) corr[chain_row(rbase, T, dir, c * 64 + tt) * 8 + h] = cr;
                run += lw[e]; cl[e] = run; }
            SEG[seg * 64 + d] = run;
        }
        BAR_LDS();
        {
            float off = 0.f, tot = 0.f;
#pragma unroll
            for (int s2 = 0; s2 < 8; ++s2) { const float sv = SEG[s2 * 64 + d]; tot += sv; off += (s2 < seg) ? sv : 0.f; }
            float kd[8], bd[8];
#pragma unroll
            for (int e = 0; e < 8; ++e) { const int tt = 8 * seg + e; const float lwi = off + cl[e], lwx = lwi - lw[e]; const float ei = __expf(-lwi), ed = __expf(tot - lwi);
                RT[tt * 72 + d] = (bf16_t)f2bf(rr[e] * __expf(lwi)); KKT[tt * 72 + d] = (bf16_t)f2bf(kk[e] * __expf(lwx)); BT[tt * 72 + d] = (bf16_t)f2bf(bb[e] * ei); KT[tt * 72 + d] = (bf16_t)f2bf(ks_[e] * ei);
                kd[e] = ks_[e] * ed; bd[e] = bb[e] * ed; }
            *(LAS u32x4*)(KDT + d * 72 + 8 * seg) = pack8(kd); *(LAS u32x4*)(BDT + d * 72 + 8 * seg) = pack8(bd); *(LAS u32x4*)(VT + d * 72 + 8 * seg) = pack8(vv);
            if (seg == 0) GL[d] = __expf(tot);
        }
        BAR_LDS();
#pragma unroll
        for (int q2 = 0; q2 < 2; ++q2) {
            const int idx = 2 * wave + q2, tm = idx >> 2, tn = idx & 3; f32x4 ab = {0.f, 0.f, 0.f, 0.f}, ak = ab, rb = ab, rk = ab;
            if (tn <= tm) {
#pragma unroll
                for (int ks = 0; ks < 2; ++ks) { const bf16x8 fa = ldfrag(KKT + (16 * tm + li) * 72 + 32 * ks + 8 * g), fr = ldfrag(RT + (16 * tm + li) * 72 + 32 * ks + 8 * g);
                    const bf16x8 fb = ldfrag(BT + (16 * tn + li) * 72 + 32 * ks + 8 * g), fk = ldfrag(KT + (16 * tn + li) * 72 + 32 * ks + 8 * g);
                    ab = mfma16(fa, fb, ab); ak = mfma16(fa, fk, ak); rb = mfma16(fr, fb, rb); rk = mfma16(fr, fk, rk); }
            }
#pragma unroll
            for (int r = 0; r < 4; ++r) { const int t = 16 * tm + 4 * g + r, s = 16 * tn + li; const bool st = s < t, in = s <= t;
                AAB[t * 68 + s] = st ? ab[r] : 0.f; AAK[t * 72 + s] = (bf16_t)f2bf(st ? ak[r] : 0.f); ARB[t * 72 + s] = (bf16_t)f2bf(in ? rb[r] : 0.f); ARK[t * 72 + s] = (bf16_t)f2bf(in ? rk[r] : 0.f); }
        }
        BAR_LDS();
#pragma unroll
        for (int q2 = 0; q2 < 2; ++q2) {
            const int idx = 2 * wave + q2, tm = idx >> 2, tn = idx & 3; f32x4 acc = {0.f, 0.f, 0.f, 0.f};
#pragma unroll
            for (int ks = 0; ks < 2; ++ks) acc = mfma16(ldfrag(AAK + (16 * tm + li) * 72 + 32 * ks + 8 * g), ldfrag(VT + (16 * tn + li) * 72 + 32 * ks + 8 * g), acc);
#pragma unroll
            for (int r = 0; r < 4; ++r) AKV[(16 * tm + 4 * g + r) * 68 + 16 * tn + li] = acc[r];
        }
        BAR_LDS();
        {
            const int col = tv >> 2, q = tv & 3, cl6 = col & 63; const bool first = col < 64;
            float x[16], rh[16];
#pragma unroll
            for (int m = 0; m < 4; ++m)
#pragma unroll
                for (int e = 0; e < 4; ++e) { const int t = 16 * m + 4 * q + e; const float r1 = bf2f(KKT[t * 72 + cl6]), r2 = AKV[t * 68 + cl6]; rh[4 * m + e] = first ? r1 : r2; }
            fwd_subst<4>(AAB, rh, x, q);
            BAR_LDS();
            if (first) {
#pragma unroll
                for (int m = 0; m < 4; ++m)
#pragma unroll
                    for (int e = 0; e < 4; ++e) KKT[(16 * m + 4 * q + e) * 72 + cl6] = (bf16_t)f2bf(x[4 * m + e]);
            } else {
#pragma unroll
                for (int m = 0; m < 4; ++m) *(LAS f32x4*)(AKV + cl6 * 68 + 16 * m + 4 * q) = (f32x4){x[4 * m], x[4 * m + 1], x[4 * m + 2], x[4 * m + 3]};
            }
        }
        BAR_LDS();
        if (wave < 4) {
            bf16x8 sb[2], vf[2];
#pragma unroll
            for (int ks = 0; ks < 2; ++ks) { sb[ks] = acc2b(S[2 * ks], S[2 * ks + 1]); vf[ks] = ldfrag(VT + (v0 + li) * 72 + 32 * ks + 8 * g); }
            f32x4 U[4];
#pragma unroll
            for (int mt = 0; mt < 4; ++mt) { f32x4 p = *(const LAS f32x4*)(AKV + (v0 + li) * 68 + 16 * mt + 4 * g);
#pragma unroll
                for (int ks = 0; ks < 2; ++ks) p = mfma16(ldperm(KKT + (16 * mt + li) * 72 + 32 * ks + 4 * g), sb[ks], p);
                U[mt] = -p; }
            bf16x8 ub[2];
#pragma unroll
            for (int k2 = 0; k2 < 2; ++k2) ub[k2] = acc2b(U[2 * k2], U[2 * k2 + 1]);
#pragma unroll
            for (int mt = 0; mt < 4; ++mt) { f32x4 o = {0.f, 0.f, 0.f, 0.f};
#pragma unroll
                for (int ks = 0; ks < 2; ++ks) { o = mfma16(ldperm(RT + (16 * mt + li) * 72 + 32 * ks + 4 * g), sb[ks], o); o = mfma16(ldperm(ARB + (16 * mt + li) * 72 + 32 * ks + 4 * g), ub[ks], o);
                    o = mfma16(ldfrag(ARK + (16 * mt + li) * 72 + 32 * ks + 8 * g), vf[ks], o); }
#pragma unroll
                for (int r = 0; r < 4; ++r) Oout[chain_row(rbase, T, dir, c * 64 + 16 * mt + 4 * g + r) * 512 + v0 + li] = (bf16_t)f2bf(o[r]); }
#pragma unroll
            for (int dt = 0; dt < 4; ++dt) { f32x4 acc = S[dt] * *(const LAS f32x4*)(GL + 16 * dt + 4 * g);
#pragma unroll
                for (int ks = 0; ks < 2; ++ks) { acc = mfma16(ldperm(BDT + (16 * dt + li) * 72 + 32 * ks + 4 * g), ub[ks], acc); acc = mfma16(ldfrag(KDT + (16 * dt + li) * 72 + 32 * ks + 8 * g), vf[ks], acc); }
                S[dt] = acc; }
        }
        pf_acc ^= pfv;
        BAR_LDS();
    }
    if (pf_acc == 0x9e3779b9u) GL[0] = 1.f;
    if (sout && wave < 4) {
        int sidx = (v0 + li0) * 64 + 4 * g0; OPAQUE(sidx);
#pragma unroll
        for (int dt = 0; dt < 4; ++dt) *(f32x4*)(sout + sidx + 16 * dt) = S[dt];
    }
}


constexpr int RWR_BYTES = 65536;
DEV void rwkv_prep_item(const Args& a, LAS unsigned char* lds, int tid, int lane_in, int wave, int T, int rbase, int h, int dir, int c, unsigned char* rec_in) {
    const BufRes rec = make_buf(rec_in);
    const int pfl = a.flags;
    if (pfl & 64) return;
    const bf16_t* PROJ = (const bf16_t*)(a.ws + WS_PROJ);
    LAS bf16_t* RT = (LAS bf16_t*)(lds + RW_RT);
    LAS bf16_t* KKT = (LAS bf16_t*)(lds + RW_KKT);
    LAS bf16_t* BT = (LAS bf16_t*)(lds + RW_BT);
    LAS bf16_t* KT = (LAS bf16_t*)(lds + RW_KT);
    LAS bf16_t* KDT = (LAS bf16_t*)(lds + RW_KDT);
    LAS bf16_t* BDT = (LAS bf16_t*)(lds + RW_BDT);
    LAS bf16_t* VT = (LAS bf16_t*)(lds + RW_VT);
    LAS float* AAB = (LAS float*)(lds + RW_AAB);
    LAS float* AKV = (LAS float*)(lds + RW_AKV);
    LAS bf16_t* AAK = (LAS bf16_t*)(lds + RW_AAK);
    LAS bf16_t* ARB = (LAS bf16_t*)(lds + RW_ARB);
    LAS bf16_t* ARK = (LAS bf16_t*)(lds + RW_ARK);
    LAS float* SEG = (LAS float*)(lds + RW_SEG);
    LAS float* GL = (LAS float*)(lds + RW_GL);
    const int seg = wave, cw = dir ? C0_WB : C0_WF;
    const float* mu = a.in[I0_MU];
    float* corr = (float*)(a.ws + WS_CORR);
    const int li0 = lane_in & 15, g0 = lane_in >> 4;
    bf16x8 w2f[2], a2f[2];
#if !defined(EMU)
    {
        const u32x4* tb = (const u32x4*)(a.ws + WS_LORA);
#pragma unroll
        for (int ks = 0; ks < 2; ++ks) { w2f[ks] = __builtin_bit_cast(bf16x8, tb[(size_t)((((dir ? 1 : 0) * 8 + h) * 4 + (wave & 3)) * 2 + ks) * 64 + lane_in]);
            a2f[ks] = __builtin_bit_cast(bf16x8, tb[(size_t)(((2 * 8 + h) * 4 + (wave & 3)) * 2 + ks) * 64 + lane_in]); }
    }
#else
    {
        const float* w2 = a.in[dir ? I0_W2B : I0_W2F]; const float* a2 = a.in[I0_A2]; const int dc = h * 64 + 16 * (wave & 3) + li0;
#pragma unroll
        for (int ks = 0; ks < 2; ++ks) { float tw[8], ta[8];
#pragma unroll
            for (int j = 0; j < 8; ++j) { tw[j] = w2[(32 * ks + 8 * g0 + j) * 512 + dc]; ta[j] = a2[(32 * ks + 8 * g0 + j) * 512 + dc]; }
            w2f[ks] = __builtin_bit_cast(bf16x8, pack8(tw)); a2f[ks] = __builtin_bit_cast(bf16x8, pack8(ta)); }
    }
#endif
    {
        int tv = tid; OPAQUE(tv);
        const int lane = tv & 63, li = lane & 15, g = lane >> 4, d = lane, hc = h * 64 + d;
        float rr[8], ks_[8], vv[8];
        {
            const int n0 = c * 64 + 8 * seg;
            const float mu_r = mu[C0_R + hc], mu_k = mu[C0_K + hc], mu_v = mu[C0_V + hc], mu_w = mu[cw + d], mu_a = mu[C0_A + d];
            float xr[10], xk[10], xv[10], xw[10], xa[10];
            unsigned short qr_[10], qk_[10], qv_[10], qw_[10], qa_[10];
#pragma unroll
            for (int i = 0; i < 10; ++i) { const int n = n0 - 1 + i; const int nc = n < 0 ? 0 : (n > T - 1 ? T - 1 : n);
                const bf16_t* p = PROJ + chain_row(rbase, T, dir, nc) * L0_LD;
                qr_[i] = p[C0_R + hc]; qk_[i] = p[C0_K + hc]; qv_[i] = p[C0_V + hc]; qw_[i] = p[cw + d]; qa_[i] = p[C0_A + d]; }
            SCHED_BARRIER();
#pragma unroll
            for (int i = 0; i < 10; ++i) { const int n = n0 - 1 + i; const bool ok = n >= 0 && n <= T - 1; const float m = ok ? 1.f : 0.f;
                xr[i] = bf2f(qr_[i]) * m; xk[i] = bf2f(qk_[i]) * m; xv[i] = bf2f(qv_[i]) * m; xw[i] = bf2f(qw_[i]) * m; xa[i] = bf2f(qa_[i]) * m; }
#pragma unroll
            for (int e = 0; e < 8; ++e) { const int tt = 8 * seg + e;
                rr[e] = xr[e + 1] + mu_r * (0.5f * (xr[e] + xr[e + 2]) - xr[e + 1]); ks_[e] = xk[e + 1] + mu_k * (0.5f * (xk[e] + xk[e + 2]) - xk[e + 1]); vv[e] = xv[e + 1] + mu_v * (0.5f * (xv[e] + xv[e + 2]) - xv[e + 1]);
                AAK[tt * 72 + d] = (bf16_t)f2bf(tanhf_(xw[e + 1] + mu_w * (0.5f * (xw[e] + xw[e + 2]) - xw[e + 1]))); ARB[tt * 72 + d] = (bf16_t)f2bf(xa[e + 1] + mu_a * (0.5f * (xa[e] + xa[e + 2]) - xa[e + 1])); }
        }
        BAR_LDS();
        {
            const int tn = wave & 3;
#pragma unroll
            for (int t2 = 0; t2 < 2; ++t2) { const int tm = 2 * (wave >> 2) + t2; f32x4 aw = {0.f, 0.f, 0.f, 0.f}, aa = {0.f, 0.f, 0.f, 0.f};
#pragma unroll
                for (int ks = 0; ks < 2; ++ks) { aw = mfma16(ldfrag(AAK + (16 * tm + li) * 72 + 32 * ks + 8 * g), w2f[ks], aw); aa = mfma16(ldfrag(ARB + (16 * tm + li) * 72 + 32 * ks + 8 * g), a2f[ks], aa); }
#pragma unroll
                for (int r = 0; r < 4; ++r) { AAB[(16 * tm + 4 * g + r) * 68 + 16 * tn + li] = aw[r]; AKV[(16 * tm + 4 * g + r) * 68 + 16 * tn + li] = aa[r]; } }
        }
        BAR_LDS();
        float kk[8], bb[8], lw[8], cl[8];
        {
            const float w0 = a.in[dir ? I0_W0B : I0_W0F][hc], a0v = a.in[I0_A0][hc], kkc = a.in[I0_KK][hc], kac = a.in[I0_KA][hc], rkc = a.in[I0_RK][hc];
            float run = 0.f;
#pragma unroll
            for (int e = 0; e < 8; ++e) { const int tt = 8 * seg + e;
                lw[e] = -0.6065306597126334f * sigmoidf_(AAB[tt * 68 + d] + w0); const float av = sigmoidf_(AKV[tt * 68 + d] + a0v);
                const float kkp = ks_[e] * kkc; kk[e] = kkp * rsqf_(wave_sum_f(kkp * kkp) + 1e-6f);
                ks_[e] = ks_[e] * (1.f + (av - 1.f) * kac); bb[e] = kk[e] * av;
                const float cr = wave_sum_f(rr[e] * ks_[e] * rkc);
                if (dir == 0 && lane == 0) corr[chain_row(rbase, T, dir, c * 64 + tt) * 8 + h] = cr;
                run += lw[e]; cl[e] = run; }
            SEG[seg * 64 + d] = run;
        }
        BAR_LDS();
        {
            float off = 0.f, tot = 0.f;
#pragma unroll
            for (int s2 = 0; s2 < 8; ++s2) { const float sv = SEG[s2 * 64 + d]; tot += sv; off += (s2 < seg) ? sv : 0.f; }
            float kd[8], bd[8];
#pragma unroll
            for (int e = 0; e < 8; ++e) { const int tt = 8 * seg + e; const float lwi = off + cl[e], lwx = lwi - lw[e]; const float ei = __expf(-lwi), ed = __expf(tot - lwi);
                RT[tt * 72 + d] = (bf16_t)f2bf(rr[e] * __expf(lwi)); KKT[tt * 72 + d] = (bf16_t)f2bf(kk[e] * __expf(lwx)); BT[tt * 72 + d] = (bf16_t)f2bf(bb[e] * ei); KT[tt * 72 + d] = (bf16_t)f2bf(ks_[e] * ei);
                kd[e] = ks_[e] * ed; bd[e] = bb[e] * ed; }
            *(LAS u32x4*)(KDT + d * 72 + 8 * seg) = pack8(kd); *(LAS u32x4*)(BDT + d * 72 + 8 * seg) = pack8(bd); *(LAS u32x4*)(VT + d * 72 + 8 * seg) = pack8(vv);
            if (seg == 0) GL[d] = __expf(tot);
        }
        BAR_LDS();
#pragma unroll
        for (int q2 = 0; q2 < 2; ++q2) {
            const int idx = 2 * wave + q2, tm = idx >> 2, tn = idx & 3; f32x4 ab = {0.f, 0.f, 0.f, 0.f}, ak = ab, rb = ab, rk = ab;
            if (tn <= tm) {
#pragma unroll
                for (int ks = 0; ks < 2; ++ks) { const bf16x8 fa = ldfrag(KKT + (16 * tm + li) * 72 + 32 * ks + 8 * g), fr = ldfrag(RT + (16 * tm + li) * 72 + 32 * ks + 8 * g);
                    const bf16x8 fb = ldfrag(BT + (16 * tn + li) * 72 + 32 * ks + 8 * g), fk = ldfrag(KT + (16 * tn + li) * 72 + 32 * ks + 8 * g);
                    ab = mfma16(fa, fb, ab); ak = mfma16(fa, fk, ak); rb = mfma16(fr, fb, rb); rk = mfma16(fr, fk, rk); }
            }
#pragma unroll
            for (int r = 0; r < 4; ++r) { const int t = 16 * tm + 4 * g + r, s = 16 * tn + li; const bool st = s < t, in = s <= t;
                AAB[t * 68 + s] = st ? ab[r] : 0.f; AAK[t * 72 + s] = (bf16_t)f2bf(st ? ak[r] : 0.f); ARB[t * 72 + s] = (bf16_t)f2bf(in ? rb[r] : 0.f); ARK[t * 72 + s] = (bf16_t)f2bf(in ? rk[r] : 0.f); }
        }
        BAR_LDS();
#pragma unroll
        for (int q2 = 0; q2 < 2; ++q2) {
            const int idx = 2 * wave + q2, tm = idx >> 2, tn = idx & 3; f32x4 acc = {0.f, 0.f, 0.f, 0.f};
#pragma unroll
            for (int ks = 0; ks < 2; ++ks) acc = mfma16(ldfrag(AAK + (16 * tm + li) * 72 + 32 * ks + 8 * g), ldfrag(VT + (16 * tn + li) * 72 + 32 * ks + 8 * g), acc);
#pragma unroll
            for (int r = 0; r < 4; ++r) AKV[(16 * tm + 4 * g + r) * 68 + 16 * tn + li] = acc[r];
            f32x4 ork = {0.f, 0.f, 0.f, 0.f}, skv = {0.f, 0.f, 0.f, 0.f};
#pragma unroll
            for (int ks = 0; ks < 2; ++ks) { const bf16x8 vb = ldfrag(VT + (16 * tn + li) * 72 + 32 * ks + 8 * g);
                ork = mfma16(ldfrag(ARK + (16 * tm + li) * 72 + 32 * ks + 8 * g), vb, ork); skv = mfma16(ldfrag(KDT + (16 * tm + li) * 72 + 32 * ks + 8 * g), vb, skv); }
            bst8(rec, 40960 + ((16 * tn + li) * 64 + 16 * tm + 4 * g) * 2, (u32x2){pk2(ork[0], ork[1]), pk2(ork[2], ork[3])});
            bst8(rec, 49152 + ((16 * tn + li) * 64 + 16 * tm + 4 * g) * 2, (u32x2){pk2(skv[0], skv[1]), pk2(skv[2], skv[3])});
        }
        {
            const int row = tv >> 3, cc = tv & 7; const f32x4 u0 = *(const LAS f32x4*)(AAB + row * 68 + 8 * cc), u1 = *(const LAS f32x4*)(AAB + row * 68 + 8 * cc + 4);
            const float u8[8] = {u0[0], u0[1], u0[2], u0[3], u1[0], u1[1], u1[2], u1[3]}; *(LAS u32x4*)(BT + row * 72 + 8 * cc) = pack8(u8);
        }
        BAR_LDS();
        {
            LAS bf16_t* ABF = BT; LAS bf16_t* DBF = KT;
            if (wave < 4) { if (!(pfl & 128)) diag16_inverse<40>(AAB, DBF, wave, lane); }
            else {
                const int tq = tv - 256;
#pragma unroll
                for (int jj = 0; jj < 2; ++jj) { const int l = tq + 256 * jj, row = l >> 3, cc = l & 7;
                    bst16(rec, 0 * 8192 + l * 16, *(const LAS u32x4*)(RT + row * 72 + 8 * cc));
                    bst16(rec, 2 * 8192 + l * 16, *(const LAS u32x4*)(ARB + row * 72 + 8 * cc));
                    bst16(rec, 3 * 8192 + l * 16, *(const LAS u32x4*)(BDT + row * 72 + 8 * cc)); }
                if (tq < 16) bst16(rec, 7 * 8192 + tq * 16, __builtin_bit_cast(u32x4, *(const LAS f32x4*)(GL + 4 * tq)));
            }
            BAR_LDS();
            f32x4 X[4];
            if (wave < 4) {
                const int col = 16 * wave + li;
                block_solve16<40>(ABF, DBF, [&](int I) { const LAS bf16_t* q_ = KKT + (16 * I + 4 * g) * 72 + col; return (f32x4){bf2f(q_[0]), bf2f(q_[72]), bf2f(q_[144]), bf2f(q_[216])}; }, X, li, g);
#pragma unroll
                for (int I = 0; I < 4; ++I)
#pragma unroll
                    for (int r = 0; r < 4; ++r) KKT[(16 * I + 4 * g + r) * 72 + col] = (bf16_t)f2bf(X[I][r]);
            } else {
                const int col = 16 * (wave - 4) + li;
                block_solve16<40>(ABF, DBF, [&](int I) { const LAS float* q_ = AKV + (16 * I + 4 * g) * 68 + col; return (f32x4){q_[0], q_[68], q_[136], q_[204]}; }, X, li, g);
#pragma unroll
                for (int I = 0; I < 4; ++I) bst8(rec, 4 * 8192 + (col * 64 + 16 * I + 4 * g) * 2, (u32x2){pk2(X[I][0], X[I][1]), pk2(X[I][2], X[I][3])});
            }
        }
        BAR_LDS();
        bst16(rec, 1 * 8192 + tv * 16, *(const LAS u32x4*)(KKT + (tv >> 3) * 72 + 8 * (tv & 7)));
    }
    BAR_LDS();
}

constexpr int RWE_RT = 0, RWE_WM = 9216, RWE_ARB = 18432, RWE_BDT = 27648, RWE_ULT = 36864, RWE_ORKT = 46080, RWE_SKVT = 55296, RWE_GL = 64512, RWE_END = 64768;
DEV f32x4 ld4bf(const LAS bf16_t* p) { const u32x2 v = *(const LAS u32x2*)p; return (f32x4){__uint_as_float(v.x << 16), __uint_as_float(v.x & 0xffff0000u), __uint_as_float(v.y << 16), __uint_as_float(v.y & 0xffff0000u)}; }
DEV void rwkv_esteps(const Args& a, LAS unsigned char* lds, int tid_in, int lane_in, int wave, int T, int rbase, int h, int dir, int c0, int n, const unsigned char* recs_in, f32x4 (&S)[4]) {
    const BufRes recs = make_buf(recs_in);
    int tid = tid_in; OPAQUE(tid); const int lane = tid & 63;
    LAS bf16_t* ERT = (LAS bf16_t*)(lds + RWE_RT); LAS bf16_t* EWM = (LAS bf16_t*)(lds + RWE_WM); LAS bf16_t* EARB = (LAS bf16_t*)(lds + RWE_ARB); LAS bf16_t* EBDT = (LAS bf16_t*)(lds + RWE_BDT);
    LAS bf16_t* EULT = (LAS bf16_t*)(lds + RWE_ULT); LAS bf16_t* EORKT = (LAS bf16_t*)(lds + RWE_ORKT); LAS bf16_t* ESKVT = (LAS bf16_t*)(lds + RWE_SKVT); LAS float* EGL = (LAS float*)(lds + RWE_GL);
    bf16_t* Oout = (bf16_t*)(a.ws + WS_XB) + (dir ? (size_t)MROWS * 512 : 0) + h * 64;
    const int li = lane & 15, g = lane >> 4, v0 = 16 * (wave & 3);
    u32x4 rg[8], rh[8];
#pragma unroll
    for (int j = 0; j < 8; ++j) { rg[j] = bld16(recs, j * 8192 + tid * 16, 0); rh[j] = bld16(recs, j * 8192 + tid * 16, (n > 1 ? 1 : 0) * RWR_BYTES); }
    for (int i = 0; i < n; ++i) {
        {
            const int row = tid >> 3, cc = tid & 7;
#pragma unroll
            for (int j = 0; j < 7; ++j) *(LAS u32x4*)(lds + j * 9216 + row * 144 + cc * 16) = rg[j];
            if (tid < 16) *(LAS u32x4*)(lds + RWE_GL + tid * 16) = rg[7];
        }
        BAR_LDS();
        {
            const unsigned nx = (unsigned)(i + 2 < n ? i + 2 : n - 1) * RWR_BYTES;
#pragma unroll
            for (int j = 0; j < 8; ++j) { rg[j] = rh[j]; rh[j] = bld16(recs, j * 8192 + tid * 16, nx); }
        }
        if (wave < 4) {
            bf16x8 sb[2];
#pragma unroll
            for (int ks = 0; ks < 2; ++ks) sb[ks] = acc2b(S[2 * ks], S[2 * ks + 1]);
            f32x4 U[4];
#pragma unroll
            for (int mt = 0; mt < 4; ++mt) { f32x4 p = ld4bf(EULT + (v0 + li) * 72 + 16 * mt + 4 * g);
#pragma unroll
                for (int ks = 0; ks < 2; ++ks) p = mfma16(ldperm(EWM + (16 * mt + li) * 72 + 32 * ks + 4 * g), sb[ks], p);
                U[mt] = -p; }
            bf16x8 ub[2];
#pragma unroll
            for (int k2 = 0; k2 < 2; ++k2) ub[k2] = acc2b(U[2 * k2], U[2 * k2 + 1]);
#pragma unroll
            for (int mt = 0; mt < 4; ++mt) { f32x4 o = ld4bf(EORKT + (v0 + li) * 72 + 16 * mt + 4 * g);
#pragma unroll
                for (int ks = 0; ks < 2; ++ks) { o = mfma16(ldperm(ERT + (16 * mt + li) * 72 + 32 * ks + 4 * g), sb[ks], o); o = mfma16(ldperm(EARB + (16 * mt + li) * 72 + 32 * ks + 4 * g), ub[ks], o); }
#pragma unroll
                for (int r = 0; r < 4; ++r) Oout[chain_row(rbase, T, dir, (c0 + i) * 64 + 16 * mt + 4 * g + r) * 512 + v0 + li] = (bf16_t)f2bf(o[r]); }
#pragma unroll
            for (int dt = 0; dt < 4; ++dt) { f32x4 acc = S[dt] * *(const LAS f32x4*)(EGL + 16 * dt + 4 * g) + ld4bf(ESKVT + (v0 + li) * 72 + 16 * dt + 4 * g);
#pragma unroll
                for (int ks = 0; ks < 2; ++ks) acc = mfma16(ldperm(EBDT + (16 * dt + li) * 72 + 32 * ks + 4 * g), ub[ks], acc);
                S[dt] = acc; }
        }
        BAR_LDS();
    }
}

constexpr int GLR_BYTES = 49152;
DEV void gla_prep_item(const Args& a, LAS unsigned char* lds, int tid_in, int lane_in, int wave, int T, int rbase, int h, int dir, int c, unsigned char* rec_in) {
    const BufRes rec = make_buf(rec_in);
    if (a.flags & 4096) return;
    int tid = tid_in; OPAQUE(tid); const int lane = tid & 63;
    const bf16_t* PROJ = (const bf16_t*)(a.ws + WS_PROJ);
    LAS bf16_t* QT = (LAS bf16_t*)(lds + GL_QT);
    LAS bf16_t* KT = (LAS bf16_t*)(lds + GL_KT);
    LAS bf16_t* KD = (LAS bf16_t*)(lds + GL_KD);
    LAS bf16_t* VT = (LAS bf16_t*)(lds + GL_VT);
    LAS bf16_t* ATT = (LAS bf16_t*)(lds + GL_ATT);
    LAS float* DEC = (LAS float*)(lds + GL_DEC);
    LAS float* SEG = (LAS float*)(lds + GL_SEG);
    LAS float* GIN = (LAS float*)(lds + GL_GIN);
    const int d = lane, seg = wave, hc = h * 64 + d;
    const float* g2 = a.in[dir ? I1_G2B : I1_G2F];
    float g2c[16];
#pragma unroll
    for (int i = 0; i < 16; ++i) g2c[i] = g2[i * 256 + hc];
    const float gb = a.in[dir ? I1_GBB : I1_GBF][hc];
    const int cgin = dir ? C1_GB : C1_GF;
    const int li = lane & 15, g = lane >> 4;
    const int ltt = tid >> 3, lp = tid & 7;
    unsigned graw; u32x4 vraw0, vraw1; unsigned short qraw[8], kraw[8];
    { const bf16_t* pr_ = PROJ + chain_row(rbase, T, dir, c * 64 + ltt) * L1_LD; graw = *(const unsigned*)(pr_ + cgin + 2 * lp);
      vraw0 = *(const u32x4*)(pr_ + C1_GV + h * 128 + 16 * lp); vraw1 = *(const u32x4*)(pr_ + C1_GV + h * 128 + 16 * lp + 8);
#pragma unroll
      for (int e = 0; e < 8; ++e) { const bf16_t* pq_ = PROJ + chain_row(rbase, T, dir, c * 64 + 8 * seg + e) * L1_LD; qraw[e] = pq_[C1_GQ + hc]; kraw[e] = pq_[C1_GK + hc]; } }
    {
        GIN[ltt * 16 + 2 * lp] = bf2f(graw & 0xffffu); GIN[ltt * 16 + 2 * lp + 1] = bf2f(graw >> 16);
        {
            const unsigned vw[8] = {vraw0.x, vraw0.y, vraw0.z, vraw0.w, vraw1.x, vraw1.y, vraw1.z, vraw1.w};
#pragma unroll
            for (int jj = 0; jj < 8; ++jj) { VT[(16 * lp + 2 * jj) * 72 + ltt] = (bf16_t)(vw[jj] & 0xffffu); VT[(16 * lp + 2 * jj + 1) * 72 + ltt] = (bf16_t)(vw[jj] >> 16); }
        }
        float qf[8], kf[8];
#pragma unroll
        for (int e = 0; e < 8; ++e) { qf[e] = bf2f(qraw[e]); kf[e] = bf2f(kraw[e]); }
        BAR_LDS();
        float cl[8];
        {
            float run = 0.f;
#pragma unroll
            for (int e = 0; e < 8; ++e) {
                const LAS f32x4* g4 = (const LAS f32x4*)(GIN + (8 * seg + e) * 16); float x = gb;
#pragma unroll
                for (int i = 0; i < 4; ++i) { const f32x4 y = g4[i]; x += y[0] * g2c[4 * i] + y[1] * g2c[4 * i + 1] + y[2] * g2c[4 * i + 2] + y[3] * g2c[4 * i + 3]; }
                run += log_sigmoidf_(x) * (1.f / 16.f); cl[e] = run;
            }
            SEG[seg * 64 + d] = run;
        }
        BAR_LDS();
        {
            float off = 0.f, tot = 0.f;
#pragma unroll
            for (int s2 = 0; s2 < 8; ++s2) { const float sv = SEG[s2 * 64 + d]; tot += sv; off += (s2 < seg) ? sv : 0.f; }
            float kd[8];
#pragma unroll
            for (int e = 0; e < 8; ++e) { const float cum = off + cl[e]; const int tt = 8 * seg + e; const float eq = __expf(cum);
                QT[tt * 72 + d] = (bf16_t)f2bf(qf[e] * 0.125f * eq); KT[tt * 72 + d] = (bf16_t)f2bf(kf[e] * __expf(-cum)); kd[e] = kf[e] * __expf(tot - cum); }
            *(LAS u32x4*)(KD + d * 72 + 8 * seg) = pack8(kd);
            if (seg == 0) DEC[d] = __expf(tot);
        }
        BAR_LDS();
#pragma unroll
        for (int q2 = 0; q2 < 2; ++q2) {
            const int idx = 2 * wave + q2, tm = idx >> 2, tn = idx & 3; f32x4 acc = {0.f, 0.f, 0.f, 0.f};
            if (tn <= tm) {
#pragma unroll
                for (int ks = 0; ks < 2; ++ks) acc = mfma16(ldfrag(QT + (16 * tm + li) * 72 + 32 * ks + 8 * g), ldfrag(KT + (16 * tn + li) * 72 + 32 * ks + 8 * g), acc);
            }
#pragma unroll
            for (int r = 0; r < 4; ++r) { const int t = 16 * tm + 4 * g + r, s = 16 * tn + li; ATT[t * 72 + s] = (bf16_t)f2bf((s <= t) ? acc[r] : 0.f); }
        }
        BAR_LDS();
#pragma unroll
        for (int q4 = 0; q4 < 4; ++q4) {
            const int idx = 4 * wave + q4, tm = idx >> 3, tn = idx & 7; f32x4 oa = {0.f, 0.f, 0.f, 0.f}, sk = {0.f, 0.f, 0.f, 0.f};
#pragma unroll
            for (int ks = 0; ks < 2; ++ks) { const bf16x8 vb = ldfrag(VT + (16 * tn + li) * 72 + 32 * ks + 8 * g);
                oa = mfma16(ldfrag(ATT + (16 * tm + li) * 72 + 32 * ks + 8 * g), vb, oa); sk = mfma16(ldfrag(KD + (16 * tm + li) * 72 + 32 * ks + 8 * g), vb, sk); }
            bst8(rec, 8192 + ((16 * tn + li) * 64 + 16 * tm + 4 * g) * 2, (u32x2){pk2(oa[0], oa[1]), pk2(oa[2], oa[3])});
            bst8(rec, 24576 + ((16 * tn + li) * 64 + 16 * tm + 4 * g) * 2, (u32x2){pk2(sk[0], sk[1]), pk2(sk[2], sk[3])});
        }
        bst16(rec, tid * 16, *(const LAS u32x4*)(QT + (tid >> 3) * 72 + 8 * (tid & 7)));
        if (tid < 16) bst16(rec, 40960 + tid * 16, __builtin_bit_cast(u32x4, *(const LAS f32x4*)(DEC + 4 * tid)));
    }
    BAR_LDS();
}
constexpr int GLE_QT = 0, GLE_OAVT = 9216, GLE_SKVT = 27648, GLE_DEC = 46080, GLE_END = 46336;
DEV void gla_esteps(const Args& a, LAS unsigned char* lds, int tid_in, int lane_in, int wave, int T, int rbase, int h, int dir, int c0, int n, int acc_from, const unsigned char* recs_in, f32x4 (&S)[8]) {
    const BufRes recs = make_buf(recs_in);
    int tid = tid_in; OPAQUE(tid); const int lane = tid & 63;
    LAS bf16_t* EQT = (LAS bf16_t*)(lds + GLE_QT); LAS bf16_t* EOAVT = (LAS bf16_t*)(lds + GLE_OAVT); LAS bf16_t* ESKVT = (LAS bf16_t*)(lds + GLE_SKVT); LAS float* EDEC = (LAS float*)(lds + GLE_DEC);
    bf16_t* O4 = (bf16_t*)(a.ws + WS_XA) + h * 128;
    const int li = lane & 15, g = lane >> 4, v0 = 16 * wave;
    u32x4 rg[6], rh[6];
#pragma unroll
    for (int j = 0; j < 6; ++j) { rg[j] = bld16(recs, j * 8192 + tid * 16, 0); rh[j] = bld16(recs, j * 8192 + tid * 16, (n > 1 ? 1 : 0) * GLR_BYTES); }
    for (int i = 0; i < n; ++i) {
        {
            const int row = tid >> 3, cc = tid & 7;
            *(LAS u32x4*)(lds + GLE_QT + row * 144 + cc * 16) = rg[0];
            *(LAS u32x4*)(lds + GLE_OAVT + row * 144 + cc * 16) = rg[1]; *(LAS u32x4*)(lds + GLE_OAVT + (row + 64) * 144 + cc * 16) = rg[2];
            *(LAS u32x4*)(lds + GLE_SKVT + row * 144 + cc * 16) = rg[3]; *(LAS u32x4*)(lds + GLE_SKVT + (row + 64) * 144 + cc * 16) = rg[4];
            if (tid < 16) *(LAS u32x4*)(lds + GLE_DEC + tid * 16) = rg[5];
        }
        BAR_LDS();
        {
            const unsigned nx = (unsigned)(i + 2 < n ? i + 2 : n - 1) * GLR_BYTES;
#pragma unroll
            for (int j = 0; j < 6; ++j) { rg[j] = rh[j]; rh[j] = bld16(recs, j * 8192 + tid * 16, nx); }
        }
        {
            const bool accum = (c0 + i) >= acc_from;
            unsigned short pv[4][4];
#pragma unroll
            for (int mt = 0; mt < 4; ++mt)
#pragma unroll
                for (int r = 0; r < 4; ++r) pv[mt][r] = O4[chain_row(rbase, T, dir, (c0 + i) * 64 + 16 * mt + 4 * g + r) * 1024 + v0 + li];
            bf16x8 sb[2];
#pragma unroll
            for (int ks = 0; ks < 2; ++ks) sb[ks] = acc2b(S[2 * ks], S[2 * ks + 1]);
#pragma unroll
            for (int mt = 0; mt < 4; ++mt) { f32x4 o = ld4bf(EOAVT + (v0 + li) * 72 + 16 * mt + 4 * g);
#pragma unroll
                for (int ks = 0; ks < 2; ++ks) o = mfma16(ldperm(EQT + (16 * mt + li) * 72 + 32 * ks + 4 * g), sb[ks], o);
#pragma unroll
                for (int r = 0; r < 4; ++r) { bf16_t* po = O4 + chain_row(rbase, T, dir, (c0 + i) * 64 + 16 * mt + 4 * g + r) * 1024 + v0 + li; const float prev = bf2f(pv[mt][r]); *po = (bf16_t)f2bf(accum ? o[r] + prev : o[r]); } }
#pragma unroll
            for (int dt = 0; dt < 4; ++dt) S[dt] = S[dt] * *(const LAS f32x4*)(EDEC + 16 * dt + 4 * g) + ld4bf(ESKVT + (v0 + li) * 72 + 16 * dt + 4 * g);
        }
        BAR_LDS();
    }
}

constexpr int GLE_IMG = 46592;
template <class CFG>
DEV void gla_stream(const Args& a, LAS unsigned char* lds, int tid_in, int wave, int n, const unsigned char* recs_in, const CFG& cfg, f32x4 (&S)[8]) {
    const BufRes recs = make_buf(recs_in);
    int tid = tid_in; OPAQUE(tid); const int lane = tid & 63;
    const int li = lane & 15, g = lane >> 4, v0 = 16 * wave;
    u32x4 rg[6];
#define GLS_LOAD(k) do { const unsigned so_ = cfg.rec_off(k); _Pragma("unroll") for (int j = 0; j < 6; ++j) rg[j] = bld16(recs, j * 8192 + tid * 16, so_); } while (0)
#define GLS_STAGE(img) do { LAS unsigned char* im_ = (img); const int row = tid >> 3, cc = tid & 7; \
        *(LAS u32x4*)(im_ + GLE_QT + row * 144 + cc * 16) = rg[0]; \
        *(LAS u32x4*)(im_ + GLE_OAVT + row * 144 + cc * 16) = rg[1]; *(LAS u32x4*)(im_ + GLE_OAVT + (row + 64) * 144 + cc * 16) = rg[2]; \
        *(LAS u32x4*)(im_ + GLE_SKVT + row * 144 + cc * 16) = rg[3]; *(LAS u32x4*)(im_ + GLE_SKVT + (row + 64) * 144 + cc * 16) = rg[4]; \
        if (tid < 16) *(LAS u32x4*)(im_ + GLE_DEC + tid * 16) = rg[5]; } while (0)
    { const unsigned f0 = cfg.flag_issue(0, wave), f1 = cfg.flag_issue(n > 1 ? 1 : 0, wave); cfg.flag_wait(0, f0, wave); cfg.flag_wait(n > 1 ? 1 : 0, f1, wave); }
    __syncthreads();
    GLS_LOAD(0);
    GLS_STAGE(lds);
    BAR_LDS();
    cfg.post(-1, S, tid);
    GLS_LOAD(n > 1 ? 1 : 0);
    for (int i = 0; i < n; ++i) {
        const int kf = i + 2 < n ? i + 2 : n - 1;
        const unsigned fl = cfg.flag_issue(kf, wave);
        int T, rbase, h, dir, cc_; bool accum; cfg.chunk(i, T, rbase, h, dir, cc_, accum);
        bf16_t* O4 = (bf16_t*)(a.ws + WS_XA) + h * 128;
        cfg.pre(i, S, tid, wave);
        LAS unsigned char* im = lds + (i & 1) * GLE_IMG;
        LAS bf16_t* EQT = (LAS bf16_t*)(im + GLE_QT); LAS bf16_t* EOAVT = (LAS bf16_t*)(im + GLE_OAVT); LAS bf16_t* ESKVT = (LAS bf16_t*)(im + GLE_SKVT); LAS float* EDEC = (LAS float*)(im + GLE_DEC);
        {
            unsigned short pv[4][4];
#pragma unroll
            for (int mt = 0; mt < 4; ++mt)
#pragma unroll
                for (int r = 0; r < 4; ++r) pv[mt][r] = O4[chain_row(rbase, T, dir, cc_ * 64 + 16 * mt + 4 * g + r) * 1024 + v0 + li];
            bf16x8 sb[2];
#pragma unroll
            for (int ks = 0; ks < 2; ++ks) sb[ks] = acc2b(S[2 * ks], S[2 * ks + 1]);
#pragma unroll
            for (int mt = 0; mt < 4; ++mt) { f32x4 o = ld4bf(EOAVT + (v0 + li) * 72 + 16 * mt + 4 * g);
#pragma unroll
                for (int ks = 0; ks < 2; ++ks) o = mfma16(ldperm(EQT + (16 * mt + li) * 72 + 32 * ks + 4 * g), sb[ks], o);
#pragma unroll
                for (int r = 0; r < 4; ++r) { bf16_t* po = O4 + chain_row(rbase, T, dir, cc_ * 64 + 16 * mt + 4 * g + r) * 1024 + v0 + li; const float prev = bf2f(pv[mt][r]); *po = (bf16_t)f2bf(accum ? o[r] + prev : o[r]); } }
#pragma unroll
            for (int dt = 0; dt < 4; ++dt) S[dt] = S[dt] * *(const LAS f32x4*)(EDEC + 16 * dt + 4 * g) + ld4bf(ESKVT + (v0 + li) * 72 + 16 * dt + 4 * g);
        }
        GLS_STAGE(lds + ((i + 1) & 1) * GLE_IMG);
        cfg.flag_wait(kf, fl, wave);
        BAR_LDS();
        cfg.post(i, S, tid);
        GLS_LOAD(kf);
    }
#undef GLS_LOAD
#undef GLS_STAGE
}

constexpr int GDR_BYTES = 81920;
DEV void gdn_prep_item(const Args& a, LAS unsigned char* lds, int tid, int lane_in, int wave, int T, int rbase, int h, int dir, int c, unsigned char* rec_in) {
    const BufRes rec = make_buf(rec_in);
    const int pfl = a.flags;
    if (pfl & 1024) return;
    const bf16_t* PROJ = (const bf16_t*)(a.ws + WS_PROJ);
    LAS bf16_t* Q = (LAS bf16_t*)(lds + GD_Q);
    LAS bf16_t* K = (LAS bf16_t*)(lds + GD_K);
    LAS bf16_t* V = (LAS bf16_t*)(lds + GD_V);
    LAS float* U0T = (LAS float*)(lds + GD_U0T);
    LAS bf16_t* KT = (LAS bf16_t*)(lds + GD_KT);
    LAS bf16_t* W = (LAS bf16_t*)(lds + GD_W);
    LAS bf16_t* AQK = (LAS bf16_t*)(lds + GD_AQK);
    LAS float* A = (LAS float*)(lds + GD_A);
    LAS float* SC = (LAS float*)(lds + GD_SC);
    LAS float* LOGA = SC, *BETA = SC + 64, *GC = SC + 128, *GAM = SC + 192, *EE = SC + 256, *BG = SC + 320, *GLs = SC + 384;
    LAS float* CW = (LAS float*)(lds + GD_CW);
    LAS bf16_t* ABF = (LAS bf16_t*)(lds + GD_END);
    LAS bf16_t* DBF = (LAS bf16_t*)(lds + GD_CW);
    const float nA = -__expf(a.in[dir ? I1_ALB : I1_ALF][h]), dtb = a.in[dir ? I1_DTB : I1_DTF][h];
    const int ca = dir ? C1_AB : C1_AF;
    for (int u = tid; u < 3 * 384; u += 512) { const int tap = u / 384, rem = u % 384, arr = rem >> 7, dd = rem & 127; CW[u] = a.in[I1_CONV][tap * 1536 + arr * 512 + h * 128 + dd]; }
    BAR_LDS();
    {
        int tv = tid; OPAQUE(tv);
        const int lane = tv & 63, li = lane & 15, g = lane >> 4, tt = tv >> 3, part = tv & 7;
        {
            const size_t row = chain_row(rbase, T, dir, c * 64 + tt); const int tact = (int)(row - rbase); const bool hp = tact > 0, hn = tact < T - 1;
            const bf16_t* pc = PROJ + row * L1_LD + C1_DQKV + h * 128 + 16 * part;
            const int op = hp ? -L1_LD : 0, on = hn ? L1_LD : 0; const float mp = hp ? 1.f : 0.f, mn = hn ? 1.f : 0.f;
            u32x4 ra[2][3], rb[2][3];
#define GDN_LD(dst, arr) do { _Pragma("unroll") for (int hf = 0; hf < 2; ++hf) { const bf16_t* p_ = pc + (arr) * 512 + 8 * hf; dst[hf][0] = *(const u32x4*)(p_ + op); dst[hf][1] = *(const u32x4*)p_; dst[hf][2] = *(const u32x4*)(p_ + on); } } while (0)
#define GDN_CONV(y, src, arr) do { _Pragma("unroll") for (int hf = 0; hf < 2; ++hf) { float cur[8], prv[8], nxt[8]; unpack8(src[hf][0], prv); unpack8(src[hf][1], cur); unpack8(src[hf][2], nxt); \
                _Pragma("unroll") for (int e4 = 0; e4 < 2; ++e4) { const int cb = (arr) * 128 + 16 * part + 8 * hf + 4 * e4; \
                    const f32x4 w0 = *(const LAS f32x4*)(CW + cb) * mp, w1 = *(const LAS f32x4*)(CW + 384 + cb), w2 = *(const LAS f32x4*)(CW + 768 + cb) * mn; \
                    _Pragma("unroll") for (int e = 0; e < 4; ++e) y[8 * hf + 4 * e4 + e] = siluf_(w0[e] * prv[4 * e4 + e] + w1[e] * cur[4 * e4 + e] + w2[e] * nxt[4 * e4 + e]); } } } while (0)
#define GDN_ST(dst, y) do { _Pragma("unroll") for (int hf = 0; hf < 2; ++hf) { float t8[8]; _Pragma("unroll") for (int e = 0; e < 8; ++e) t8[e] = y[8 * hf + e]; *(LAS u32x4*)(dst + tt * 136 + 16 * part + 8 * hf) = pack8(t8); } } while (0)
            GDN_LD(ra, 0); GDN_LD(rb, 1);
            SCHED_BARRIER();
            {
                float y[16]; GDN_CONV(y, ra, 0); float sq = 0.f;
#pragma unroll
                for (int e = 0; e < 16; ++e) sq += y[e] * y[e];
                const float qn = rsqf_(sum8(sq) + 1e-6f) * 0.08838834764831845f;
#pragma unroll
                for (int e = 0; e < 16; ++e) y[e] *= qn;
                GDN_ST(Q, y);
            }
            SCHED_BARRIER();
            GDN_LD(ra, 2);
            SCHED_BARRIER();
            {
                float y[16]; GDN_CONV(y, rb, 1); float sk = 0.f;
#pragma unroll
                for (int e = 0; e < 16; ++e) sk += y[e] * y[e];
                const float kn = rsqf_(sum8(sk) + 1e-6f);
#pragma unroll
                for (int e = 0; e < 16; ++e) y[e] *= kn;
                GDN_ST(K, y);
#pragma unroll
                for (int e = 0; e < 16; ++e) KT[(16 * part + e) * 72 + tt] = (bf16_t)f2bf(y[e]);
            }
            SCHED_BARRIER();
            {
                float y[16]; GDN_CONV(y, ra, 2); GDN_ST(V, y);
            }
#undef GDN_LD
#undef GDN_CONV
#undef GDN_ST
            if (part == 0) { const bf16_t* ps = PROJ + row * L1_LD; LOGA[tt] = nA * softplusf_(bf2f(ps[ca + h]) + dtb); BETA[tt] = sigmoidf_(bf2f(ps[C1_BETA + h])); }
        }
        BAR_LDS();
        if (wave == 0) {
            float x = LOGA[lane];
#pragma unroll
            for (int off = 1; off < 64; off <<= 1) { const float y2 = __shfl_up(x, off); x += (lane >= off) ? y2 : 0.f; }
            const float gl = __shfl(x, 63);
            GC[lane] = x; const float gm = __expf(x); GAM[lane] = gm; EE[lane] = __expf(gl - x); BG[lane] = BETA[lane] * gm;
            if (lane == 63) GLs[0] = __expf(gl);
        }
        BAR_LDS();
#pragma unroll
        for (int q2 = 0; q2 < 2; ++q2) {
            const int idx = 2 * wave + q2, tm = idx >> 2, tn = idx & 3; f32x4 ak = {0.f, 0.f, 0.f, 0.f}, aq = {0.f, 0.f, 0.f, 0.f};
            if (tn <= tm) {
#pragma unroll
                for (int ks = 0; ks < 4; ++ks) { const bf16x8 kb = ldfrag(K + (16 * tn + li) * 136 + 32 * ks + 8 * g);
                    ak = mfma16(ldfrag(K + (16 * tm + li) * 136 + 32 * ks + 8 * g), kb, ak); aq = mfma16(ldfrag(Q + (16 * tm + li) * 136 + 32 * ks + 8 * g), kb, aq); }
            }
            const int s = 16 * tn + li; const float gs = GC[s];
#pragma unroll
            for (int r = 0; r < 4; ++r) { const int t = 16 * tm + 4 * g + r; const float dec = __expf(fminf(GC[t] - gs, 0.f));
                const float av_ = (s < t) ? BETA[t] * dec * ak[r] : 0.f; A[t * 68 + s] = av_; ABF[t * 72 + s] = (bf16_t)f2bf(av_); AQK[t * 72 + s] = (bf16_t)f2bf((s <= t) ? dec * aq[r] : 0.f); }
        }
        BAR_LDS();
        {
            if (wave < 4) { if (!(pfl & 2048)) diag16_inverse<36>(A, DBF, wave, lane); }
            else {
                const int tq = tv - 256;
#pragma unroll
                for (int jj = 0; jj < 4; ++jj) { const int l = tq + 256 * jj;
                    bst16(rec, 16384 + l * 16, *(const LAS u32x4*)(Q + (l >> 4) * 136 + 8 * (l & 15)));
                    bst16(rec, 32768 + l * 16, *(const LAS u32x4*)(KT + (l >> 3) * 72 + 8 * (l & 7))); }
#pragma unroll
                for (int jj = 0; jj < 2; ++jj) { const int l = tq + 256 * jj; bst16(rec, 65536 + l * 16, *(const LAS u32x4*)(AQK + (l >> 3) * 72 + 8 * (l & 7))); }
                if (tq < 16) bst16(rec, 73728 + tq * 16, __builtin_bit_cast(u32x4, *(const LAS f32x4*)(GAM + 4 * tq)));
                else if (tq < 32) bst16(rec, 73728 + tq * 16, __builtin_bit_cast(u32x4, *(const LAS f32x4*)(EE + 4 * (tq - 16))));
                else if (tq == 32) bst16(rec, 73728 + 512, __builtin_bit_cast(u32x4, (f32x4){GLs[0], 0.f, 0.f, 0.f}));
            }
            BAR_LDS();
            const int col = 16 * wave + li; f32x4 X[4];
            block_solve16<36>(ABF, DBF, [&](int I) { const LAS bf16_t* q_ = K + (16 * I + 4 * g) * 136 + col; const f32x4 sc = *(const LAS f32x4*)(BG + 16 * I + 4 * g);
                return (f32x4){sc[0] * bf2f(q_[0]), sc[1] * bf2f(q_[136]), sc[2] * bf2f(q_[272]), sc[3] * bf2f(q_[408])}; }, X, li, g);
#pragma unroll
            for (int I = 0; I < 4; ++I)
#pragma unroll
                for (int r = 0; r < 4; ++r) W[(16 * I + 4 * g + r) * 136 + col] = (bf16_t)f2bf(X[I][r]);
            block_solve16<36>(ABF, DBF, [&](int I) { const LAS bf16_t* q_ = V + (16 * I + 4 * g) * 136 + col; const f32x4 sc = *(const LAS f32x4*)(BETA + 16 * I + 4 * g);
                return (f32x4){sc[0] * bf2f(q_[0]), sc[1] * bf2f(q_[136]), sc[2] * bf2f(q_[272]), sc[3] * bf2f(q_[408])}; }, X, li, g);
#pragma unroll
            for (int I = 0; I < 4; ++I) bst8(rec, 49152 + (col * 64 + 16 * I + 4 * g) * 2, (u32x2){pk2(X[I][0], X[I][1]), pk2(X[I][2], X[I][3])});
        }
        BAR_LDS();
#pragma unroll
        for (int jj = 0; jj < 2; ++jj) { const int l = tv + 512 * jj; bst16(rec, l * 16, *(const LAS u32x4*)(W + (l >> 4) * 136 + 8 * (l & 15))); }
    }
    BAR_LDS();
}
constexpr int GDE_W = 0, GDE_Q = 17408, GDE_KT = 34816, GDE_AQK = 53248, GDE_SC = 62464, GDE_IMG = 63488, GDE_END = 2 * GDE_IMG;
DEV void gdn_esteps(const Args& a, LAS unsigned char* lds, int tid_in, int lane_in, int wave, int T, int rbase, int h, int dir, int c0, int n, int acc_from, const unsigned char* recs_in, f32x4 (&S)[8]) {
    const BufRes recs = make_buf(recs_in);
    int tid = tid_in; OPAQUE(tid); const int lane = tid & 63;
    bf16_t* O4 = (bf16_t*)(a.ws + WS_XA) + 512 + h * 128;
    const int li = lane & 15, g = lane >> 4, v0 = 16 * wave;
    const int u0off = 49152 + ((v0 + li) * 64 + 4 * g) * 2;
    u32x4 rg[8]; u32x2 u0n[4];
#define GDE_LOAD(k) do { const unsigned so_ = (unsigned)(k) * GDR_BYTES; _Pragma("unroll") for (int j = 0; j < 6; ++j) rg[j] = bld16(recs, j * 8192 + tid * 16, so_); \
        rg[6] = bld16(recs, 65536 + tid * 16, so_); rg[7] = bld16(recs, 73728 + (tid < 33 ? tid : 0) * 16, so_); } while (0)
#define GDE_LOADU(k) do { const unsigned so_ = (unsigned)(k) * GDR_BYTES; _Pragma("unroll") for (int mt = 0; mt < 4; ++mt) u0n[mt] = bld8(recs, u0off + mt * 32, so_); } while (0)
#define GDE_STAGE(img) do { LAS unsigned char* im_ = (img); _Pragma("unroll") for (int j = 0; j < 2; ++j) { const int l = tid + 512 * j; \
        *(LAS u32x4*)(im_ + GDE_W + (l >> 4) * 272 + (l & 15) * 16) = rg[j]; *(LAS u32x4*)(im_ + GDE_Q + (l >> 4) * 272 + (l & 15) * 16) = rg[2 + j]; \
        *(LAS u32x4*)(im_ + GDE_KT + (l >> 3) * 144 + (l & 7) * 16) = rg[4 + j]; } \
        *(LAS u32x4*)(im_ + GDE_AQK + (tid >> 3) * 144 + (tid & 7) * 16) = rg[6]; if (tid < 33) *(LAS u32x4*)(im_ + GDE_SC + tid * 16) = rg[7]; } while (0)
    GDE_LOAD(0); GDE_LOADU(0);
    GDE_STAGE(lds);
    BAR_LDS();
    GDE_LOAD(n > 1 ? 1 : 0);
    for (int i = 0; i < n; ++i) {
        LAS unsigned char* im = lds + (i & 1) * GDE_IMG;
        LAS bf16_t* EW = (LAS bf16_t*)(im + GDE_W); LAS bf16_t* EQ = (LAS bf16_t*)(im + GDE_Q); LAS bf16_t* EKT = (LAS bf16_t*)(im + GDE_KT);
        LAS bf16_t* EAQK = (LAS bf16_t*)(im + GDE_AQK); LAS float* EGAM = (LAS float*)(im + GDE_SC); LAS float* EEE = EGAM + 64; LAS float* EGL = EGAM + 128;
        {
            const bool accum = (c0 + i) >= acc_from;
            unsigned short pv[4][4];
#pragma unroll
            for (int mt = 0; mt < 4; ++mt)
#pragma unroll
                for (int r = 0; r < 4; ++r) pv[mt][r] = O4[chain_row(rbase, T, dir, (c0 + i) * 64 + 16 * mt + 4 * g + r) * 1024 + v0 + li];
            const LAS bf16_t* pW = EW + li * 136 + 4 * g; const LAS bf16_t* pQ = EQ + li * 136 + 4 * g; const LAS bf16_t* pA = EAQK + li * 72 + 4 * g; const LAS bf16_t* pK = EKT + li * 72 + 4 * g;
#define LD4(F, P, MT) do { _Pragma("unroll") for (int ks = 0; ks < 4; ++ks) F[ks] = ldperm((P) + (MT) * 16 * 136 + 32 * ks); } while (0)
#define LD22(F, P, M2) do { F[0] = ldperm((P) + (2 * (M2)) * 16 * 72); F[1] = ldperm((P) + (2 * (M2)) * 16 * 72 + 32); F[2] = ldperm((P) + (2 * (M2) + 1) * 16 * 72); F[3] = ldperm((P) + (2 * (M2) + 1) * 16 * 72 + 32); } while (0)
#define CH4(ACC, F, B) do { _Pragma("unroll") for (int ks = 0; ks < 4; ++ks) ACC = mfma16(F[ks], B[ks], ACC); } while (0)
#define UFROM(MT) do { u[MT] = -u[MT]; } while (0)
#define UB(K2) do { ub[K2] = acc2b(u[2 * (K2)], u[2 * (K2) + 1]); ueb[K2] = acc2b(u[2 * (K2)] * *(const LAS f32x4*)(EEE + 32 * (K2) + 4 * g), u[2 * (K2) + 1] * *(const LAS f32x4*)(EEE + 32 * (K2) + 16 + 4 * g)); } while (0)
#define OST(MT) do { _Pragma("unroll") for (int r = 0; r < 4; ++r) { bf16_t* po = O4 + chain_row(rbase, T, dir, (c0 + i) * 64 + 16 * (MT) + 4 * g + r) * 1024 + v0 + li; const float prev = bf2f(pv[MT][r]); *po = (bf16_t)f2bf(accum ? o[MT][r] + prev : o[MT][r]); } } while (0)
            bf16x8 fa[4], fb[4], sb[4], ub[2], ueb[2];
            f32x4 u[4], o[4];
            LD4(fa, pW, 0);
#pragma unroll
            for (int ks = 0; ks < 4; ++ks) sb[ks] = acc2b(S[2 * ks], S[2 * ks + 1]);
#pragma unroll
            for (int mt = 0; mt < 4; ++mt) { const u32x2 uw = u0n[mt]; o[mt] = (f32x4){0.f, 0.f, 0.f, 0.f};
                u[mt] = -(f32x4){__uint_as_float(uw.x << 16), __uint_as_float(uw.x & 0xffff0000u), __uint_as_float(uw.y << 16), __uint_as_float(uw.y & 0xffff0000u)}; }
            GDE_LOADU(i + 1 < n ? i + 1 : n - 1);
            SCHED_BARRIER();
            LD4(fb, pW, 1); SCHED_BARRIER(); CH4(u[0], fa, sb); SCHED_BARRIER();
            LD4(fa, pW, 2); SCHED_BARRIER(); CH4(u[1], fb, sb); SCHED_BARRIER();
            LD4(fb, pW, 3); SCHED_BARRIER(); CH4(u[2], fa, sb); SCHED_BARRIER();
            LD4(fa, pQ, 0); SCHED_BARRIER(); CH4(u[3], fb, sb); UFROM(0); UFROM(1); SCHED_BARRIER();
            LD4(fb, pQ, 1); SCHED_BARRIER(); CH4(o[0], fa, sb); UFROM(2); UB(0); SCHED_BARRIER();
            LD4(fa, pQ, 2); SCHED_BARRIER(); CH4(o[1], fb, sb); UFROM(3); SCHED_BARRIER();
            LD4(fb, pQ, 3); SCHED_BARRIER(); CH4(o[2], fa, sb); UB(1); SCHED_BARRIER();
            LD22(fa, pA, 0); SCHED_BARRIER(); CH4(o[3], fb, sb); o[0] = o[0] * *(const LAS f32x4*)(EGAM + 4 * g); o[1] = o[1] * *(const LAS f32x4*)(EGAM + 16 + 4 * g); SCHED_BARRIER();
            LD22(fb, pA, 1); SCHED_BARRIER();
            o[0] = mfma16(fa[0], ub[0], o[0]); o[1] = mfma16(fa[2], ub[0], o[1]); o[0] = mfma16(fa[1], ub[1], o[0]); o[1] = mfma16(fa[3], ub[1], o[1]);
            o[2] = o[2] * *(const LAS f32x4*)(EGAM + 32 + 4 * g); o[3] = o[3] * *(const LAS f32x4*)(EGAM + 48 + 4 * g); SCHED_BARRIER();
            LD22(fa, pK, 0); SCHED_BARRIER();
            o[2] = mfma16(fb[0], ub[0], o[2]); o[3] = mfma16(fb[2], ub[0], o[3]); o[2] = mfma16(fb[1], ub[1], o[2]); o[3] = mfma16(fb[3], ub[1], o[3]);
            const float gl = EGL[0];
#pragma unroll
            for (int dt = 0; dt < 8; ++dt) S[dt] = S[dt] * gl;
            SCHED_BARRIER();
            LD22(fb, pK, 1); SCHED_BARRIER();
            S[0] = mfma16(fa[0], ueb[0], S[0]); S[1] = mfma16(fa[2], ueb[0], S[1]); S[0] = mfma16(fa[1], ueb[1], S[0]); S[1] = mfma16(fa[3], ueb[1], S[1]); OST(0); OST(1); SCHED_BARRIER();
            LD22(fa, pK, 2); SCHED_BARRIER();
            S[2] = mfma16(fb[0], ueb[0], S[2]); S[3] = mfma16(fb[2], ueb[0], S[3]); S[2] = mfma16(fb[1], ueb[1], S[2]); S[3] = mfma16(fb[3], ueb[1], S[3]); OST(2); OST(3); SCHED_BARRIER();
            LD22(fb, pK, 3); SCHED_BARRIER();
            S[4] = mfma16(fa[0], ueb[0], S[4]); S[5] = mfma16(fa[2], ueb[0], S[5]); S[4] = mfma16(fa[1], ueb[1], S[4]); S[5] = mfma16(fa[3], ueb[1], S[5]); SCHED_BARRIER();
            S[6] = mfma16(fb[0], ueb[0], S[6]); S[7] = mfma16(fb[2], ueb[0], S[7]); S[6] = mfma16(fb[1], ueb[1], S[6]); S[7] = mfma16(fb[3], ueb[1], S[7]);
#undef LD4
#undef LD22
#undef CH4
#undef UFROM
#undef UB
#undef OST
        }
        GDE_STAGE(lds + ((i + 1) & 1) * GDE_IMG);
        GDE_LOAD(i + 2 < n ? i + 2 : n - 1);
        BAR_LDS();
    }
#undef GDE_LOAD
#undef GDE_LOADU
#undef GDE_STAGE
}

template <class CFG>
DEV void gdn_stream(const Args& a, LAS unsigned char* lds, int tid_in, int wave, int n, const unsigned char* recs_in, const CFG& cfg, f32x4 (&S)[8]) {
    const BufRes recs = make_buf(recs_in);
    int tid = tid_in; OPAQUE(tid); const int lane = tid & 63;
    const int li = lane & 15, g = lane >> 4, v0 = 16 * wave;
    const int u0off = 49152 + ((v0 + li) * 64 + 4 * g) * 2;
    u32x4 rg[8]; u32x2 u0n[4]; f32x4 u[4];
#define GDE_UNEXT() do { _Pragma("unroll") for (int mt = 0; mt < 4; ++mt) { const u32x2 uw = u0n[mt]; u[mt] = -(f32x4){__uint_as_float(uw.x << 16), __uint_as_float(uw.x & 0xffff0000u), __uint_as_float(uw.y << 16), __uint_as_float(uw.y & 0xffff0000u)}; } } while (0)
#define GDE_LOAD(k) do { const unsigned so_ = cfg.rec_off(k); _Pragma("unroll") for (int j = 0; j < 6; ++j) rg[j] = bld16(recs, j * 8192 + tid * 16, so_); \
        rg[6] = bld16(recs, 65536 + tid * 16, so_); rg[7] = bld16(recs, 73728 + (tid < 33 ? tid : 0) * 16, so_); } while (0)
#define GDE_LOADU(k) do { const unsigned so_ = cfg.rec_off(k); _Pragma("unroll") for (int mt = 0; mt < 4; ++mt) u0n[mt] = bld8(recs, u0off + mt * 32, so_); } while (0)
#define GDE_STAGE(img) do { LAS unsigned char* im_ = (img); _Pragma("unroll") for (int j = 0; j < 2; ++j) { const int l = tid + 512 * j; \
        *(LAS u32x4*)(im_ + GDE_W + (l >> 4) * 272 + (l & 15) * 16) = rg[j]; *(LAS u32x4*)(im_ + GDE_Q + (l >> 4) * 272 + (l & 15) * 16) = rg[2 + j]; \
        *(LAS u32x4*)(im_ + GDE_KT + (l >> 3) * 144 + (l & 7) * 16) = rg[4 + j]; } \
        *(LAS u32x4*)(im_ + GDE_AQK + (tid >> 3) * 144 + (tid & 7) * 16) = rg[6]; if (tid < 33) *(LAS u32x4*)(im_ + GDE_SC + tid * 16) = rg[7]; } while (0)
    { const unsigned f0 = cfg.flag_issue(0, wave), f1 = cfg.flag_issue(n > 1 ? 1 : 0, wave); cfg.flag_wait(0, f0, wave); cfg.flag_wait(n > 1 ? 1 : 0, f1, wave); }
    __syncthreads();
    GDE_LOAD(0); GDE_LOADU(0);
    GDE_STAGE(lds);
    BAR_LDS();
    cfg.post(-1, S, tid);
    GDE_LOAD(n > 1 ? 1 : 0);
    GDE_UNEXT();
    for (int i = 0; i < n; ++i) {
        const int kf = i + 2 < n ? i + 2 : n - 1;
        const unsigned fl = cfg.flag_issue(kf, wave);
        int T, rbase, h, dir, cc; bool accum_; cfg.chunk(i, T, rbase, h, dir, cc, accum_);
        bf16_t* O4 = (bf16_t*)(a.ws + WS_XA) + 512 + h * 128;
        cfg.pre(i, S, tid, wave);
        LAS unsigned char* im = lds + (i & 1) * GDE_IMG;
        LAS bf16_t* EW = (LAS bf16_t*)(im + GDE_W); LAS bf16_t* EQ = (LAS bf16_t*)(im + GDE_Q); LAS bf16_t* EKT = (LAS bf16_t*)(im + GDE_KT);
        LAS bf16_t* EAQK = (LAS bf16_t*)(im + GDE_AQK); LAS float* EGAM = (LAS float*)(im + GDE_SC); LAS float* EEE = EGAM + 64; LAS float* EGL = EGAM + 128;
        {
            const bool accum = accum_;
            GDE_LOADU(i + 1 < n ? i + 1 : n - 1);
            unsigned short pv[4][4];
#pragma unroll
            for (int mt = 0; mt < 4; ++mt)
#pragma unroll
                for (int r = 0; r < 4; ++r) pv[mt][r] = O4[chain_row(rbase, T, dir, cc * 64 + 16 * mt + 4 * g + r) * 1024 + v0 + li];
            const LAS bf16_t* pW = EW + li * 136 + 4 * g; const LAS bf16_t* pQ = EQ + li * 136 + 4 * g; const LAS bf16_t* pA = EAQK + li * 72 + 4 * g; const LAS bf16_t* pK = EKT + li * 72 + 4 * g;
#define LD4(F, P, MT) do { _Pragma("unroll") for (int ks = 0; ks < 4; ++ks) F[ks] = ldperm((P) + (MT) * 16 * 136 + 32 * ks); } while (0)
#define LD22(F, P, M2) do { F[0] = ldperm((P) + (2 * (M2)) * 16 * 72); F[1] = ldperm((P) + (2 * (M2)) * 16 * 72 + 32); F[2] = ldperm((P) + (2 * (M2) + 1) * 16 * 72); F[3] = ldperm((P) + (2 * (M2) + 1) * 16 * 72 + 32); } while (0)
#define CH4(ACC, F, B) do { _Pragma("unroll") for (int ks = 0; ks < 4; ++ks) ACC = mfma16(F[ks], B[ks], ACC); } while (0)
#define UFROM(MT) do { u[MT] = -u[MT]; } while (0)
#define UB(K2) do { ub[K2] = acc2b(u[2 * (K2)], u[2 * (K2) + 1]); ueb[K2] = acc2b(u[2 * (K2)] * *(const LAS f32x4*)(EEE + 32 * (K2) + 4 * g), u[2 * (K2) + 1] * *(const LAS f32x4*)(EEE + 32 * (K2) + 16 + 4 * g)); } while (0)
#define OST(MT) do { _Pragma("unroll") for (int r = 0; r < 4; ++r) { bf16_t* po = O4 + chain_row(rbase, T, dir, cc * 64 + 16 * (MT) + 4 * g + r) * 1024 + v0 + li; const float prev = bf2f(pv[MT][r]); *po = (bf16_t)f2bf(accum ? o[MT][r] + prev : o[MT][r]); } } while (0)
            bf16x8 fa[4], fb[4], sb[4], ub[2], ueb[2];
            f32x4 o[4];
            LD4(fa, pW, 0);
#pragma unroll
            for (int ks = 0; ks < 4; ++ks) sb[ks] = acc2b(S[2 * ks], S[2 * ks + 1]);
#pragma unroll
            for (int mt = 0; mt < 4; ++mt) o[mt] = (f32x4){0.f, 0.f, 0.f, 0.f};
            SCHED_BARRIER();
            LD4(fb, pW, 1); SCHED_BARRIER(); CH4(u[0], fa, sb); SCHED_BARRIER();
            LD4(fa, pW, 2); SCHED_BARRIER(); CH4(u[1], fb, sb); SCHED_BARRIER();
            LD4(fb, pW, 3); SCHED_BARRIER(); CH4(u[2], fa, sb); SCHED_BARRIER();
            LD4(fa, pQ, 0); SCHED_BARRIER(); CH4(u[3], fb, sb); UFROM(0); UFROM(1); SCHED_BARRIER();
            LD4(fb, pQ, 1); SCHED_BARRIER(); CH4(o[0], fa, sb); UFROM(2); UB(0); SCHED_BARRIER();
            LD4(fa, pQ, 2); SCHED_BARRIER(); CH4(o[1], fb, sb); UFROM(3); SCHED_BARRIER();
            LD4(fb, pQ, 3); SCHED_BARRIER(); CH4(o[2], fa, sb); UB(1); GDE_UNEXT(); SCHED_BARRIER();
            LD22(fa, pA, 0); SCHED_BARRIER(); CH4(o[3], fb, sb); o[0] = o[0] * *(const LAS f32x4*)(EGAM + 4 * g); o[1] = o[1] * *(const LAS f32x4*)(EGAM + 16 + 4 * g); SCHED_BARRIER();
            LD22(fb, pA, 1); SCHED_BARRIER();
            o[0] = mfma16(fa[0], ub[0], o[0]); o[1] = mfma16(fa[2], ub[0], o[1]); o[0] = mfma16(fa[1], ub[1], o[0]); o[1] = mfma16(fa[3], ub[1], o[1]);
            o[2] = o[2] * *(const LAS f32x4*)(EGAM + 32 + 4 * g); o[3] = o[3] * *(const LAS f32x4*)(EGAM + 48 + 4 * g); SCHED_BARRIER();
            LD22(fa, pK, 0); SCHED_BARRIER();
            o[2] = mfma16(fb[0], ub[0], o[2]); o[3] = mfma16(fb[2], ub[0], o[3]); o[2] = mfma16(fb[1], ub[1], o[2]); o[3] = mfma16(fb[3], ub[1], o[3]);
            const float gl = EGL[0];
#pragma unroll
            for (int dt = 0; dt < 8; ++dt) S[dt] = S[dt] * gl;
            SCHED_BARRIER();
            LD22(fb, pK, 1); SCHED_BARRIER();
            S[0] = mfma16(fa[0], ueb[0], S[0]); S[1] = mfma16(fa[2], ueb[0], S[1]); S[0] = mfma16(fa[1], ueb[1], S[0]); S[1] = mfma16(fa[3], ueb[1], S[1]); OST(0); OST(1); SCHED_BARRIER();
            LD22(fa, pK, 2); SCHED_BARRIER();
            S[2] = mfma16(fb[0], ueb[0], S[2]); S[3] = mfma16(fb[2], ueb[0], S[3]); S[2] = mfma16(fb[1], ueb[1], S[2]); S[3] = mfma16(fb[3], ueb[1], S[3]); OST(2); OST(3); SCHED_BARRIER();
            LD22(fb, pK, 3); SCHED_BARRIER();
            S[4] = mfma16(fa[0], ueb[0], S[4]); S[5] = mfma16(fa[2], ueb[0], S[5]); S[4] = mfma16(fa[1], ueb[1], S[4]); S[5] = mfma16(fa[3], ueb[1], S[5]); SCHED_BARRIER();
            S[6] = mfma16(fb[0], ueb[0], S[6]); S[7] = mfma16(fb[2], ueb[0], S[7]); S[6] = mfma16(fb[1], ueb[1], S[6]); S[7] = mfma16(fb[3], ueb[1], S[7]);
#undef LD4
#undef LD22
#undef CH4
#undef UFROM
#undef UB
#undef OST
        }
        GDE_STAGE(lds + ((i + 1) & 1) * GDE_IMG);
        cfg.flag_wait(kf, fl, wave);
        BAR_LDS();
        cfg.post(i, S, tid);
        GDE_LOAD(kf);
    }
#undef GDE_LOAD
#undef GDE_LOADU
#undef GDE_UNEXT
#undef GDE_STAGE
}

#define XB_TMO      128
#define XB_XCNT(j)  (256  + 64 * (j))
#define XB_XSUB(j)  (1280 + 64 * (j))
#define XB_XGEN(j)  (2304 + 64 * (j))
#define XB_TOP      3328
#define XB_TOPGEN   3392
#define XCD_BAR_WORDS 3456
#define XB_SPIN_CAP (1u << 18)

__device__ __forceinline__ unsigned xb_ld(unsigned* p)              { return __hip_atomic_load(p, __ATOMIC_RELAXED, __HIP_MEMORY_SCOPE_AGENT); }
__device__ __forceinline__ unsigned xb_add(unsigned* p, unsigned v) { return __hip_atomic_fetch_add(p, v, __ATOMIC_RELAXED, __HIP_MEMORY_SCOPE_AGENT); }
__device__ __forceinline__ unsigned xb_xcc_id() { return (unsigned)__builtin_amdgcn_s_getreg((3 << 11) | 20) & 0xFu; }
#define XB_SPIN(cond, bar) do { unsigned _sp = 0; while (cond) { __builtin_amdgcn_s_sleep(1); \
    if ((++_sp & 255u) == 0u) { if (xb_ld(&(bar)[XB_TMO])) break; if (_sp > XB_SPIN_CAP) { atomicAdd(&(bar)[XB_TMO], 1u); break; } } } } while (0)

struct XcdBarrier {
    unsigned* bar; unsigned x;
    volatile LAS unsigned* st;
};

__device__ __forceinline__ XcdBarrier xcd_barrier_post(unsigned* bar, volatile LAS unsigned* st) {
    XcdBarrier b; b.bar = bar; b.x = xb_xcc_id(); b.st = st;
    if (threadIdx.x == 0) (void)xb_add(&bar[XB_XCNT(b.x)], 1u);
    return b;
}
__device__ __forceinline__ void xcd_barrier_complete(unsigned* bar, unsigned x, unsigned& nloc, unsigned& nx) {
    const unsigned G = gridDim.x * gridDim.y * gridDim.z;
    unsigned sum, cnt, mine, sp = 0u;
    for (;;) {
        sum = 0u; cnt = 0u; mine = 0u;
#pragma unroll
        for (unsigned j = 0; j < 16; ++j) { const unsigned c = xb_ld(&bar[XB_XCNT(j)]); sum += c; cnt += (c > 0u) ? 1u : 0u; mine = (j == x) ? c : mine; }
        if (sum == G) break;
        __builtin_amdgcn_s_sleep(1);
        if ((++sp & 255u) == 0u) { if (xb_ld(&bar[XB_TMO])) break; if (sp > XB_SPIN_CAP) { atomicAdd(&bar[XB_TMO], 1u); break; } }
    }
    nloc = mine > 0u ? mine : 1u; nx = cnt > 0u ? cnt : 1u;
}

__device__ __forceinline__ void xcd_barrier(const XcdBarrier& b) {
    asm volatile("s_waitcnt vmcnt(0)" ::: "memory");
    __syncthreads();
    if (threadIdx.x == 0) {
        unsigned* bar = b.bar;
        __builtin_amdgcn_s_waitcnt(0);
        unsigned nloc = b.st[0], nx = b.st[1];
        if (nloc == 0u) { xcd_barrier_complete(bar, b.x, nloc, nx); b.st[0] = nloc; b.st[1] = nx; }
        const unsigned old = xb_add(&bar[XB_XSUB(b.x)], 1u);
        const unsigned gen = old / nloc;
        if (old + 1u == (gen + 1u) * nloc) {
            __builtin_amdgcn_fence(__ATOMIC_RELEASE, "agent");
            asm volatile("s_waitcnt vmcnt(0)" ::: "memory");
            const unsigned og = xb_add(&bar[XB_TOP], 1u);
            const unsigned tg = og / nx;
            if (og + 1u == (tg + 1u) * nx) xb_add(&bar[XB_TOPGEN], 1u);
            else XB_SPIN(xb_ld(&bar[XB_TOPGEN]) == tg, bar);
            __builtin_amdgcn_fence(__ATOMIC_ACQUIRE, "agent");
            xb_add(&bar[XB_XGEN(b.x)], 1u);
            asm volatile("s_waitcnt vmcnt(0)" ::: "memory");
        } else {
            XB_SPIN(xb_ld(&bar[XB_XGEN(b.x)]) == gen, bar);
            __builtin_amdgcn_fence(__ATOMIC_ACQUIRE, "agent");
            asm volatile("s_waitcnt vmcnt(0)" ::: "memory");
        }
    }
    __syncthreads();
}

DEV bool df_giveup(unsigned& sp, GAS unsigned* tmo) {
    __builtin_amdgcn_s_sleep(1);
    if ((++sp & 255u) != 0u) return false;
    if (__builtin_amdgcn_readfirstlane((int)__hip_atomic_load(tmo, __ATOMIC_RELAXED, __HIP_MEMORY_SCOPE_AGENT))) return true;
    if (sp > (1u << 20)) { __hip_atomic_store(tmo, 1u, __ATOMIC_RELAXED, __HIP_MEMORY_SCOPE_AGENT); return true; }
    return false;
}
DEV void df_wait_ge(GAS unsigned* w, unsigned want, GAS unsigned* tmo) {
    unsigned sp = 0;
    while ((unsigned)__builtin_amdgcn_readfirstlane((int)__hip_atomic_load(w, __ATOMIC_RELAXED, __HIP_MEMORY_SCOPE_AGENT)) < want) { if (df_giveup(sp, tmo)) break; }
}
DEV void df_wait4_ge(GAS unsigned* w0, int lane, unsigned want, GAS unsigned* tmo) {
    unsigned sp = 0;
    while (!__all((int)(__hip_atomic_load(w0 + (lane & 3) * 16, __ATOMIC_RELAXED, __HIP_MEMORY_SCOPE_AGENT) >= want))) { if (df_giveup(sp, tmo)) break; }
}
struct DfWords { GAS unsigned* c2;
    DEV GAS unsigned* rdy(int buf, int slot) const { return c2 + (buf * 320 + slot) * 16; }
    DEV GAS unsigned* prog(int cons) const { return c2 + 10240 + cons * 16; }
    DEV GAS unsigned* half(int chain) const { return c2 + 11520 + chain * 16; }
    DEV GAS unsigned* queue() const { return c2 + 12544; }
    DEV GAS unsigned* tmo() const { return c2 + 12560; }
    DEV unsigned issue(GAS unsigned* f, int wave) const { return wave == 0 ? __hip_atomic_load(f, __ATOMIC_RELAXED, __HIP_MEMORY_SCOPE_AGENT) : 0u; }
    DEV void wait(GAS unsigned* f, unsigned want, unsigned v, int wave) const { if (wave == 0) { unsigned sp = 0;
        while ((unsigned)__builtin_amdgcn_readfirstlane((int)v) < want) { if (df_giveup(sp, tmo())) break; v = __hip_atomic_load(f, __ATOMIC_RELAXED, __HIP_MEMORY_SCOPE_AGENT); } } }
};
struct GdnLatCfg { DfWords w; int bid, b, h, dir;
    DEV unsigned rec_off(int k) const { return (unsigned)((k >> 2) & 1) * (20u << 20) + (unsigned)(bid * 4 + (k & 3)) * GDR_BYTES; }
    DEV unsigned flag_issue(int k, int wave) const { return w.issue(w.rdy((k >> 2) & 1, bid * 4 + (k & 3)), wave); }
    DEV void flag_wait(int k, unsigned v, int wave) const { w.wait(w.rdy((k >> 2) & 1, bid * 4 + (k & 3)), (unsigned)(k >> 2) + 1u, v, wave); }
    DEV void chunk(int k, int& T, int& rb, int& h_, int& d_, int& c_, bool& acc) const { T = TLAT; rb = MCTX + b * TLAT; h_ = h; d_ = dir; c_ = k; acc = k >= 32; }
    DEV void pre(int k, f32x4 (&)[8], int, int wave) const {
        if (k == 32) { if (wave == 0) { df_wait_ge(w.half(bid ^ 1), 1u, w.tmo()); __builtin_amdgcn_fence(__ATOMIC_ACQUIRE, "agent"); asm volatile("s_waitcnt vmcnt(0)" ::: "memory"); } __syncthreads(); } }
    DEV void post(int k, f32x4 (&)[8], int tid) const {
        if (tid == 0) __hip_atomic_store(w.prog(bid), (unsigned)(k + 2), __ATOMIC_RELAXED, __HIP_MEMORY_SCOPE_AGENT);
        if (k == 31) { asm volatile("s_waitcnt vmcnt(0)" ::: "memory"); __syncthreads();
            if (tid == 0) { __builtin_amdgcn_fence(__ATOMIC_RELEASE, "agent"); asm volatile("s_waitcnt vmcnt(0)" ::: "memory"); __hip_atomic_store(w.half(bid), 1u, __ATOMIC_RELAXED, __HIP_MEMORY_SCOPE_AGENT); } } }
};
struct GlaLatCfg { DfWords w; int bid, cb, b, h, dir;
    DEV unsigned rec_off(int k) const { return (unsigned)((k >> 2) & 1) * (20u << 20) + 160u * GDR_BYTES + (unsigned)(cb * 4 + (k & 3)) * GLR_BYTES; }
    DEV unsigned flag_issue(int k, int wave) const { return w.issue(w.rdy((k >> 2) & 1, 160 + cb * 4 + (k & 3)), wave); }
    DEV void flag_wait(int k, unsigned v, int wave) const { w.wait(w.rdy((k >> 2) & 1, 160 + cb * 4 + (k & 3)), (unsigned)(k >> 2) + 1u, v, wave); }
    DEV void chunk(int k, int& T, int& rb, int& h_, int& d_, int& c_, bool& acc) const { T = TLAT; rb = MCTX + b * TLAT; h_ = h; d_ = dir; c_ = k; acc = k >= 32; }
    DEV void pre(int k, f32x4 (&)[8], int, int wave) const {
        if (k == 32) { if (wave == 0) { df_wait_ge(w.half(bid ^ 1), 1u, w.tmo()); __builtin_amdgcn_fence(__ATOMIC_ACQUIRE, "agent"); asm volatile("s_waitcnt vmcnt(0)" ::: "memory"); } __syncthreads(); } }
    DEV void post(int k, f32x4 (&)[8], int tid) const {
        if (tid == 0) __hip_atomic_store(w.prog(bid), (unsigned)(k + 2), __ATOMIC_RELAXED, __HIP_MEMORY_SCOPE_AGENT);
        if (k == 31) { asm volatile("s_waitcnt vmcnt(0)" ::: "memory"); __syncthreads();
            if (tid == 0) { __builtin_amdgcn_fence(__ATOMIC_RELEASE, "agent"); asm volatile("s_waitcnt vmcnt(0)" ::: "memory"); __hip_atomic_store(w.half(bid), 1u, __ATOMIC_RELAXED, __HIP_MEMORY_SCOPE_AGENT); } } }
};
struct GlaPairCfg { DfWords w; int pr, b, h;
    DEV unsigned rec_off(int k) const { const int kk = k >> 1, cb = 2 * pr + (k & 1); return (unsigned)((kk >> 2) & 1) * (20u << 20) + 160u * GDR_BYTES + (unsigned)(cb * 4 + (kk & 3)) * GLR_BYTES; }
    DEV GAS unsigned* flag(int k) const { const int kk = k >> 1, cb = 2 * pr + (k & 1); return w.rdy((kk >> 2) & 1, 160 + cb * 4 + (kk & 3)); }
    DEV unsigned flag_issue(int k, int wave) const { return w.issue(flag(k), wave); }
    DEV void flag_wait(int k, unsigned v, int wave) const { w.wait(flag(k), (unsigned)(k >> 3) + 1u, v, wave); }
    DEV void chunk(int k, int& T, int& rb, int& h_, int& d_, int& c_, bool& acc) const { T = TLAT; rb = MCTX + b * TLAT; h_ = h; d_ = k & 1; c_ = k >> 1; acc = (k >> 1) >= 32; }
    DEV void pre(int k, f32x4 (&S)[8], int, int wave) const {
        if (k > 0) {
#pragma unroll
            for (int dt = 0; dt < 4; ++dt) { const f32x4 t = S[dt]; S[dt] = S[4 + dt]; S[4 + dt] = t; } }
        if (k == 64) {
            asm volatile("s_waitcnt vmcnt(0)" ::: "memory"); __syncthreads();
            if (wave == 0) { __builtin_amdgcn_fence(__ATOMIC_ACQUIRE, "agent"); asm volatile("s_waitcnt vmcnt(0)" ::: "memory"); }
            __syncthreads(); } }
    DEV void post(int k, f32x4 (&)[8], int tid) const {
        if (tid == 0) { const int k1 = k + 1;
            __hip_atomic_store(w.prog(32 + 2 * pr + (k1 & 1)), (unsigned)((k1 >> 1) + 1), __ATOMIC_RELAXED, __HIP_MEMORY_SCOPE_AGENT);
            if (k >= 0) __hip_atomic_store(w.prog(32 + 2 * pr + (k & 1)), (unsigned)((k >> 1) + 1), __ATOMIC_RELAXED, __HIP_MEMORY_SCOPE_AGENT); } }
};
struct GdnCtxCfg { DfWords w; int bid, j; float* out;
    DEV unsigned rec_off(int k) const { return (unsigned)((k >> 2) & 1) * (20u << 20) + (unsigned)(128 + j * 4 + (k & 3)) * GDR_BYTES; }
    DEV unsigned flag_issue(int k, int wave) const { return w.issue(w.rdy((k >> 2) & 1, 128 + j * 4 + (k & 3)), wave); }
    DEV void flag_wait(int k, unsigned v, int wave) const { w.wait(w.rdy((k >> 2) & 1, 128 + j * 4 + (k & 3)), (unsigned)(k >> 2) + 1u, v, wave); }
    DEV void chunk(int k, int& T, int& rb, int& h_, int& d_, int& c_, bool& acc) const { const int s = k >> 2, p = 8 * (s & 7) + j; T = TCTX; rb = (p >> 2) * TCTX; h_ = p & 3; d_ = s >> 3; c_ = k & 3; acc = (s >> 3) != 0; }
    DEV void pre(int k, f32x4 (&S)[8], int, int) const { if ((k & 3) == 0) {
#pragma unroll
        for (int dt = 0; dt < 8; ++dt) S[dt] = (f32x4){0.f, 0.f, 0.f, 0.f}; } }
    DEV void post(int k, f32x4 (&S)[8], int tid) const {
        if (tid == 0) __hip_atomic_store(w.prog(bid), (unsigned)(k + 2), __ATOMIC_RELAXED, __HIP_MEMORY_SCOPE_AGENT);
        if (k >= 0 && (k & 3) == 3) { const int s = k >> 2, p = 8 * (s & 7) + j, lane = tid & 63, li = lane & 15, g = lane >> 4, v0 = 16 * (tid >> 6);
            float* so = out + ((s >> 3) ? O_GDB : O_GDF) + (size_t)p * 16384;
#pragma unroll
            for (int dt = 0; dt < 8; ++dt)
#pragma unroll
                for (int r = 0; r < 4; ++r) so[(size_t)(16 * dt + 4 * g + r) * 128 + v0 + li] = S[dt][r]; } }
};
DEV int olane(int t) { OPAQUE(t); return t & 63; }
__global__ void __launch_bounds__(512, 2) fwd_megakernel(Args a) {
    extern __shared__ __attribute__((aligned(16))) unsigned char lds_raw[];
    cg::grid_group grid = cg::this_grid();
    LAS unsigned char* lds = (LAS unsigned char*)lds_raw;
    const int tid = threadIdx.x, lane = tid & 63, wave = __builtin_amdgcn_readfirstlane(tid >> 6);
    const int G = gridDim.x, bid = blockIdx.x;
    const int gw = bid * 8 + wave, NGW = G * 8;
    unsigned char* ws = a.ws;
    const int lo = a.ph_lo, hi = a.ph_hi; const bool IN4_ = lo <= 4 && 4 < hi, IN9_ = lo <= 9 && 9 < hi;
    volatile LAS unsigned* bar_st = (volatile LAS unsigned*)(lds + 131072);
    if (tid < 2) bar_st[tid] = 0u;
    __syncthreads();
    unsigned* const ctlw = (unsigned*)ws + (a.pad ? 16384 : 0);
    XcdBarrier bar; bar.bar = ctlw; bar.x = 0; bar.st = bar_st;
    if (hi - lo > 1 || IN4_ || IN9_) bar = xcd_barrier_post(ctlw, bar_st);
#define IN(k) (lo <= (k) && (k) < hi)
#define SEAM(k) do { if (IN(k) && IN((k) + 1)) xcd_barrier(bar); } while (0)
    if (a.ph_hi < 0) grid.sync();

    if (IN(0)) { p0_prologue(a, lds, tid, olane(tid), wave); } SEAM(0);
    if (IN(1)) { rows_h0(a, olane(tid), gw, NGW); } SEAM(1);
    if (IN(2)) {
        pg8::Gemm g{(const bf16_t*)(ws + WS_XA), (const bf16_t*)(ws + WS_W0IN), MROWS, L0_INP, 1024, 1024}; pg8::StaticOrder S; S.init(MROWS, L0_INP, G, bid);
        EpiStoreBf16 E{(bf16_t*)(ws + WS_PROJ), L0_LD};
        pg8::gemm_phase<EpiStoreBf16, pg8::StaticOrder, true, true>(lds, g, S, E);
    } SEAM(2);
    if (IN(4)) {
        unsigned char* rbuf[2] = {ws + WS_XA, (unsigned char*)a.out + 20 * MiB};
        unsigned* qctr = ctlw + 8192;
        GAS unsigned* c4 = (GAS unsigned*)(ctlw + 12288);
#define RW_PD(s_) (c4 + 64 * (s_))
#define RW_ED(s_) (c4 + 1024 + 64 * (s_))
#define RW_ROWS (c4 + 2048)
#define RW_TMO (c4 + 2112)
        GAS unsigned* c4f = (GAS unsigned*)((unsigned*)ws + 32768 + 12800 + (a.pad ? 16384 : 0));
#define RW_RDY(buf_, slot_) (c4f + (buf_) * 640 + (slot_))
        LAS unsigned* qslot = (LAS unsigned*)(lds + 131072 + 64);
        f32x4 S[4];
        { const int b = (bid & 63) >> 4, h = (bid >> 1) & 7, dir = bid & 1, li = lane & 15, g = lane >> 4, v0 = 16 * (wave & 3);
            const float* s0 = a.in[dir ? I_RWB : I_RWF] + (size_t)(b * 8 + h) * 4096;
#pragma unroll
            for (int dt = 0; dt < 4; ++dt) S[dt] = *(const f32x4*)(s0 + (size_t)(v0 + li) * 64 + 16 * dt + 4 * g); }
        int pkind = 0, pst = 0, pslot = 0;
        for (int s = 0; s <= 8; ++s) {
            int lv = lane; OPAQUE(lv);
            if (s >= 1 && bid < 96) {
                asm volatile("s_waitcnt vmcnt(0)" ::: "memory"); __syncthreads();
                if (tid == 0) { if (pkind == 1) __hip_atomic_store(RW_RDY(pst & 1, pslot), (unsigned)pst + 1u, __ATOMIC_RELAXED, __HIP_MEMORY_SCOPE_AGENT); else if (pkind == 2) __hip_atomic_fetch_add(RW_ROWS, 1u, __ATOMIC_RELAXED, __HIP_MEMORY_SCOPE_AGENT); }
                pkind = 0;
                if (wave == 0) {
                    GAS unsigned* f0 = RW_RDY((s - 1) & 1, bid < 64 ? bid * 8 : 512 + (bid - 64) * 4); const int nf = bid < 64 ? 7 : 3; unsigned sp = 0;
                    while (!__all((int)(__hip_atomic_load(f0 + (lv & nf), __ATOMIC_RELAXED, __HIP_MEMORY_SCOPE_AGENT) >= (unsigned)s))) { if (df_giveup(sp, RW_TMO)) break; } }
                __syncthreads();
                if (!(a.flags & 16384)) {
                const unsigned char* rb = rbuf[(s - 1) & 1];
                if (bid < 64) { const int b = bid >> 4, h = (bid >> 1) & 7, dir = bid & 1;
                    rwkv_esteps(a, lds, tid, lv, wave, TLAT, MCTX + b * TLAT, h, dir, 8 * (s - 1), 8, rb + (size_t)(bid * 8) * RWR_BYTES, S); }
                else { const int cc = 32 * (s - 1) + (bid - 64), b = cc >> 4, h = (cc >> 1) & 7, dir = cc & 1, li = lv & 15, g = lv >> 4, v0 = 16 * (wave & 3);
                    f32x4 Sc[4];
#pragma unroll
                    for (int dt = 0; dt < 4; ++dt) Sc[dt] = (f32x4){0.f, 0.f, 0.f, 0.f};
                    rwkv_esteps(a, lds, tid, lv, wave, TCTX, b * TCTX, h, dir, 0, 4, rb + (size_t)(512 + (bid - 64) * 4) * RWR_BYTES, Sc);
                    if (wave < 4) { float* so = a.out + (dir ? O_RWB : O_RWF) + (size_t)(b * 8 + h) * 4096 + (size_t)(v0 + li) * 64 + 4 * g;
#pragma unroll
                        for (int dt = 0; dt < 4; ++dt) *(f32x4*)(so + 16 * dt) = Sc[dt]; } }
                }
                if (tid == 0) __hip_atomic_fetch_add(RW_ED(s), 1u, __ATOMIC_RELAXED, __HIP_MEMORY_SCOPE_AGENT);
            }
            if (s < 8) {
                unsigned char* wb = rbuf[s & 1];
                bool first = true;
                for (;;) {
                    unsigned t0 = 0u;
                    if (wave == 0) { if (lane == 0) t0 = __hip_atomic_fetch_add((GAS unsigned*)(qctr + 64 * s), 1u, __ATOMIC_RELAXED, __HIP_MEMORY_SCOPE_AGENT); }
                    asm volatile("s_waitcnt vmcnt(0)" ::: "memory");
                    __syncthreads();
                    if (tid == 0) { if (pkind == 1) __hip_atomic_store(RW_RDY(pst & 1, pslot), (unsigned)pst + 1u, __ATOMIC_RELAXED, __HIP_MEMORY_SCOPE_AGENT); else if (pkind == 2) __hip_atomic_fetch_add(RW_ROWS, 1u, __ATOMIC_RELAXED, __HIP_MEMORY_SCOPE_AGENT); }
                    pkind = 0;
                    if (wave == 0) {
                        if (first && s >= 2) df_wait_ge(RW_ED(s - 1), 96u, RW_TMO);
                        if (lane == 0) qslot[0] = (unsigned)__builtin_amdgcn_readfirstlane((int)t0);
                    }
                    first = false;
                    __syncthreads();
                    const int item = (int)__builtin_amdgcn_readfirstlane((int)qslot[0]);
                    if (item >= 704) break;
                    if (item >= 640) { const int q = 64 * s + (item - 640); rows_attn_prep(a, lv, wave, 8, 40 * q, 40 * q + 40, 4 * q, 4 * q + 4); pkind = 2; continue; }
                    if (item < 512) { const int ch = item >> 3, b = ch >> 4, h = (ch >> 1) & 7, dir = ch & 1;
                        rwkv_prep_item(a, lds, tid, lv, wave, TLAT, MCTX + b * TLAT, h, dir, 8 * s + (item & 7), wb + (size_t)item * RWR_BYTES); }
                    else { const int it = item - 512, cc = 32 * s + (it >> 2), b = cc >> 4, h = (cc >> 1) & 7, dir = cc & 1;
                        rwkv_prep_item(a, lds, tid, lv, wave, TCTX, b * TCTX, h, dir, it & 3, wb + (size_t)item * RWR_BYTES); }
                    pkind = 1; pst = s; pslot = item;
                }
            }
        }
        if (wave == 0) { df_wait_ge(RW_ROWS, 512u, RW_TMO); __builtin_amdgcn_fence(__ATOMIC_ACQUIRE, "agent"); asm volatile("s_waitcnt vmcnt(0)" ::: "memory"); }
        __syncthreads();
        if (!(a.flags & 8192)) for (int uu = bid; uu < 512 + G; uu += G) {
            int u = uu;
            if (uu >= 512) { u = 512 + (uu - 512 + G - 96) % G; if (u >= 640) continue; }
            else u = (uu & ~255) | ((uu & 7) << 5) | ((uu & 255) >> 3);
            const attn_body::bf16* Qb = (const attn_body::bf16*)a.out;
            if (u < 512) { const int b = u >> 7, h = (u >> 4) & 7, qb = u & 15;
                attn_body::attn_unit<8>((long)MCTX + (long)b * TLAT, (long)b * TKL, h, qb, TKL, Qb, (const attn_body::bf16*)(ws + WS_KL), (const attn_body::bf16*)(ws + WS_VL), (attn_body::bf16*)a.out, (char*)lds_raw); }
            else { const int uc = u - 512, b = uc >> 3, h = uc & 7;
                attn_body::attn_unit<8>((long)b * TCTX, (long)b * TCTX, h, 0, TCTX, Qb, (const attn_body::bf16*)(ws + WS_KC), (const attn_body::bf16*)(ws + WS_VC), (attn_body::bf16*)a.out, (char*)lds_raw); }
        }
#undef RW_PD
#undef RW_ED
#undef RW_ROWS
#undef RW_TMO
#undef RW_RDY
    } SEAM(4);
    if (IN(5)) { rows_fin0(a, olane(tid), gw, NGW); } SEAM(5);
    if (IN(6) && IN(7)) {
        GAS unsigned* c2w = (GAS unsigned*)((unsigned*)ws + 32768 + (a.pad ? 16384 : 0));
        GAS unsigned* cnt = c2w + 14336; GAS unsigned* rq = c2w + 15680; GAS unsigned* rtmo = c2w + 15696;
        {   pg8::Gemm g{(const bf16_t*)(ws + WS_XA), (const bf16_t*)(ws + WS_W0OUT), MROWS, 1024, 1024, 1024}; pg8::MMajorOrder S; S.init(MROWS, G, bid);
            EpiStoreBf16Sig E{(bf16_t*)(ws + WS_XB), 1024, cnt};
            pg8::gemm_phase<EpiStoreBf16Sig, pg8::MMajorOrder, true, true>(lds, g, S, E); }
        __syncthreads();
        LAS unsigned char* late = lds; LAS unsigned char* order = lds + 128; LAS unsigned* qs = (LAS unsigned*)(lds + 256);
        constexpr int NMB = MROWS / 256;
        if (tid < NMB) order[tid] = (unsigned char)tid;
        __syncthreads();
        const BufRes ores = make_buf(ws + WS_XB);
        int lane2 = tid; OPAQUE(lane2); lane2 &= 63;
        const RowPar gpost = rowpar_load(a.in[I0_GPOST], lane2), gpre = rowpar_load(a.in[I1_GPRE], lane2); MidPar m; m.gate = gpost; m.shift = gpost; m.scale = gpost; int cur = -1;
        for (;;) {
            if (wave == 0) { unsigned q = 0u; if (lane2 == 0) q = __hip_atomic_fetch_add(rq, 1u, __ATOMIC_RELAXED, __HIP_MEMORY_SCOPE_AGENT); q = (unsigned)__builtin_amdgcn_readfirstlane((int)q);
                if (q < (unsigned)(NMB * 16)) df_wait_ge(cnt + (int)order[q >> 4] * 16, 32u, rtmo);
                if (lane2 == 0) qs[0] = q; }
            __syncthreads();
            const unsigned q = (unsigned)__builtin_amdgcn_readfirstlane((int)qs[0]);
            __syncthreads();
            if (q >= (unsigned)(NMB * 16)) break;
            const int pm = (int)order[q >> 4], row = pm * 256 + (int)(q & 15u) * 16 + wave * 2, row2 = row + 1;
            const f32x4* xr = (const f32x4*)xrow_ptr(a, row) + lane2; const f32x4* xr2 = (const f32x4*)xrow_ptr(a, row2) + lane2;
            u32x2 o0[4], o1[4]; f32x4 x0[4], x1[4];
#pragma unroll
            for (int j = 0; j < 4; ++j) { o0[j] = bld8nt(ores, (unsigned)(row * 1024 + (64 * j + lane2) * 4) * 2u, 0); o1[j] = bld8nt(ores, (unsigned)(row2 * 1024 + (64 * j + lane2) * 4) * 2u, 0); x0[j] = __builtin_nontemporal_load(&xr[64 * j]); x1[j] = __builtin_nontemporal_load(&xr2[64 * j]); }
            if (row_cv(row) != cur) { cur = row_cv(row); m = midpar_load(a, cur, lane2); }
            mid_compute(a, o0, x0, row, lane2, gpost, gpre, m);
            mid_compute(a, o1, x1, row2, lane2, gpost, gpre, m);
        }
    } else {
    if (IN(6)) {
        pg8::Gemm g{(const bf16_t*)(ws + WS_XA), (const bf16_t*)(ws + WS_W0OUT), MROWS, 1024, 1024, 1024}; pg8::StaticOrder S; S.init(MROWS, 1024, G, bid);
        EpiStoreBf16 E{(bf16_t*)(ws + WS_XB), 1024};
        pg8::gemm_phase<EpiStoreBf16, pg8::StaticOrder, true, true>(lds, g, S, E);
    } SEAM(6);
    if (IN(7)) { rows_mid(a, olane(tid), gw, NGW); }
    } SEAM(7);
    if (IN(8)) {
        pg8::Gemm g{(const bf16_t*)(ws + WS_XB), (const bf16_t*)(ws + WS_W1IN), MROWS, L1_INP, 1024, 1024}; pg8::StaticOrder S; S.init(MROWS, L1_INP, G, bid);
        EpiStoreBf16 E{(bf16_t*)(ws + WS_PROJ), L1_LD};
        pg8::gemm_phase<EpiStoreBf16, pg8::StaticOrder, true, true>(lds, g, S, E);
    } SEAM(8);
    if (IN(9)) {
        unsigned char* rbuf[2] = {ws + WS_XB, ws + WS_XB + 20 * MiB};
        constexpr size_t GLA_OFF = (size_t)160 * GDR_BYTES;
        GAS unsigned* c2 = (GAS unsigned*)((unsigned*)ws + 32768 + (a.pad ? 16384 : 0));
#define DF_RDY(buf_, slot_) (c2 + ((buf_) * 320 + (slot_)) * 16)
#define DF_P(cons_) (c2 + 10240 + (cons_) * 16)
#define DF_D(chain_) (c2 + 11520 + (chain_) * 16)
#define DF_Q (c2 + 12544)
#define DF_TMO (c2 + 12560)
        LAS unsigned* qslot = (LAS unsigned*)(lds + 131072 + 64);
        constexpr int NCW_GDN = 32, NCW_GLA = 22;
#define DF_WAIT_GROUP(slot0_) do { if (wave == 0) df_wait4_ge(DF_RDY(sg & 1, (slot0_)), lv, (unsigned)sg + 1u, DF_TMO); __syncthreads(); } while (0)
#define DF_DONE_GROUP() do { if (tid == 0) __hip_atomic_store(DF_P(bid), 4u * (unsigned)(sg + 1), __ATOMIC_RELAXED, __HIP_MEMORY_SCOPE_AGENT); } while (0)
#define DF_HALF_WAIT() do { if (sg == 8) { if (wave == 0) { df_wait_ge(DF_D(bid ^ 1), 1u, DF_TMO); __builtin_amdgcn_fence(__ATOMIC_ACQUIRE, "agent"); asm volatile("s_waitcnt vmcnt(0)" ::: "memory"); } __syncthreads(); } } while (0)
#define DF_HALF_MARK() do { if (sg == 7) { asm volatile("s_waitcnt vmcnt(0)" ::: "memory"); __syncthreads(); \
            if (tid == 0) { __builtin_amdgcn_fence(__ATOMIC_RELEASE, "agent"); asm volatile("s_waitcnt vmcnt(0)" ::: "memory"); __hip_atomic_store(DF_D(bid), 1u, __ATOMIC_RELAXED, __HIP_MEMORY_SCOPE_AGENT); } } } while (0)
        if (bid < 32) {
            f32x4 S[8];
            const int b = bid >> 3, h = (bid >> 1) & 3, dir = bid & 1;
            {   const int li = lane & 15, g = lane >> 4, v0 = 16 * wave;
                const float* s0 = a.in[dir ? I_GDB : I_GDF] + (size_t)(b * 4 + h) * 16384;
#pragma unroll
                for (int dt = 0; dt < 8; ++dt)
#pragma unroll
                    for (int r = 0; r < 4; ++r) S[dt][r] = s0[(size_t)(16 * dt + 4 * g + r) * 128 + v0 + li]; }
            const GdnLatCfg cfg{DfWords{c2}, bid, b, h, dir};
            gdn_stream(a, lds, tid, wave, 64, ws + WS_XB, cfg, S);
        } else if (bid < 48) {
            f32x4 S[8];
            const int pr = bid - 32, b = pr >> 2, h = pr & 3;
            {   const int li = lane & 15, g = lane >> 4, v0 = 16 * wave;
                const float* sa = a.in[I_GLF] + (size_t)(b * 4 + h) * 8192; const float* sb_ = a.in[I_GLB] + (size_t)(b * 4 + h) * 8192;
#pragma unroll
                for (int dt = 0; dt < 4; ++dt)
#pragma unroll
                    for (int r = 0; r < 4; ++r) { S[dt][r] = sa[(size_t)(16 * dt + 4 * g + r) * 128 + v0 + li]; S[4 + dt][r] = sb_[(size_t)(16 * dt + 4 * g + r) * 128 + v0 + li]; } }
            const GlaPairCfg cfg{DfWords{c2}, pr, b, h};
            gla_stream(a, lds, tid, wave, 128, ws + WS_XB, cfg, S);
        } else if (bid < 48 + NCW_GDN + NCW_GLA) {
            const bool wgla = bid >= 48 + NCW_GDN; const int w = wgla ? bid - 48 - NCW_GDN : bid - 48, NW = wgla ? NCW_GLA : NCW_GDN;
            unsigned char* scratch = wgla ? ws + 2 * MiB + (size_t)w * 4 * GLR_BYTES : ws + 21 * MiB + (size_t)w * 4 * GDR_BYTES;
            for (int pr = w; pr < 64; pr += NW) {
                const int b = pr >> 2, h = pr & 3;
                for (int dir = 0; dir < 2; ++dir) {
                    int lv = lane; OPAQUE(lv);
                    const int li = lv & 15, g = lv >> 4, v0 = 16 * wave;
                    for (int q = 0; q < 4; ++q) {
                        if (!wgla) gdn_prep_item(a, lds, tid, lv, wave, TCTX, b * TCTX, h, dir, q, scratch + (size_t)q * GDR_BYTES);
                        else       gla_prep_item(a, lds, tid, lv, wave, TCTX, b * TCTX, h, dir, q, scratch + (size_t)q * GLR_BYTES);
                    }
                    asm volatile("s_waitcnt vmcnt(0)" ::: "memory");
                    __syncthreads();
                    f32x4 Sc[8];
#pragma unroll
                    for (int dt = 0; dt < 8; ++dt) Sc[dt] = (f32x4){0.f, 0.f, 0.f, 0.f};
                    if (!wgla) gdn_esteps(a, lds, tid, lv, wave, TCTX, b * TCTX, h, dir, 0, 4, dir ? 0 : 1000, scratch, Sc);
                    else       gla_esteps(a, lds, tid, lv, wave, TCTX, b * TCTX, h, dir, 0, 4, dir ? 0 : 1000, scratch, Sc);
                    float* so = wgla ? a.out + (dir ? O_GLB : O_GLF) + (size_t)(b * 4 + h) * 8192 : a.out + (dir ? O_GDB : O_GDF) + (size_t)(b * 4 + h) * 16384;
                    const int ndt = wgla ? 4 : 8;
#pragma unroll
                    for (int dt = 0; dt < 8; ++dt) if (dt < ndt) {
#pragma unroll
                        for (int r = 0; r < 4; ++r) so[(size_t)(16 * dt + 4 * g + r) * 128 + v0 + li] = Sc[dt][r]; }
                    asm volatile("s_waitcnt vmcnt(0)" ::: "memory");
                    __syncthreads();
                }
            }
        }
        if (bid >= 48) {
            for (;;) {
                if (wave == 0) {
                    unsigned t0 = 0u; if (lane == 0) t0 = __hip_atomic_fetch_add(DF_Q, 1u, __ATOMIC_RELAXED, __HIP_MEMORY_SCOPE_AGENT);
                    t0 = (unsigned)__builtin_amdgcn_readfirstlane((int)t0);
                    if (t0 < 4096u) { const int s = (int)(t0 >> 8), item = (int)(t0 & 255u);
                        if (s >= 2) df_wait_ge(DF_P((item & 1) ? 32 + ((item & 63) >> 1) : ((item & 63) >> 1)), 4u * (unsigned)(s - 2) + (unsigned)(item >> 6) + 1u, DF_TMO); }
                    if (lane == 0) qslot[0] = t0;
                }
                __syncthreads();
                const unsigned t = (unsigned)__builtin_amdgcn_readfirstlane((int)qslot[0]);
                __syncthreads();
                if (t >= 4096u) break;
                const int s = (int)(t >> 8), item = (int)(t & 255u);
                int lv = lane; OPAQUE(lv);
                unsigned char* wb = rbuf[s & 1];
                const bool gla_ = (item & 1) != 0; const int c_ = (item & 63) >> 1, q_ = item >> 6, idx_ = c_ * 4 + q_;
                const int b_ = c_ >> 3, h_ = (c_ >> 1) & 3, dir_ = c_ & 1, ch_ = 4 * s + q_;
                if (!gla_) gdn_prep_item(a, lds, tid, lv, wave, TLAT, MCTX + b_ * TLAT, h_, dir_, ch_, wb + (size_t)idx_ * GDR_BYTES);
                else       gla_prep_item(a, lds, tid, lv, wave, TLAT, MCTX + b_ * TLAT, h_, dir_, ch_, wb + GLA_OFF + (size_t)idx_ * GLR_BYTES);
                asm volatile("s_waitcnt vmcnt(0)" ::: "memory");
                __syncthreads();
                if (tid == 0) __hip_atomic_store(DF_RDY(s & 1, gla_ ? 160 + idx_ : idx_), (unsigned)s + 1u, __ATOMIC_RELAXED, __HIP_MEMORY_SCOPE_AGENT);
            }
        }
        if (IN(9) && IN(10)) xcd_barrier(bar);
#undef DF_WAIT_GROUP
#undef DF_DONE_GROUP
#undef DF_HALF_WAIT
#undef DF_HALF_MARK
#undef DF_RDY
#undef DF_P
#undef DF_D
#undef DF_Q
#undef DF_TMO
    }
    if (IN(10)) { rows_fin1(a, olane(tid), gw, NGW); } SEAM(10);
    if (IN(11) && IN(12)) {
        GAS unsigned* cnt = (GAS unsigned*)(ctlw + 14720); GAS unsigned* rq = (GAS unsigned*)(ctlw + 16000); GAS unsigned* rtmo = (GAS unsigned*)(ctlw + 16016);
        {   pg8::Gemm g{(const bf16_t*)(ws + WS_XA), (const bf16_t*)(ws + WS_W1OUT), MROWS, 1024, 1024, 1024}; pg8::MMajorOrder S; S.init(MROWS, G, bid);
            EpiStoreBf16Sig E{(bf16_t*)(ws + WS_XB), 1024, cnt};
            pg8::gemm_phase<EpiStoreBf16Sig, pg8::MMajorOrder, true, true>(lds, g, S, E); }
        __syncthreads();
        LAS unsigned char* order = lds + 128;
        LAS unsigned* qs = (LAS unsigned*)(lds + 256);
        constexpr int NMB = MROWS / 256;
        if (tid < NMB) order[tid] = (unsigned char)tid;
        __syncthreads();
        const bf16_t* out2 = (const bf16_t*)(ws + WS_XB); const BufRes ores = make_buf(out2);
        int lane2 = tid; OPAQUE(lane2); lane2 &= 63;
        const RowPar gpost = rowpar_load(a.in[I1_GPOST], lane2); RowPar gate = gpost; int cur = -1;
        for (;;) {
            if (wave == 0) { unsigned q = 0u; if (lane2 == 0) q = __hip_atomic_fetch_add(rq, 1u, __ATOMIC_RELAXED, __HIP_MEMORY_SCOPE_AGENT); q = (unsigned)__builtin_amdgcn_readfirstlane((int)q);
                if (q < (unsigned)(NMB * 16)) df_wait_ge(cnt + (int)order[q >> 4] * 16, 32u, rtmo);
                if (lane2 == 0) qs[0] = q; }
            __syncthreads();
            const unsigned q = (unsigned)__builtin_amdgcn_readfirstlane((int)qs[0]);
            __syncthreads();
            if (q >= (unsigned)(NMB * 16)) break;
            const int pm = (int)order[q >> 4], row = pm * 256 + (int)(q & 15u) * 16 + wave * 2, row2 = row + 1;
            f32x4* y0 = (f32x4*)(a.out + (size_t)row * 1024) + lane2; f32x4* y1 = (f32x4*)(a.out + (size_t)row2 * 1024) + lane2;
            u32x2 o0[4], o1[4], x0[4], x1[4];
#pragma unroll
            for (int j = 0; j < 4; ++j) { o0[j] = bld8nt(ores, (unsigned)(row * 1024 + (64 * j + lane2) * 4) * 2u, 0); o1[j] = bld8nt(ores, (unsigned)(row2 * 1024 + (64 * j + lane2) * 4) * 2u, 0); x0[j] = __builtin_nontemporal_load((const u32x2*)(a.out + (size_t)row * 1024) + lane2 + 64 * j); x1[j] = __builtin_nontemporal_load((const u32x2*)(a.out + (size_t)row2 * 1024) + lane2 + 64 * j); }
            if (row_cv(row) != cur) { cur = row_cv(row); gate = modpar_load(a, (5 + cur) * 3072 + 2048, lane2); }
            final_compute(o0, x0, y0, gate, gpost);
            final_compute(o1, x1, y1, gate, gpost);
        }
    } else {
    if (IN(11)) {
        pg8::Gemm g{(const bf16_t*)(ws + WS_XA), (const bf16_t*)(ws + WS_W1OUT), MROWS, 1024, 1024, 1024}; pg8::StaticOrder S; S.init(MROWS, 1024, G, bid);
        EpiStoreBf16 E{(bf16_t*)(ws + WS_XB), 1024};
        pg8::gemm_phase<EpiStoreBf16, pg8::StaticOrder, true, true>(lds, g, S, E);
    }
    if (IN(12)) { rows_final(a, olane(tid), gw, NGW); }
    }
#undef IN
#undef SEAM
}

extern "C" void kernel_launch(void* const* d_in, const int* in_sizes, int n_in, void* d_out, int out_size, void* d_ws, size_t ws_size, hipStream_t stream) {
    static int grid = 0;
    if (grid == 0) {
        if (n_in != N_IN || out_size != (int)O_END || ws_size < 256 * MiB) { fprintf(stderr, "kernel_launch: unexpected problem (n_in %d, out %d, ws %zu); nothing launched\n", n_in, out_size, ws_size); grid = -1; return; }
        int dev = 0, cus = 0, per_cu = 0;
        if (hipGetDevice(&dev) != hipSuccess || hipDeviceGetAttribute(&cus, hipDeviceAttributeMultiprocessorCount, dev) != hipSuccess) { grid = -1; return; }
        if (hipFuncSetAttribute((const void*)fwd_megakernel, hipFuncAttributeMaxDynamicSharedMemorySize, LDS_BYTES) != hipSuccess) { fprintf(stderr, "kernel_launch: hipFuncSetAttribute failed\n"); grid = -1; return; }
        if (hipOccupancyMaxActiveBlocksPerMultiprocessor(&per_cu, (const void*)fwd_megakernel, 512, LDS_BYTES) != hipSuccess || per_cu < 1) { fprintf(stderr, "kernel_launch: occupancy query reports %d blocks per CU\n", per_cu); (void)hipGetLastError(); grid = -1; return; }
        if (cus < 208) { fprintf(stderr, "kernel_launch: %d CUs: this kernel assigns fixed roles to workgroups 0..192 (prologue) / 0..101 (scan phases) and needs a grid of at least 208 workgroups; nothing launched\n", cus); grid = -1; return; }
        grid = cus;
    }
    if (grid < 0) return;
    Args a{};
    for (int i = 0; i < N_IN; ++i) a.in[i] = (const float*)d_in[i];
    a.out = (float*)d_out; a.ws = (unsigned char*)d_ws; a.ph_lo = 0; a.ph_hi = 13;
    void* args[] = {&a};
    if (hipMemsetAsync(d_ws, 0, 262144, stream) != hipSuccess) { fprintf(stderr, "kernel_launch: hipMemsetAsync failed\n"); return; }
#if defined(PROBE_LO)
    {
        Args p = a; p.ph_lo = PROBE_LO; p.ph_hi = PROBE_HI; p.flags = PROBE_FLAGS; p.pad = 1; void* pargs[] = {&p};
        (void)hipLaunchCooperativeKernel((const void*)fwd_megakernel, dim3(grid), dim3(512), pargs, LDS_BYTES, stream);
    }
#endif
    const hipError_t e = hipLaunchCooperativeKernel((const void*)fwd_megakernel, dim3(grid), dim3(512), args, LDS_BYTES, stream);
    if (e != hipSuccess) fprintf(stderr, "kernel_launch: cooperative launch failed: %s (grid %d)\n", hipGetErrorString(e), grid);
}
```
